# Optimizing an MI355X kernel written in HIP

```python
import functools
import jax, jax.numpy as jnp
from jax import lax
import numpy as np

D_MODEL = 1024
BATCH = 8
SEQ = 2048
DEPTH = 4
DEC_BATCH = 32
DEC_SEQ = 1
PAST_LEN = 8192
PAGE_SIZE = 128

N_A = DEPTH // 2
N_B = DEPTH - N_A
HEAD_DIM = 128
D_CONV = D_MODEL
CONV_W = 3
DIL_CONFIGS = ((128, 1), (512, 4), (2048, 16))
N_GROUPS = len(DIL_CONFIGS)
DIL_HEADS = 4
D_DIL = DIL_HEADS * HEAD_DIM
MEM_LEN = 256
MEM_HEADS = 4
D_MEM = MEM_HEADS * HEAD_DIM
BAND_BLOCK = 128
EPS = 1e-6
NEG = -1e30
D_IN_A = 4 * D_CONV + 2 * D_MEM
D_IN_B = N_GROUPS * D_DIL + D_DIL + 2 * D_MEM
D_KV = N_GROUPS * 2 * D_DIL

kernel_name = "yoco_shortconv_dilated_swa_memxattn_step"


def rms_norm(x, g):
    xf = x.astype(jnp.float32)
    y = xf * lax.rsqrt(jnp.mean(xf * xf, axis=-1, keepdims=True) + EPS) * g.astype(jnp.float32)
    return y.astype(x.dtype)


def mem_kv_proj(mem, norm_g, w, k_norm_g):
    b, m, _ = mem.shape
    kv = (rms_norm(mem, norm_g) @ w).reshape(b, m, 2, MEM_HEADS, HEAD_DIM)
    k = rms_norm(kv[:, :, 0], k_norm_g)
    return jnp.stack([k, kv[:, :, 1]], axis=2)


def mem_attend(q, mem_kv):
    s = jnp.einsum('bthe,bmhe->bhtm', q, mem_kv[:, :, 0], preferred_element_type=jnp.float32)
    p = jax.nn.softmax(s, axis=-1)
    return jnp.einsum('bhtm,bmhe->bthe', p, mem_kv[:, :, 1].astype(jnp.float32)).astype(q.dtype)


def shared_kv(x, kv_norm_g, w_kv, k_norm_g):
    b, t, _ = x.shape
    kv = (rms_norm(x, kv_norm_g) @ w_kv).reshape(b, t, N_GROUPS, 2, DIL_HEADS, HEAD_DIM)
    k = rms_norm(kv[:, :, :, 0], k_norm_g[:, None, :])
    return k, kv[:, :, :, 1]


def band_attend(q, k, v, d, nw):
    b, s_len, h, e = q.shape
    span = d * BAND_BLOCK
    s_pad = -(-s_len // span) * span
    n = s_pad // d
    nb = n // BAND_BLOCK

    def to_res(a):
        a = jnp.pad(a, ((0, 0), (0, s_pad - s_len), (0, 0), (0, 0)))
        a = a.reshape(b, n, d, h, e).transpose(0, 2, 1, 3, 4)
        return a.reshape(b, d, nb, BAND_BLOCK, h, e)

    def with_prev(a):
        prev = jnp.pad(a, ((0, 0), (0, 0), (1, 0), (0, 0), (0, 0), (0, 0)))[:, :, :-1]
        return jnp.concatenate([prev, a], axis=3)

    qb = to_res(q)
    kk = with_prev(to_res(k))
    vv = with_prev(to_res(v))
    s = jnp.einsum('brnqhe,brnkhe->brnhqk', qb, kk, preferred_element_type=jnp.float32)
    qi = jnp.arange(BAND_BLOCK)[:, None]
    kj = jnp.arange(2 * BAND_BLOCK)[None, :]
    rel = qi + BAND_BLOCK - kj
    valid = (rel >= 0) & (rel <= nw)
    has_prev = (jnp.arange(nb)[:, None, None] > 0) | (kj >= BAND_BLOCK)[None]
    valid = valid[None] & has_prev
    s = jnp.where(valid[None, None, :, None], s, NEG)
    m = jnp.max(s, axis=-1, keepdims=True)
    p = jnp.exp(s - m)
    l = jnp.sum(p, axis=-1, keepdims=True)
    o = jnp.einsum('brnhqk,brnkhe->brnqhe', p / l, vv.astype(jnp.float32)).astype(q.dtype)
    lse = (m + jnp.log(l))[..., 0]
    o = o.reshape(b, d, n, h, e).transpose(0, 2, 1, 3, 4).reshape(b, s_pad, h, e)[:, :s_len]
    lse = lse.transpose(0, 1, 2, 4, 3).reshape(b, d, n, h).transpose(0, 2, 1, 3)
    lse = lse.reshape(b, s_pad, h)[:, :s_len]
    return o, lse


def strided_gather_attend(q, kk, vv, d, nw):
    t_len = q.shape[1]
    l_len = kk.shape[1] - t_len
    rows = l_len + jnp.arange(t_len)[:, None] - d * jnp.arange(nw + 1)[None, :]
    valid = rows >= 0
    idx = jnp.maximum(rows, 0)
    kg = kk[:, idx]
    vg = vv[:, idx]
    s = jnp.einsum('bthe,btshe->bhts', q, kg, preferred_element_type=jnp.float32)
    s = jnp.where(valid[None, None], s, NEG)
    m = jnp.max(s, axis=-1, keepdims=True)
    p = jnp.exp(s - m)
    l = jnp.sum(p, axis=-1, keepdims=True)
    o = jnp.einsum('bhts,btshe->bthe', p / l, vg.astype(jnp.float32)).astype(q.dtype)
    lse = (m + jnp.log(l))[..., 0].transpose(0, 2, 1)
    return o, lse


def combine_groups(outs, lses):
    o = jnp.stack(outs, axis=2).astype(jnp.float32)
    w = jax.nn.softmax(jnp.stack(lses, axis=2), axis=2)
    return jnp.sum(o * w[..., None], axis=2).astype(outs[0].dtype)


def dilated_prompt(q, k, v):
    outs, lses = [], []
    for g, (win, d) in enumerate(DIL_CONFIGS):
        o, lse = band_attend(q[:, :, g], k[:, :, g], v[:, :, g], d, win // d)
        outs.append(o)
        lses.append(lse)
    return combine_groups(outs, lses)


def dilated_sample(q, k_new, v_new, bufs):
    outs, lses = [], []
    for g, (win, d) in enumerate(DIL_CONFIGS):
        kk = jnp.concatenate([bufs[g][:, :, 0], k_new[:, :, g]], axis=1)
        vv = jnp.concatenate([bufs[g][:, :, 1], v_new[:, :, g]], axis=1)
        o, lse = strided_gather_attend(q[:, :, g], kk, vv, d, win // d)
        outs.append(o)
        lses.append(lse)
    return combine_groups(outs, lses)


def conv_layer(x, conv_state, mem_kv, norm_g, w_in, conv_w, mem_q_g, w_out):
    b, t, _ = x.shape
    z = rms_norm(x, norm_g) @ w_in
    hh, c, bg, g, mq, mg = jnp.split(
        z, [D_CONV, 2 * D_CONV, 3 * D_CONV, 4 * D_CONV, 4 * D_CONV + D_MEM], axis=-1)
    u = c * hh
    ext = jnp.concatenate([conv_state, u], axis=1)
    y = sum(conv_w[j] * ext[:, j:j + t] for j in range(CONV_W))
    conv_out = jax.nn.silu(g) * bg * y
    q = rms_norm(mq.reshape(b, t, MEM_HEADS, HEAD_DIM), mem_q_g) * (HEAD_DIM ** -0.5)
    mem_out = mem_attend(q, mem_kv).reshape(b, t, D_MEM) * jax.nn.silu(mg)
    out = jnp.concatenate([conv_out, mem_out], axis=-1) @ w_out
    return x + out, ext[:, -(CONV_W - 1):]


def dil_layer(x, dil_fn, mem_kv, norm_g, w_in, q_norm_g, mem_q_g, w_out):
    b, t, _ = x.shape
    z = rms_norm(x, norm_g) @ w_in
    qd, gd, mq, mg = jnp.split(
        z, [N_GROUPS * D_DIL, (N_GROUPS + 1) * D_DIL, (N_GROUPS + 1) * D_DIL + D_MEM], axis=-1)
    qd = rms_norm(qd.reshape(b, t, N_GROUPS, DIL_HEADS, HEAD_DIM), q_norm_g[:, None, :]) * (HEAD_DIM ** -0.5)
    dil_out = dil_fn(qd).reshape(b, t, D_DIL) * jax.nn.silu(gd)
    q = rms_norm(mq.reshape(b, t, MEM_HEADS, HEAD_DIM), mem_q_g) * (HEAD_DIM ** -0.5)
    mem_out = mem_attend(q, mem_kv).reshape(b, t, D_MEM) * jax.nn.silu(mg)
    out = jnp.concatenate([dil_out, mem_out], axis=-1) @ w_out
    return x + out


def setup_inputs(seed: int = 0) -> dict:
    key = jax.random.key(seed)
    ks = jax.random.split(key, 24)
    f32 = jnp.float32

    def nrm(k, shape, scale=1.0):
        return jax.random.normal(k, shape, f32) * scale

    def gain(k, shape):
        return 1.0 + 0.1 * jax.random.normal(k, shape, f32)

    win = [min(w, PAST_LEN) for w, _ in DIL_CONFIGS]
    return {
        "x_prompt": nrm(ks[0], (BATCH, SEQ, D_MODEL)),
        "x_sample": nrm(ks[1], (DEC_BATCH, DEC_SEQ, D_MODEL)),
        "cache_mem_kv": nrm(ks[2], (DEPTH, DEC_BATCH, MEM_LEN, 2, MEM_HEADS, HEAD_DIM)),
        "state_conv": nrm(ks[3], (N_A, DEC_BATCH, CONV_W - 1, D_CONV)),
        "cache_dil0_kv": nrm(ks[4], (DEC_BATCH, win[0], 2, DIL_HEADS, HEAD_DIM)),
        "cache_dil1_kv": nrm(ks[5], (DEC_BATCH, win[1], 2, DIL_HEADS, HEAD_DIM)),
        "cache_dil2_kv": nrm(ks[6], (DEC_BATCH, win[2], 2, DIL_HEADS, HEAD_DIM)),
        "mem_prompt": nrm(ks[7], (BATCH, MEM_LEN, D_MODEL)),
        "norm_a": gain(ks[8], (N_A, D_MODEL)),
        "w_in_a": nrm(ks[9], (N_A, D_MODEL, D_IN_A), D_MODEL ** -0.5),
        "conv_w_a": nrm(ks[10], (N_A, CONV_W, D_CONV), CONV_W ** -0.5),
        "w_out_a": nrm(ks[11], (N_A, D_CONV + D_MEM, D_MODEL), (D_CONV + D_MEM) ** -0.5),
        "norm_b": gain(ks[12], (N_B, D_MODEL)),
        "w_in_b": nrm(ks[13], (N_B, D_MODEL, D_IN_B), D_MODEL ** -0.5),
        "q_norm_b": gain(ks[14], (N_B, N_GROUPS, HEAD_DIM)),
        "w_out_b": nrm(ks[15], (N_B, D_DIL + D_MEM, D_MODEL), (D_DIL + D_MEM) ** -0.5),
        "kv_norm": gain(ks[16], (D_MODEL,)),
        "w_kv": nrm(ks[17], (D_MODEL, D_KV), D_MODEL ** -0.5),
        "k_norm_dil": gain(ks[18], (N_GROUPS, HEAD_DIM)),
        "mem_norm": gain(ks[19], (DEPTH, D_MODEL)),
        "w_mem_kv": nrm(ks[20], (DEPTH, D_MODEL, 2 * D_MEM), D_MODEL ** -0.5),
        "mem_k_norm": gain(ks[21], (DEPTH, HEAD_DIM)),
        "mem_q_norm": gain(ks[22], (DEPTH, HEAD_DIM)),
    }


def reference(x_prompt, x_sample, cache_mem_kv, state_conv, cache_dil0_kv, cache_dil1_kv,
              cache_dil2_kv, mem_prompt, norm_a, w_in_a, conv_w_a, w_out_a, norm_b, w_in_b,
              q_norm_b, w_out_b, kv_norm, w_kv, k_norm_dil, mem_norm, w_mem_kv, mem_k_norm,
              mem_q_norm):
    mem_kv_p = jnp.stack([mem_kv_proj(mem_prompt, mem_norm[l], w_mem_kv[l], mem_k_norm[l])
                          for l in range(DEPTH)])
    xp, xs = x_prompt, x_sample
    s_len = x_prompt.shape[1]
    conv_p, conv_s = [], []
    dil_p_state, dil_s_state = [], []
    dil_p_fn = dil_s_fn = None
    for l in range(DEPTH):
        if l < N_A:
            a = l
            zero_state = jnp.zeros((xp.shape[0], CONV_W - 1, D_CONV), xp.dtype)
            xp, cp = conv_layer(xp, zero_state, mem_kv_p[l], norm_a[a], w_in_a[a], conv_w_a[a],
                                mem_q_norm[l], w_out_a[a])
            xs, cs = conv_layer(xs, state_conv[a], cache_mem_kv[l], norm_a[a], w_in_a[a],
                                conv_w_a[a], mem_q_norm[l], w_out_a[a])
            conv_p.append(cp)
            conv_s.append(cs)
        else:
            if l == N_A:
                kp, vp = shared_kv(xp, kv_norm, w_kv, k_norm_dil)
                ks_, vs_ = shared_kv(xs, kv_norm, w_kv, k_norm_dil)
                dil_p_fn = functools.partial(dilated_prompt, k=kp, v=vp)
                dil_s_fn = functools.partial(dilated_sample, k_new=ks_, v_new=vs_,
                                             bufs=(cache_dil0_kv, cache_dil1_kv, cache_dil2_kv))
                for g, (win, _) in enumerate(DIL_CONFIGS):
                    keep = min(win, s_len)
                    dil_p_state.append(jnp.stack([kp[:, -keep:, g], vp[:, -keep:, g]], axis=2))
                    dil_s_state.append(jnp.stack([ks_[:, :, g], vs_[:, :, g]], axis=2))
            bl = l - N_A
            xp = dil_layer(xp, dil_p_fn, mem_kv_p[l], norm_b[bl], w_in_b[bl], q_norm_b[bl],
                           mem_q_norm[l], w_out_b[bl])
            xs = dil_layer(xs, dil_s_fn, cache_mem_kv[l], norm_b[bl], w_in_b[bl], q_norm_b[bl],
                           mem_q_norm[l], w_out_b[bl])
    conv_prompt = jnp.stack(conv_p)
    conv_sample = jnp.stack(conv_s)
    return (xp, xs, mem_kv_p, conv_prompt, conv_sample,
            dil_p_state[0], dil_p_state[1], dil_p_state[2],
            dil_s_state[0], dil_s_state[1], dil_s_state[2])
```

```cpp
#include <hip/hip_runtime.h>
#include <hip/hip_cooperative_groups.h>
#include <cstdio>
namespace cg = cooperative_groups;

#ifndef N_LAUNCH_MODE
#define N_LAUNCH_MODE 0
#endif

#ifndef RMASK
#define RMASK 0
#endif

#define LAS __attribute__((address_space(3)))
typedef unsigned short bf16_t;
typedef short bf16x8 __attribute__((ext_vector_type(8)));
typedef short s16x4 __attribute__((ext_vector_type(4)));
typedef float f32x4 __attribute__((ext_vector_type(4)));
typedef float f32x16 __attribute__((ext_vector_type(16)));
typedef unsigned u32x4 __attribute__((ext_vector_type(4)));
typedef unsigned u32x2 __attribute__((ext_vector_type(2)));
typedef __bf16 bf16v2 __attribute__((ext_vector_type(2)));

constexpr int D = 1024, NB = 8, SEQ = 2048, MP = NB * SEQ, NS = 32, MR = MP + NS, MEML = 256;
constexpr int NINA = 5120, NKVB = 6144, NINB = 3072, KOUTA = 1536, KOUTB = 1024;
constexpr float EPS = 1e-6f;
constexpr float QSCALE = 0.08838834764831845f * 1.4426950408889634f;

constexpr size_t O_Y = 0, O_MEMKV = 16809984, O_CONVP = 25198592, O_CONVS = 25231360, O_DIL0P = 25362432, O_DIL1P = 26411008,
                 O_DIL2P = 30605312, O_DIL0S = 47382528, O_DIL1S = 47415296, O_DIL2S = 47448064;

constexpr size_t MiB = 1u << 20;
constexpr size_t WS_WMEM = 0, WS_WINA = 8 * MiB, WS_WOUTA = 28 * MiB, WS_WKVB = 34 * MiB, WS_WINB1 = 46 * MiB, WS_WOUTB = 52 * MiB,
                 WS_MEMN = 56 * MiB, WS_MEMKV = 60 * MiB, WS_XB = 76 * MiB, WS_SS = 110 * MiB, WS_Z = 112 * MiB, WS_KVB = 274 * MiB,
                 WS_ACT = 372 * MiB, WS_DILO = 422 * MiB, WS_LSE = 472 * MiB, WS_CTL = 474 * MiB, WS_ZS = 475 * MiB, WS_END = 476 * MiB;
constexpr size_t CTL_ZERO_BYTES = 16384;
constexpr int LDS_ST_OFF = 139264;
constexpr int SS_STRIDE = 16640;

constexpr int LDS_BYTES = 140 * 1024;

__device__ __forceinline__ unsigned pk2(float lo, float hi) { bf16v2 v = {(__bf16)lo, (__bf16)hi}; return __builtin_bit_cast(unsigned, v); }
__device__ __forceinline__ float bflo(unsigned w) { return __builtin_bit_cast(float, w << 16); }
__device__ __forceinline__ float bfhi(unsigned w) { return __builtin_bit_cast(float, w & 0xffff0000u); }
__device__ __forceinline__ float silu(float x) { return x * __builtin_amdgcn_rcpf(1.0f + __builtin_amdgcn_exp2f(x * -1.4426950408889634f)); }
__device__ __forceinline__ float row16_sum(float v) {
    v += __builtin_bit_cast(float, __builtin_amdgcn_mov_dpp(__builtin_bit_cast(int, v), 0xB1, 0xF, 0xF, true));
    v += __builtin_bit_cast(float, __builtin_amdgcn_mov_dpp(__builtin_bit_cast(int, v), 0x4E, 0xF, 0xF, true));
    v += __builtin_bit_cast(float, __builtin_amdgcn_mov_dpp(__builtin_bit_cast(int, v), 0x124, 0xF, 0xF, true));
    v += __builtin_bit_cast(float, __builtin_amdgcn_mov_dpp(__builtin_bit_cast(int, v), 0x128, 0xF, 0xF, true));
    return v;
}
__device__ __forceinline__ float wave_sum(float v) {
#pragma unroll
    for (int o = 1; o < 64; o <<= 1) v += __shfl_xor(v, o);
    return v;
}
__device__ __forceinline__ float wave_max(float v) {
#pragma unroll
    for (int o = 1; o < 64; o <<= 1) v = fmaxf(v, __shfl_xor(v, o));
    return v;
}

namespace pg8 {
constexpr int BM = 256, BK = 64, HALF = 128, HTB = HALF * BK * 2, STAGE_BYTES = 8 * HTB, NXCD = 8, WGM = 4;
__device__ __forceinline__ int lds_byte(int r, int c) { const int st = (r >> 4) * 2 + (c >> 5), rr = r & 15, cc = c & 31, ob = rr * 64 + cc * 2; return st * 1024 + (ob ^ (((ob >> 9) & 1) << 5)); }
__device__ __forceinline__ void stage_rc(int b, int& R, int& C) { const int st = b / 1024, sb = b % 1024, swz = sb ^ (((sb >> 9) & 1) << 5); R = (st >> 1) * 16 + swz / 64; C = (st & 1) * 32 + (swz % 64) / 2; }
__device__ __forceinline__ int perm32(int rho) { const int n = rho >> 4, i = rho & 15; return 8 * (i >> 2) + 4 * n + (i & 3); }
struct Unit { int pm, pn; };
struct Gemm { const bf16_t* A; const bf16_t* Bt; int M, N, K; };
struct StaticOrder {
    int nM, nN, nwg, G, c;
    __device__ void init(int M, int N, int G_, int c_) { nM = M / BM; nN = N / BM; nwg = nM * nN; G = G_; c = c_; }
    __device__ bool next(int i, Unit& u) const {
        const long L = (long)i * G + c; if (L >= nwg) return false;
        int wgid = (int)L; { const int q = nwg / NXCD, r = nwg % NXCD, xcd = wgid % NXCD, off = wgid / NXCD; wgid = (xcd < r ? xcd * (q + 1) : r * (q + 1) + (xcd - r) * q) + off; }
        const int nig = WGM * nN, gid = wgid / nig, fm = gid * WGM, gsz = (nM - fm) < WGM ? (nM - fm) : WGM;
        u.pm = fm + ((wgid % nig) % gsz); u.pn = (wgid % nig) / gsz; return true;
    }
};
struct EpiScale {
    bf16_t* O; int ldc; const LAS float* rst; int split_cols; size_t split_stride;
    float* convp;
    __device__ __forceinline__ void operator()(const f32x4 (&acc)[2][2][4][2], const Unit& u, int wr, int wc, int fr, int fq, int ui) const {
        const int row0 = u.pm * BM + wr * 64 + fr; int colt = u.pn * BM; bf16_t* base = O;
        if (split_cols) { const int t = colt / split_cols; base += (size_t)t * split_stride; colt -= t * split_cols; }
        float rsv[2][4];
        if (convp) { colt = u.pn < 16 ? (u.pn & 7) * 128 + (u.pn >> 3) * 1024 : u.pn * BM - 2048; }
        { const unsigned a = (unsigned)(size_t)(rst + ui * 256 + wr * 64 + fr);
          asm volatile("ds_read_b32 %0, %8\n\tds_read_b32 %1, %8 offset:64\n\tds_read_b32 %2, %8 offset:128\n\tds_read_b32 %3, %8 offset:192\n\t"
                       "ds_read_b32 %4, %8 offset:512\n\tds_read_b32 %5, %8 offset:576\n\tds_read_b32 %6, %8 offset:640\n\tds_read_b32 %7, %8 offset:704\n\ts_waitcnt lgkmcnt(0)"
                       : "=&v"(rsv[0][0]), "=&v"(rsv[0][1]), "=&v"(rsv[0][2]), "=&v"(rsv[0][3]), "=&v"(rsv[1][0]), "=&v"(rsv[1][1]), "=&v"(rsv[1][2]), "=&v"(rsv[1][3]) : "v"(a) : "memory"); }
        const int col0 = colt + wc * 32 + 8 * fq;
        if (convp && u.pn < 16) {
            const bool isu = u.pn < 8;
#pragma unroll
            for (int ai = 0; ai < 2; ++ai)
#pragma unroll
                for (int m = 0; m < 4; ++m) {
                    const int row = row0 + ai * HALF + m * 16; const float rs = rsv[ai][m];
                    f32x4 v0, v1;
                    if (isu) { v0 = acc[ai][0][m][0] * acc[ai][1][m][0] * (rs * rs); v1 = acc[ai][0][m][1] * acc[ai][1][m][1] * (rs * rs); }
                    else {
#pragma unroll
                        for (int j = 0; j < 4; ++j) { v0[j] = acc[ai][0][m][0][j] * rs * silu(acc[ai][1][m][0][j] * rs); v1[j] = acc[ai][0][m][1][j] * rs * silu(acc[ai][1][m][1][j] * rs); } }
                    u32x4 w; w.x = pk2(v0[0], v0[1]); w.y = pk2(v0[2], v0[3]); w.z = pk2(v1[0], v1[1]); w.w = pk2(v1[2], v1[3]);
                    *(u32x4*)(base + (size_t)row * ldc + col0) = w;
                    if (isu && (row & (SEQ - 1)) >= SEQ - 2) { float* cp = convp + ((size_t)(row >> 11) * 2 + ((row & (SEQ - 1)) - (SEQ - 2))) * D + col0; *(f32x4*)cp = v0; *(f32x4*)(cp + 4) = v1; }
                    asm volatile("" ::: "memory"); }
            return;
        }
#pragma unroll
        for (int ai = 0; ai < 2; ++ai)
#pragma unroll
            for (int m = 0; m < 4; ++m) {
                const int row = row0 + ai * HALF + m * 16;
                const float rs = rsv[ai][m];
                bf16_t* rowp = base + (size_t)row * ldc + col0;
#pragma unroll
                for (int bj = 0; bj < 2; ++bj) { const f32x4 v0 = acc[ai][bj][m][0] * rs, v1 = acc[ai][bj][m][1] * rs;
                    u32x4 w; w.x = pk2(v0[0], v0[1]); w.y = pk2(v0[2], v0[3]); w.z = pk2(v1[0], v1[1]); w.w = pk2(v1[2], v1[3]);
                    *(u32x4*)(rowp + bj * HALF) = w; }
                asm volatile("" ::: "memory"); }
    }
};
struct EpiResid {
    bf16_t* xb; float* xout; float* ssn;
    __device__ __forceinline__ void operator()(const f32x4 (&acc)[2][2][4][2], const Unit& u, int wr, int wc, int fr, int fq, int) const {
        const int row0 = u.pm * BM + wr * 64 + fr; const int col0 = u.pn * BM + wc * 32 + 8 * fq;
#pragma unroll
        for (int ai = 0; ai < 2; ++ai)
#pragma unroll
            for (int m = 0; m < 4; ++m) {
                const int row = row0 + ai * HALF + m * 16; float part = 0.f;
#pragma unroll
                for (int bj = 0; bj < 2; ++bj) { const size_t off = (size_t)row * D + col0 + bj * HALF;
                    const u32x4 xw = *(const u32x4*)(xb + off);
                    const f32x4 v0 = acc[ai][bj][m][0] + (f32x4){bflo(xw.x), bfhi(xw.x), bflo(xw.y), bfhi(xw.y)}, v1 = acc[ai][bj][m][1] + (f32x4){bflo(xw.z), bfhi(xw.z), bflo(xw.w), bfhi(xw.w)};
                    if (xout) { *(f32x4*)(xout + off) = v0; *(f32x4*)(xout + off + 4) = v1; }
                    else { u32x4 w; w.x = pk2(v0[0], v0[1]); w.y = pk2(v0[2], v0[3]); w.z = pk2(v1[0], v1[1]); w.w = pk2(v1[2], v1[3]); *(u32x4*)(xb + off) = w;
                        part += (v0[0] * v0[0] + v0[1] * v0[1]) + (v0[2] * v0[2] + v0[3] * v0[3]) + (v1[0] * v1[0] + v1[1] * v1[1]) + (v1[2] * v1[2] + v1[3] * v1[3]); } }
                if (!xout) { part += __shfl_xor(part, 16); part += __shfl_xor(part, 32); if (fq == 0) atomicAdd(ssn + row, part); }
                asm volatile("" ::: "memory"); }
    }
};

template <class Epi>
__device__ __forceinline__ void gemm_phase(LAS unsigned char* lds, const Gemm g, const StaticOrder& S, const Epi& E, const int tid) {
    const int wid = __builtin_amdgcn_readfirstlane(tid >> 6), lane = tid & 63, wr = wid >> 2, wc = wid & 3, fr = lane & 15, fq = lane >> 4;
    const int K = g.K, nt = K / BK;
    unsigned voffA[2], voffB[2];
#pragma unroll
    for (int i = 0; i < 2; ++i) { int R, C; stage_rc(tid * 16 + i * 8192, R, C); const int Rb = (R & ~31) + perm32(R & 31);
        voffA[i] = (unsigned)(R * K + C) * 2u; voffB[i] = (unsigned)(Rb * K + C) * 2u; }
    const size_t kstep = (size_t)(BK * 2);
    const size_t hstep = (size_t)HALF * K * 2;
    const size_t tstep = 2 * hstep;
    const unsigned ldsw = (unsigned)wid * 1024u;
    const int aoff = lds_byte(wr * 64 + fr, fq * 8), boff = lds_byte(wc * 32 + fr, fq * 8);
#define PG8_SA(b, h) (((b) * 2 + (h)) * HTB)
#define PG8_SB(b, h) ((4 + (b) * 2 + (h)) * HTB)
#define PG8_STAGE(bufoff, gbase, voff) do { _Pragma("unroll") for (int _i = 0; _i < 2; ++_i) \
        __builtin_amdgcn_global_load_lds((const unsigned*)((const char*)(gbase) + (voff)[_i]), (LAS unsigned*)(lds + (bufoff) + ldsw + _i * 8192), 16, 0, 0); } while (0)
#define PG8_LDA(dst, b, h) do { _Pragma("unroll") for (int m = 0; m < 4; ++m) _Pragma("unroll") for (int k = 0; k < 2; ++k) dst[m][k] = *(const LAS bf16x8*)(lds + PG8_SA(b, h) + aoff + m * 2048 + k * 1024); } while (0)
#define PG8_LDB(dst, b, h) do { _Pragma("unroll") for (int n = 0; n < 2; ++n) _Pragma("unroll") for (int k = 0; k < 2; ++k) dst[n][k] = *(const LAS bf16x8*)(lds + PG8_SB(b, h) + boff + n * 2048 + k * 1024); } while (0)
#define PG8_MMA(ai, bj, At, Bt) do { __builtin_amdgcn_s_setprio(1); _Pragma("unroll") for (int m = 0; m < 4; ++m) _Pragma("unroll") for (int n = 0; n < 2; ++n) _Pragma("unroll") for (int k = 0; k < 2; ++k) \
        acc[ai][bj][m][n] = __builtin_amdgcn_mfma_f32_16x16x32_bf16(Bt[n][k], At[m][k], acc[ai][bj][m][n], 0, 0, 0); __builtin_amdgcn_s_setprio(0); } while (0)
#define PG8_WAIT_V(n) asm volatile("s_waitcnt vmcnt(" #n ")" ::: "memory")
#define PG8_WAIT_L(n) asm volatile("s_waitcnt lgkmcnt(" #n ")" ::: "memory")
#define PG8_BAR __builtin_amdgcn_s_barrier()
#define PG8_SCHED __builtin_amdgcn_sched_barrier(0)
    Unit cur, nxt; int ui = 0;
    if (!S.next(0, cur)) return;
    f32x4 acc[2][2][4][2];
#pragma unroll
    for (int a = 0; a < 2; ++a)
#pragma unroll
        for (int b = 0; b < 2; ++b)
#pragma unroll
            for (int m = 0; m < 4; ++m)
#pragma unroll
                for (int n = 0; n < 2; ++n) acc[a][b][m][n] = (f32x4){0.f, 0.f, 0.f, 0.f};
    bf16x8 At[4][2], B0[2][2], B1[2][2];
    const char* cA = (const char*)g.A + (size_t)cur.pm * tstep; const char* cB = (const char*)g.Bt + (size_t)cur.pn * tstep;
    PG8_STAGE(PG8_SB(0, 0), cB, voffB); PG8_STAGE(PG8_SA(0, 0), cA, voffA); PG8_STAGE(PG8_SB(0, 1), cB + hstep, voffB); PG8_STAGE(PG8_SA(0, 1), cA + hstep, voffA);
    if (wr == 1) PG8_BAR;
    PG8_WAIT_V(4); PG8_BAR;
    PG8_STAGE(PG8_SB(1, 0), cB + kstep, voffB); PG8_STAGE(PG8_SA(1, 0), cA + kstep, voffA); PG8_STAGE(PG8_SB(1, 1), cB + hstep + kstep, voffB);
    PG8_WAIT_V(6); PG8_BAR;
    for (;;) {
        const bool has_next = S.next(ui + 1, nxt);
        const char* nA = has_next ? (const char*)g.A + (size_t)nxt.pm * tstep : cA; const char* nB = has_next ? (const char*)g.Bt + (size_t)nxt.pn * tstep : cB;
        for (int t = 0; t < nt; t += 2) {
            const bool last = (t == nt - 2);
            const char* a1 = cA + (size_t)(t + 1) * kstep;
            const char* a2 = last ? nA : cA + (size_t)(t + 2) * kstep; const char* b2 = last ? nB : cB + (size_t)(t + 2) * kstep;
            const char* a3 = a2 + kstep; const char* b3 = b2 + kstep;
            PG8_LDB(B0, 0, 0); PG8_SCHED; PG8_LDA(At, 0, 0); PG8_STAGE(PG8_SA(1, 1), a1 + hstep, voffA);
            PG8_WAIT_L(8); PG8_BAR; PG8_WAIT_L(0); PG8_MMA(0, 0, At, B0); PG8_BAR; PG8_SCHED;
            PG8_LDB(B1, 0, 1); PG8_STAGE(PG8_SB(0, 0), b2, voffB);
            PG8_BAR; PG8_WAIT_L(0); PG8_MMA(0, 1, At, B1); PG8_BAR;
            PG8_LDA(At, 0, 1); PG8_STAGE(PG8_SA(0, 0), a2, voffA);
            PG8_BAR; PG8_WAIT_L(0); PG8_MMA(1, 0, At, B0); PG8_BAR; PG8_SCHED;
            PG8_STAGE(PG8_SB(0, 1), b2 + hstep, voffB);
            PG8_WAIT_V(6); PG8_BAR; PG8_MMA(1, 1, At, B1); PG8_BAR;
            PG8_LDB(B0, 1, 0); PG8_SCHED; PG8_LDA(At, 1, 0); PG8_STAGE(PG8_SA(0, 1), a2 + hstep, voffA);
            PG8_WAIT_L(8); PG8_BAR; PG8_WAIT_L(0); PG8_MMA(0, 0, At, B0); PG8_BAR; PG8_SCHED;
            PG8_LDB(B1, 1, 1); PG8_STAGE(PG8_SB(1, 0), b3, voffB);
            PG8_BAR; PG8_WAIT_L(0); PG8_MMA(0, 1, At, B1); PG8_BAR;
            PG8_LDA(At, 1, 1); PG8_STAGE(PG8_SA(1, 0), a3, voffA);
            PG8_BAR; PG8_WAIT_L(0); PG8_MMA(1, 0, At, B0); PG8_BAR; PG8_SCHED;
            PG8_STAGE(PG8_SB(1, 1), b3 + hstep, voffB);
            PG8_WAIT_V(6); PG8_BAR; PG8_MMA(1, 1, At, B1); PG8_BAR;
        }
        E(acc, cur, wr, wc, fr, fq, ui);
        if (!has_next) break;
#pragma unroll
        for (int a = 0; a < 2; ++a)
#pragma unroll
            for (int b = 0; b < 2; ++b)
#pragma unroll
                for (int m = 0; m < 4; ++m)
#pragma unroll
                    for (int n = 0; n < 2; ++n) acc[a][b][m][n] = (f32x4){0.f, 0.f, 0.f, 0.f};
        cur = nxt; cA = nA; cB = nB; ++ui;
    }
    PG8_WAIT_V(0);
    if (wr == 0) PG8_BAR;
    PG8_BAR;
#undef PG8_SA
#undef PG8_SB
#undef PG8_STAGE
#undef PG8_LDA
#undef PG8_LDB
#undef PG8_MMA
#undef PG8_WAIT_V
#undef PG8_WAIT_L
#undef PG8_BAR
#undef PG8_SCHED
}
}

#define XB_TMO      128
#define XB_XCNT(j)  (256  + 64 * (j))
#define XB_XSUB(j)  (1280 + 64 * (j))
#define XB_XGEN(j)  (2304 + 64 * (j))
#define XB_TOP      3328
#define XB_TOPGEN   3392
#define XCD_BAR_WORDS 3456
#define XB_SPIN_CAP (1u << 18)

__device__ __forceinline__ unsigned xb_ld(unsigned* p)              { return __hip_atomic_load(p, __ATOMIC_RELAXED, __HIP_MEMORY_SCOPE_AGENT); }
__device__ __forceinline__ unsigned xb_add(unsigned* p, unsigned v) { return __hip_atomic_fetch_add(p, v, __ATOMIC_RELAXED, __HIP_MEMORY_SCOPE_AGENT); }
__device__ __forceinline__ unsigned xb_xcc_id() { return (unsigned)__builtin_amdgcn_s_getreg((3 << 11) | 20) & 0xFu; }
#define XB_SPIN(cond, bar) do { unsigned _sp = 0; while (cond) { __builtin_amdgcn_s_sleep(1); \
    if ((++_sp & 255u) == 0u) { if (xb_ld(&(bar)[XB_TMO])) break; if (_sp > XB_SPIN_CAP) { atomicAdd(&(bar)[XB_TMO], 1u); break; } } } } while (0)

struct XcdBarrier {
    unsigned* bar; unsigned x;
    volatile LAS unsigned* st;
};

__device__ __forceinline__ XcdBarrier xcd_barrier_post(unsigned* bar, volatile LAS unsigned* st) {
    XcdBarrier b; b.bar = bar; b.x = xb_xcc_id(); b.st = st;
    if (threadIdx.x == 0) (void)xb_add(&bar[XB_XCNT(b.x)], 1u);
    return b;
}
__device__ __forceinline__ void xcd_barrier_complete(unsigned* bar, unsigned x, unsigned& nloc, unsigned& nx) {
    const unsigned G = gridDim.x * gridDim.y * gridDim.z;
    unsigned sum, cnt, mine, sp = 0u;
    for (;;) {
        sum = 0u; cnt = 0u; mine = 0u;
#pragma unroll
        for (unsigned j = 0; j < 16; ++j) { const unsigned c = xb_ld(&bar[XB_XCNT(j)]); sum += c; cnt += (c > 0u) ? 1u : 0u; mine = (j == x) ? c : mine; }
        if (sum == G) break;
        __builtin_amdgcn_s_sleep(1);
        if ((++sp & 255u) == 0u) { if (xb_ld(&bar[XB_TMO])) break; if (sp > XB_SPIN_CAP) { atomicAdd(&bar[XB_TMO], 1u); break; } }
    }
    nloc = mine > 0u ? mine : 1u; nx = cnt > 0u ? cnt : 1u;
}

__device__ __forceinline__ void xcd_barrier(const XcdBarrier& b) {
    asm volatile("s_waitcnt vmcnt(0)" ::: "memory");
    __syncthreads();
    if (threadIdx.x == 0) {
        unsigned* bar = b.bar;
        __builtin_amdgcn_s_waitcnt(0);
        unsigned nloc = b.st[0], nx = b.st[1];
        if (nloc == 0u) { xcd_barrier_complete(bar, b.x, nloc, nx); b.st[0] = nloc; b.st[1] = nx; }
        const unsigned old = xb_add(&bar[XB_XSUB(b.x)], 1u);
        const unsigned gen = old / nloc;
        if (old + 1u == (gen + 1u) * nloc) {
            __builtin_amdgcn_fence(__ATOMIC_RELEASE, "agent");
            asm volatile("s_waitcnt vmcnt(0)" ::: "memory");
            const unsigned og = xb_add(&bar[XB_TOP], 1u);
            const unsigned tg = og / nx;
            if (og + 1u == (tg + 1u) * nx) xb_add(&bar[XB_TOPGEN], 1u);
            else XB_SPIN(xb_ld(&bar[XB_TOPGEN]) == tg, bar);
            __builtin_amdgcn_fence(__ATOMIC_ACQUIRE, "agent");
            xb_add(&bar[XB_XGEN(b.x)], 1u);
            asm volatile("s_waitcnt vmcnt(0)" ::: "memory");
        } else {
            XB_SPIN(xb_ld(&bar[XB_XGEN(b.x)]) == gen, bar);
            __builtin_amdgcn_fence(__ATOMIC_ACQUIRE, "agent");
            asm volatile("s_waitcnt vmcnt(0)" ::: "memory");
        }
    }
    __syncthreads();
}

struct Params {
    const float* in[23];
    float* out;
    unsigned char* ws;
    int ph_lo, ph_hi;
};

struct Ctx {
    const float* const* in; float* out; unsigned char* ws; LAS unsigned char* lds;
    int tid, lane, wid, G, bid;
};
__device__ __forceinline__ Ctx launder(const Ctx& C0) { Ctx C = C0;
    int w = C0.wid, g = C0.G, b = C0.bid; asm volatile("" : "+s"(w), "+s"(g), "+s"(b));
    int t = w * 64 + (int)__builtin_amdgcn_mbcnt_hi(~0u, __builtin_amdgcn_mbcnt_lo(~0u, 0u));
    asm volatile("" : "+v"(t)); C.tid = t; C.lane = t & 63; C.wid = w; C.G = g; C.bid = b; return C; }

__device__ __forceinline__ int perm_a(int n) { if (n >= 4096) return n; const int part = n >> 10, j = n & 1023; return (part >> 1) * 2048 + (j >> 7) * 256 + (part & 1) * 128 + (j & 127); }
__device__ __forceinline__ void p0_transpose_item(const float* W, int K, int N, bf16_t* WT, int row_off, const float* gain, LAS float* scr, int item, int lane, bool pa = false) {
    const int nblk = N / 32, kb = item / nblk, nb = item % nblk, k0 = 64 * kb, n0 = 32 * nb;
    if (pa) row_off = perm_a(n0) - n0;
    float wv[32];
#pragma unroll
    for (int i = 0; i < 32; ++i) wv[i] = __builtin_nontemporal_load(W + (size_t)(k0 + 2 * i + (lane >> 5)) * N + n0 + (lane & 31));
    const float gl = gain ? gain[k0 + lane] : 1.0f;
#pragma unroll
    for (int i = 0; i < 32; ++i) { const int kk = 2 * i + (lane >> 5); const float gv = __shfl(gl, kk); scr[kk * 33 + (lane & 31)] = wv[i] * gv; }
    asm volatile("s_waitcnt lgkmcnt(0)" ::: "memory");
    const int c = lane & 7;
#pragma unroll
    for (int j = 0; j < 4; ++j) { const int n = (lane >> 3) + 8 * j; const LAS float* s = scr + (8 * c) * 33 + n;
        u32x4 o; o.x = pk2(s[0 * 33], s[1 * 33]); o.y = pk2(s[2 * 33], s[3 * 33]); o.z = pk2(s[4 * 33], s[5 * 33]); o.w = pk2(s[6 * 33], s[7 * 33]);
        *(u32x4*)(WT + (size_t)(row_off + n0 + n) * K + k0 + 8 * c) = o; }
    asm volatile("s_waitcnt lgkmcnt(0)" ::: "memory");
}
__device__ __forceinline__ void row_cvt_ss(const float* xrow, bf16_t* orow, float* ssp, int lane) {
    const f32x4* xr = (const f32x4*)xrow + lane; f32x4 v[4]; float s = 0.f;
#pragma unroll
    for (int j = 0; j < 4; ++j) { v[j] = xr[64 * j]; s += (v[j].x * v[j].x + v[j].y * v[j].y) + (v[j].z * v[j].z + v[j].w * v[j].w); }
    s = wave_sum(s);
    u32x2* o8 = (u32x2*)orow + lane;
#pragma unroll
    for (int j = 0; j < 4; ++j) { u32x2 w; w.x = pk2(v[j].x, v[j].y); w.y = pk2(v[j].z, v[j].w); o8[64 * j] = w; }
    if (lane == 0) *ssp = s;
}
__device__ __forceinline__ void p0_prologue(const Ctx& C) {
    LAS float* scr = (LAS float*)(C.lds + C.wid * 16384);
    const int gw = C.bid * 8 + C.wid, NGW = C.G * 8;
    bf16_t* Wmem = (bf16_t*)(C.ws + WS_WMEM); bf16_t* Wina = (bf16_t*)(C.ws + WS_WINA); bf16_t* Wouta = (bf16_t*)(C.ws + WS_WOUTA);
    bf16_t* Wkvb = (bf16_t*)(C.ws + WS_WKVB); bf16_t* Winb1 = (bf16_t*)(C.ws + WS_WINB1); bf16_t* Woutb = (bf16_t*)(C.ws + WS_WOUTB);
    constexpr int I_MEM = 16 * 32, I_INA = 16 * 160, I_OUTA = 24 * 32, I_KV = 16 * 96, I_INB = 16 * 96, I_OUTB = 16 * 32;
    constexpr int NITEMS = 4 * I_MEM + 2 * I_INA + 2 * I_OUTA + I_KV + 2 * I_INB + 2 * I_OUTB;
    for (int it = gw; it < NITEMS; it += NGW) {
        int r = it;
        if (r < 4 * I_MEM) { const int l = r / I_MEM; p0_transpose_item(C.in[20] + (size_t)l * D * 1024, D, 1024, Wmem, l * 1024, C.in[19] + l * D, scr, r % I_MEM, C.lane); continue; } r -= 4 * I_MEM;
        if (r < 2 * I_INA) { const int a = r / I_INA; p0_transpose_item(C.in[9] + (size_t)a * D * NINA, D, NINA, Wina + (size_t)a * NINA * D, 0, C.in[8] + a * D, scr, r % I_INA, C.lane, true); continue; } r -= 2 * I_INA;
        if (r < 2 * I_OUTA) { const int a = r / I_OUTA; p0_transpose_item(C.in[11] + (size_t)a * KOUTA * D, KOUTA, D, Wouta + (size_t)a * D * KOUTA, 0, nullptr, scr, r % I_OUTA, C.lane); continue; } r -= 2 * I_OUTA;
        if (r < I_KV) { p0_transpose_item(C.in[17], D, 3072, Wkvb, 0, C.in[16], scr, r, C.lane); continue; } r -= I_KV;
        if (r < 2 * I_INB) { const int bl = r / I_INB; p0_transpose_item(C.in[13] + (size_t)bl * D * NINB, D, NINB, bl ? Winb1 : Wkvb, bl ? 0 : 3072, C.in[12] + bl * D, scr, r % I_INB, C.lane); continue; } r -= 2 * I_INB;
        { const int bl = r / I_OUTB; p0_transpose_item(C.in[15] + (size_t)bl * KOUTB * D, KOUTB, D, Woutb + (size_t)bl * D * KOUTB, 0, nullptr, scr, r % I_OUTB, C.lane); }
    }
    bf16_t* XB = (bf16_t*)(C.ws + WS_XB); bf16_t* MEMN = (bf16_t*)(C.ws + WS_MEMN); float* SS = (float*)(C.ws + WS_SS);
    for (int m = 2 * gw; m < MR + 2048; m += 2 * NGW) {
        const float* src; bf16_t* dst; float* ssp;
        if (m < MP) { src = C.in[0] + (size_t)m * D; dst = XB + (size_t)m * D; ssp = SS + m; }
        else if (m < MR) { src = C.in[1] + (size_t)(m - MP) * D; dst = XB + (size_t)m * D; ssp = SS + m; }
        else { src = C.in[7] + (size_t)(m - MR) * D; dst = MEMN + (size_t)(m - MR) * D; ssp = SS + 4 * SS_STRIDE + (m - MR); }
        const f32x4* xr = (const f32x4*)src + C.lane; f32x4 v[8]; float s0 = 0.f, s1 = 0.f;
#pragma unroll
        for (int j = 0; j < 8; ++j) v[j] = __builtin_nontemporal_load(xr + 64 * j);
#pragma unroll
        for (int j = 0; j < 4; ++j) { s0 += (v[j].x * v[j].x + v[j].y * v[j].y) + (v[j].z * v[j].z + v[j].w * v[j].w); s1 += (v[4 + j].x * v[4 + j].x + v[4 + j].y * v[4 + j].y) + (v[4 + j].z * v[4 + j].z + v[4 + j].w * v[4 + j].w); }
        s0 = wave_sum(s0); s1 = wave_sum(s1);
        u32x2* o8 = (u32x2*)dst + C.lane;
#pragma unroll
        for (int j = 0; j < 8; ++j) { u32x2 w; w.x = pk2(v[j].x, v[j].y); w.y = pk2(v[j].z, v[j].w); o8[64 * j] = w; }
        if (C.lane == 0) { ssp[0] = s0; ssp[1] = s1; }
    }
    for (int i = C.bid * 512 + C.tid; i < 3 * SS_STRIDE; i += C.G * 512) SS[SS_STRIDE + i] = 0.f;
}

template <class F>
__device__ __forceinline__ void sgemm_tile(const Ctx& C, const bf16_t* A, int lda, const bf16_t* Bt, int K, int tile, float* ssrow, F epi) {
    LAS float* red = (LAS float*)C.lds;
    int lane = C.lane; asm volatile("" : "+v"(lane));
    const int r = lane & 31, h = lane >> 5, kc = K / 8, k0 = C.wid * kc, nst = kc / 16;
    f32x16 acc; for (int i = 0; i < 16; ++i) acc[i] = 0.f;
    const bf16_t* ap = A + (size_t)r * lda + k0 + 8 * h;
    const bf16_t* bp = Bt + (size_t)(tile * 32 + r) * K + k0 + 8 * h;
    bf16x8 av[12], bv[12];
#pragma unroll
    for (int s = 0; s < 12; ++s) if (s < nst) { av[s] = *(const bf16x8*)(ap + 16 * s); bv[s] = *(const bf16x8*)(bp + 16 * s); }
#pragma unroll
    for (int s = 0; s < 12; ++s) if (s < nst) acc = __builtin_amdgcn_mfma_f32_32x32x16_bf16(av[s], bv[s], acc, 0, 0, 0);
#pragma unroll
    for (int i = 0; i < 16; ++i) { const int row = (i & 3) + 8 * (i >> 2) + 4 * h; red[(C.wid * 32 + row) * 32 + r] = acc[i]; }
    __syncthreads();
#pragma unroll
    for (int rep = 0; rep < 2; ++rep) { const int idx = C.tid + 512 * rep; float v = 0.f;
#pragma unroll
        for (int w = 0; w < 8; ++w) v += red[w * 1024 + idx];
        float sq = epi(idx >> 5, tile * 32 + (idx & 31), v);
        if (ssrow) { sq += __shfl_xor(sq, 16); sq += __shfl_xor(sq, 8); sq += __shfl_xor(sq, 4); sq += __shfl_xor(sq, 2); sq += __shfl_xor(sq, 1);
            if ((lane & 31) == 0) atomicAdd(ssrow + (idx >> 5), sq); } }
    __syncthreads();
}

__device__ __forceinline__ unsigned off_b(unsigned row, unsigned ch) { return 256u * row + 16u * (ch ^ (((row & 3) << 2) | ((row >> 2) & 3))); }
struct AttnP {
    const bf16_t* q; int ldq, qrow0, qrstep;
    const bf16_t* k; const bf16_t* v; int ldk, krow0, krstep;
    const float* gq; const float* gk;
    int mode;
    float* kvout; int kv_jfrom; size_t kv_ostride;
    bf16_t* o; int ldo;
    const bf16_t* gate;
    float* lse;
    const bf16_t* cdil; const float* clse;
};
struct NextKV { const bf16_t* k; int ldk, krow0, krstep, it0, valid; };
__device__ __forceinline__ void attn_item(const Ctx& C, const AttnP& P, u32x4 (&kw)[8], u32x4 (&vw)[8], const bool have, const NextKV& nx) {
    int tid = C.tid; asm volatile("" : "+v"(tid));
    const int lane = tid & 63, wid = C.wid, r = lane & 31, h = lane >> 5, qb = wid & 3, kh = wid >> 2;
    LAS unsigned char* Kl = C.lds; LAS unsigned char* Vl = C.lds + 65536;
    bf16x8 qf[8];
    const int qrow = P.qrow0 + (32 * qb + r) * P.qrstep;
    {
        const int c = tid & 15, kr = tid >> 4, it0 = (P.mode == 2 ? 4 : 0);
        const bf16_t* qp = P.q + (size_t)qrow * P.ldq + 8 * h;
        u32x4 raw[8];
#pragma unroll
        for (int s = 0; s < 8; ++s) raw[s] = *(const u32x4*)(qp + 16 * s);
        if (!have) {
#pragma unroll
            for (int it = 0; it < 8; ++it) if (it >= it0) { const size_t row = (size_t)(P.krow0 + (kr + 32 * it) * P.krstep);
                kw[it] = *(const u32x4*)(P.k + row * P.ldk + 8 * c); vw[it] = *(const u32x4*)(P.v + row * P.ldk + 8 * c); } }
        float ss = 0.f;
#pragma unroll
        for (int s = 0; s < 8; ++s)
#pragma unroll
            for (int j = 0; j < 4; ++j) { const float a = bflo(raw[s][j]), b = bfhi(raw[s][j]); ss += a * a + b * b; }
        ss += __shfl_xor(ss, 32);
        const float rs = rsqrtf(ss * (1.0f / 128.0f) + EPS) * QSCALE;
#pragma unroll
        for (int s = 0; s < 8; ++s) {
            u32x4 w; w.x = pk2(bflo(raw[s][0]) * rs, bfhi(raw[s][0]) * rs); w.y = pk2(bflo(raw[s][1]) * rs, bfhi(raw[s][1]) * rs);
            w.z = pk2(bflo(raw[s][2]) * rs, bfhi(raw[s][2]) * rs); w.w = pk2(bflo(raw[s][3]) * rs, bfhi(raw[s][3]) * rs);
            qf[s] = __builtin_bit_cast(bf16x8, w); }
        const f32x4 gk0 = *(const f32x4*)(P.gk + 8 * c), gk1 = *(const f32x4*)(P.gk + 8 * c + 4);
        const f32x4 gq0 = *(const f32x4*)(P.gq + 8 * c), gq1 = *(const f32x4*)(P.gq + 8 * c + 4);
#pragma unroll
        for (int it = 0; it < 8; ++it) if (it >= it0) {
            const int j = kr + 32 * it;
            f32x4 k0 = {bflo(kw[it].x), bfhi(kw[it].x), bflo(kw[it].y), bfhi(kw[it].y)}, k1 = {bflo(kw[it].z), bfhi(kw[it].z), bflo(kw[it].w), bfhi(kw[it].w)};
            float s2 = (k0[0] * k0[0] + k0[1] * k0[1]) + (k0[2] * k0[2] + k0[3] * k0[3]) + (k1[0] * k1[0] + k1[1] * k1[1]) + (k1[2] * k1[2] + k1[3] * k1[3]);
            s2 = row16_sum(s2);
            const float rk = rsqrtf(s2 * (1.0f / 128.0f) + EPS);
            k0 = k0 * rk * gk0; k1 = k1 * rk * gk1;
            const f32x4 kq0 = k0 * gq0, kq1 = k1 * gq1;
            u32x4 w; w.x = pk2(kq0[0], kq0[1]); w.y = pk2(kq0[2], kq0[3]); w.z = pk2(kq1[0], kq1[1]); w.w = pk2(kq1[2], kq1[3]);
            *(LAS u32x4*)(Kl + off_b(j, c)) = w; *(LAS u32x4*)(Vl + off_b(j, c)) = vw[it];
            if (j >= P.kv_jfrom) { float* o = P.kvout + (size_t)(j - P.kv_jfrom) * P.kv_ostride + 8 * c;
                *(f32x4*)o = k0; *(f32x4*)(o + 4) = k1;
                *(f32x4*)(o + 512) = (f32x4){bflo(vw[it].x), bfhi(vw[it].x), bflo(vw[it].y), bfhi(vw[it].y)}; *(f32x4*)(o + 516) = (f32x4){bflo(vw[it].z), bfhi(vw[it].z), bflo(vw[it].w), bfhi(vw[it].w)}; }
        }
    }
    __syncthreads();
    f32x16 o[4]; float mrow = -1e30f, lrow = 0.f;
    const bool active = !(P.mode == 2 && kh == 0);
    u32x4 pb[4][2];
    if (active) {
        {
            f32x16 sacc[4];
            const unsigned xr = ((r & 3) << 2) | ((r >> 2) & 3);
            unsigned kaddr[8];
#pragma unroll
            for (int s = 0; s < 8; ++s) kaddr[s] = 256u * (128 * kh + r) + 16u * ((unsigned)(2 * s + h) ^ xr);
#pragma unroll
            for (int kt = 0; kt < 4; ++kt) { for (int i = 0; i < 16; ++i) sacc[kt][i] = -1e30f;
                if (P.mode == 0 || (kh ? kt <= qb : kt >= qb)) {
                    for (int i = 0; i < 16; ++i) sacc[kt][i] = 0.f;
#pragma unroll
                    for (int s = 0; s < 8; ++s) { const bf16x8 a = *(const LAS bf16x8*)(Kl + kaddr[s] + 8192 * kt); sacc[kt] = __builtin_amdgcn_mfma_f32_32x32x16_bf16(a, qf[s], sacc[kt], 0, 0, 0); } }
                asm volatile("" ::: "memory"); }
            const int qi = 32 * qb + r;
            if (P.mode != 0) {
#pragma unroll
                for (int kt = 0; kt < 4; ++kt)
#pragma unroll
                    for (int i = 0; i < 16; ++i) { const int kj = 32 * kt + (i & 3) + 8 * (i >> 2) + 4 * h; const bool valid = kh ? (kj <= qi) : (kj >= qi); sacc[kt][i] = valid ? sacc[kt][i] : -1e30f; }
            }
            float m = -1e30f;
#pragma unroll
            for (int kt = 0; kt < 4; ++kt)
#pragma unroll
                for (int i = 0; i < 16; ++i) m = fmaxf(m, sacc[kt][i]);
            m = fmaxf(m, __shfl_xor(m, 32));
            float l = 0.f;
#pragma unroll
            for (int kt = 0; kt < 4; ++kt)
#pragma unroll
                for (int s2 = 0; s2 < 2; ++s2) {
                    float pv[8];
#pragma unroll
                    for (int j = 0; j < 8; ++j) { pv[j] = __builtin_amdgcn_exp2f(sacc[kt][8 * s2 + j] - m); l += pv[j]; }
                    pb[kt][s2].x = pk2(pv[0], pv[1]); pb[kt][s2].y = pk2(pv[2], pv[3]); pb[kt][s2].z = pk2(pv[4], pv[5]); pb[kt][s2].w = pk2(pv[6], pv[7]);
                }
            l += __shfl_xor(l, 32);
            mrow = m; lrow = l;
        }
    }
    if (nx.valid) {
        const int c = tid & 15, kr = tid >> 4;
#pragma unroll
        for (int it = 0; it < 8; ++it) if (it >= nx.it0) { const size_t row = (size_t)(nx.krow0 + (kr + 32 * it) * nx.krstep);
            kw[it] = *(const u32x4*)(nx.k + row * nx.ldk + 8 * c); vw[it] = *(const u32x4*)(nx.k + 512 + row * nx.ldk + 8 * c); }
    }
#pragma unroll
    for (int et = 0; et < 4; ++et) for (int i = 0; i < 16; ++i) o[et][i] = 0.f;
    if (active) {
        const int q4 = (lane & 15) >> 2, p4 = lane & 3, blk = (lane >> 4) & 1, clow = 2 * blk + (p4 >> 1);
        unsigned vaddr[4][2];
#pragma unroll
        for (int et = 0; et < 4; ++et)
#pragma unroll
            for (int hi = 0; hi < 2; ++hi) vaddr[et][hi] = 256u * (128 * kh + 4 * h + q4 + 8 * hi) + 64u * (unsigned)(et ^ q4) + 16u * (unsigned)(clow ^ (h + 2 * hi)) + 8u * (p4 & 1);
#pragma unroll
        for (int kt = 0; kt < 4; ++kt)
#pragma unroll
            for (int s2 = 0; s2 < 2; ++s2) if (P.mode == 0 || (kh ? kt <= qb : kt >= qb)) {
                const bf16x8 pbv = __builtin_bit_cast(bf16x8, pb[kt][s2]);
#pragma unroll
                for (int et = 0; et < 4; ++et) {
                    const s16x4 lo = __builtin_amdgcn_ds_read_tr16_b64_v4i16((LAS s16x4*)(Vl + vaddr[et][0] + 8192 * kt + 4096 * s2));
                    const s16x4 hi = __builtin_amdgcn_ds_read_tr16_b64_v4i16((LAS s16x4*)(Vl + vaddr[et][1] + 8192 * kt + 4096 * s2));
                    const bf16x8 va = __builtin_shufflevector(lo, hi, 0, 1, 2, 3, 4, 5, 6, 7);
                    o[et] = __builtin_amdgcn_mfma_f32_32x32x16_bf16(va, pbv, o[et], 0, 0, 0);
                }
                asm volatile("" ::: "memory");
            }
    }
    __syncthreads();
    LAS float* Mo = (LAS float*)C.lds;
    LAS float* Mml = (LAS float*)(C.lds + 65536);
    if (kh == 1) {
#pragma unroll
        for (int et = 0; et < 4; ++et)
#pragma unroll
            for (int i = 0; i < 16; ++i) { const int e = 32 * et + (i & 3) + 8 * (i >> 2) + 4 * h; Mo[(qb * 128 + e) * 32 + r] = o[et][i]; }
        if (h == 0) { Mml[(qb * 2 + 0) * 32 + r] = mrow; Mml[(qb * 2 + 1) * 32 + r] = lrow; }
    }
    __syncthreads();
    LAS unsigned char* Ot = C.lds + 65536 + 2048;
    if (kh == 0) {
        const float m1 = Mml[(qb * 2 + 0) * 32 + r], l1 = Mml[(qb * 2 + 1) * 32 + r];
        const float m = fmaxf(mrow, m1), w0 = __builtin_amdgcn_exp2f(mrow - m), w1 = __builtin_amdgcn_exp2f(m1 - m), l = lrow * w0 + l1 * w1, inv = 1.0f / l;
        const float a0 = w0 * inv, a1 = w1 * inv;
#pragma unroll
        for (int et = 0; et < 4; ++et)
#pragma unroll
            for (int g4 = 0; g4 < 4; ++g4) {
                const int e0 = 32 * et + 8 * g4 + 4 * h;
                float v[4];
#pragma unroll
                for (int j = 0; j < 4; ++j) v[j] = o[et][4 * g4 + j] * a0 + Mo[(qb * 128 + e0 + j) * 32 + r] * a1;
                u32x2 w; w.x = pk2(v[0], v[1]); w.y = pk2(v[2], v[3]);
                *(LAS u32x2*)(Ot + (32 * qb + r) * 272 + 2 * e0) = w;
            }
        if (P.mode != 0 && h == 0) P.lse[(size_t)qrow * 4] = m + log2f(l);
    }
    __syncthreads();
#pragma unroll
    for (int i = 0; i < 4; ++i) { const int id = tid + 512 * i, qi = id >> 4, c = id & 15; const size_t grow = (size_t)(P.qrow0 + qi * P.qrstep);
        u32x4 w = *(const LAS u32x4*)(Ot + qi * 272 + 16 * c);
        if (P.mode == 0) { const u32x4 gw = *(const u32x4*)(P.gate + grow * P.ldq + 8 * c);
#pragma unroll
            for (int j = 0; j < 4; ++j) w[j] = pk2(bflo(w[j]) * silu(bflo(gw[j])), bfhi(w[j]) * silu(bfhi(gw[j]))); }
        *(u32x4*)(P.o + grow * P.ldo + 8 * c) = w;
        if (P.cdil) {
            const float l0 = P.clse[grow * 4], l1 = P.clse[((size_t)MR + grow) * 4], l2 = P.clse[((size_t)2 * MR + grow) * 4];
            const float mm = fmaxf(l0, fmaxf(l1, l2)); float w0 = __builtin_amdgcn_exp2f(l0 - mm), w1 = __builtin_amdgcn_exp2f(l1 - mm), w2 = __builtin_amdgcn_exp2f(l2 - mm); const float inv = 1.0f / (w0 + w1 + w2);
            w0 *= inv; w1 *= inv; w2 *= inv;
            const u32x4 a = *(const u32x4*)(P.cdil + grow * 512 + 8 * c), b = *(const u32x4*)(P.cdil + ((size_t)MR + grow) * 512 + 8 * c),
                        cc = *(const u32x4*)(P.cdil + ((size_t)2 * MR + grow) * 512 + 8 * c), gd = *(const u32x4*)(P.gate - 1024 + grow * P.ldq + 8 * c);
            u32x4 wo;
#pragma unroll
            for (int j = 0; j < 4; ++j) wo[j] = pk2((bflo(a[j]) * w0 + bflo(b[j]) * w1 + bflo(cc[j]) * w2) * silu(bflo(gd[j])), (bfhi(a[j]) * w0 + bfhi(b[j]) * w1 + bfhi(cc[j]) * w2) * silu(bfhi(gd[j])));
            *(u32x4*)(P.o - 512 + grow * P.ldo + 8 * c) = wo; } }
    __syncthreads();
}

__device__ __forceinline__ void attn_item_wide(const Ctx& C, const AttnP& P, u32x4 (&kw)[8], u32x4 (&vw)[8], const bool have, const NextKV& nx) {
    int tid = C.tid; asm volatile("" : "+v"(tid));
    const int lane = tid & 63, wid = C.wid, r = lane & 31, h = lane >> 5;
    LAS unsigned char* Kl = C.lds; LAS unsigned char* Vl = C.lds + 65536;
    bf16x8 qf[8];
    const int qrow = P.qrow0 + 32 * wid + r;
    {
        const int c = tid & 15, kr = tid >> 4;
        const bf16_t* qp = P.q + (size_t)qrow * P.ldq + 8 * h;
        u32x4 raw[8];
#pragma unroll
        for (int s = 0; s < 8; ++s) raw[s] = *(const u32x4*)(qp + 16 * s);
        if (!have) {
#pragma unroll
            for (int it = 0; it < 8; ++it) { const size_t row = (size_t)(P.krow0 + (kr + 32 * it) * P.krstep);
                kw[it] = *(const u32x4*)(P.k + row * P.ldk + 8 * c); vw[it] = *(const u32x4*)(P.v + row * P.ldk + 8 * c); } }
        float ss = 0.f;
#pragma unroll
        for (int s = 0; s < 8; ++s)
#pragma unroll
            for (int j = 0; j < 4; ++j) { const float a = bflo(raw[s][j]), b = bfhi(raw[s][j]); ss += a * a + b * b; }
        ss += __shfl_xor(ss, 32);
        const float rs = rsqrtf(ss * (1.0f / 128.0f) + EPS) * QSCALE;
#pragma unroll
        for (int s = 0; s < 8; ++s) {
            u32x4 w; w.x = pk2(bflo(raw[s][0]) * rs, bfhi(raw[s][0]) * rs); w.y = pk2(bflo(raw[s][1]) * rs, bfhi(raw[s][1]) * rs);
            w.z = pk2(bflo(raw[s][2]) * rs, bfhi(raw[s][2]) * rs); w.w = pk2(bflo(raw[s][3]) * rs, bfhi(raw[s][3]) * rs);
            qf[s] = __builtin_bit_cast(bf16x8, w); }
        const f32x4 gk0 = *(const f32x4*)(P.gk + 8 * c), gk1 = *(const f32x4*)(P.gk + 8 * c + 4);
        const f32x4 gq0 = *(const f32x4*)(P.gq + 8 * c), gq1 = *(const f32x4*)(P.gq + 8 * c + 4);
#pragma unroll
        for (int it = 0; it < 8; ++it) {
            const int j = kr + 32 * it;
            f32x4 k0 = {bflo(kw[it].x), bfhi(kw[it].x), bflo(kw[it].y), bfhi(kw[it].y)}, k1 = {bflo(kw[it].z), bfhi(kw[it].z), bflo(kw[it].w), bfhi(kw[it].w)};
            float s2 = (k0[0] * k0[0] + k0[1] * k0[1]) + (k0[2] * k0[2] + k0[3] * k0[3]) + (k1[0] * k1[0] + k1[1] * k1[1]) + (k1[2] * k1[2] + k1[3] * k1[3]);
            s2 = row16_sum(s2);
            const float rk = rsqrtf(s2 * (1.0f / 128.0f) + EPS);
            k0 = k0 * rk * gk0; k1 = k1 * rk * gk1;
            const f32x4 kq0 = k0 * gq0, kq1 = k1 * gq1;
            u32x4 w; w.x = pk2(kq0[0], kq0[1]); w.y = pk2(kq0[2], kq0[3]); w.z = pk2(kq1[0], kq1[1]); w.w = pk2(kq1[2], kq1[3]);
            *(LAS u32x4*)(Kl + off_b(j, c)) = w; *(LAS u32x4*)(Vl + off_b(j, c)) = vw[it];
            if (j >= P.kv_jfrom) { float* o = P.kvout + (size_t)(j - P.kv_jfrom) * P.kv_ostride + 8 * c;
                *(f32x4*)o = k0; *(f32x4*)(o + 4) = k1;
                *(f32x4*)(o + 512) = (f32x4){bflo(vw[it].x), bfhi(vw[it].x), bflo(vw[it].y), bfhi(vw[it].y)}; *(f32x4*)(o + 516) = (f32x4){bflo(vw[it].z), bfhi(vw[it].z), bflo(vw[it].w), bfhi(vw[it].w)}; }
        }
    }
    __syncthreads();
    f32x16 o[4]; float mrun = -1e30f, lrun = 0.f;
#pragma unroll
    for (int et = 0; et < 4; ++et) for (int i = 0; i < 16; ++i) o[et][i] = 0.f;
    const unsigned xr = ((r & 3) << 2) | ((r >> 2) & 3);
    const int q4 = (lane & 15) >> 2, p4 = lane & 3, blk = (lane >> 4) & 1, clow = 2 * blk + (p4 >> 1);
#pragma unroll
    for (int st = 0; st < 4; ++st) {
        u32x4 pb[2][2];
        {
            f32x16 sacc[2];
            unsigned kaddr[8];
#pragma unroll
            for (int s = 0; s < 8; ++s) kaddr[s] = 256u * (64 * st + r) + 16u * ((unsigned)(2 * s + h) ^ xr);
#pragma unroll
            for (int kt = 0; kt < 2; ++kt) { for (int i = 0; i < 16; ++i) sacc[kt][i] = 0.f;
#pragma unroll
                for (int s = 0; s < 8; ++s) { const bf16x8 a = *(const LAS bf16x8*)(Kl + kaddr[s] + 8192 * kt); sacc[kt] = __builtin_amdgcn_mfma_f32_32x32x16_bf16(a, qf[s], sacc[kt], 0, 0, 0); }
                asm volatile("" ::: "memory"); }
            float m = mrun;
#pragma unroll
            for (int kt = 0; kt < 2; ++kt)
#pragma unroll
                for (int i = 0; i < 16; ++i) m = fmaxf(m, sacc[kt][i]);
            m = fmaxf(m, __shfl_xor(m, 32));
            const float alpha = __builtin_amdgcn_exp2f(mrun - m);
            float l = 0.f;
#pragma unroll
            for (int kt = 0; kt < 2; ++kt)
#pragma unroll
                for (int s2 = 0; s2 < 2; ++s2) {
                    float pv[8];
#pragma unroll
                    for (int j = 0; j < 8; ++j) { pv[j] = __builtin_amdgcn_exp2f(sacc[kt][8 * s2 + j] - m); l += pv[j]; }
                    pb[kt][s2].x = pk2(pv[0], pv[1]); pb[kt][s2].y = pk2(pv[2], pv[3]); pb[kt][s2].z = pk2(pv[4], pv[5]); pb[kt][s2].w = pk2(pv[6], pv[7]);
                }
            l += __shfl_xor(l, 32);
            lrun = lrun * alpha + l; mrun = m;
#pragma unroll
            for (int et = 0; et < 4; ++et) o[et] = o[et] * alpha;
        }
        if (st == 3 && nx.valid) {
            const int c = tid & 15, kr = tid >> 4;
#pragma unroll
            for (int it = 0; it < 8; ++it) if (it >= nx.it0) { const size_t row = (size_t)(nx.krow0 + (kr + 32 * it) * nx.krstep);
                kw[it] = *(const u32x4*)(nx.k + row * nx.ldk + 8 * c); vw[it] = *(const u32x4*)(nx.k + 512 + row * nx.ldk + 8 * c); }
        }
        unsigned vaddr[4][2];
#pragma unroll
        for (int et = 0; et < 4; ++et)
#pragma unroll
            for (int hi = 0; hi < 2; ++hi) vaddr[et][hi] = 256u * (64 * st + 4 * h + q4 + 8 * hi) + 64u * (unsigned)(et ^ q4) + 16u * (unsigned)(clow ^ (h + 2 * hi)) + 8u * (p4 & 1);
#pragma unroll
        for (int kt = 0; kt < 2; ++kt)
#pragma unroll
            for (int s2 = 0; s2 < 2; ++s2) {
                const bf16x8 pbv = __builtin_bit_cast(bf16x8, pb[kt][s2]);
#pragma unroll
                for (int et = 0; et < 4; ++et) {
                    const s16x4 lo = __builtin_amdgcn_ds_read_tr16_b64_v4i16((LAS s16x4*)(Vl + vaddr[et][0] + 8192 * kt + 4096 * s2));
                    const s16x4 hi = __builtin_amdgcn_ds_read_tr16_b64_v4i16((LAS s16x4*)(Vl + vaddr[et][1] + 8192 * kt + 4096 * s2));
                    const bf16x8 va = __builtin_shufflevector(lo, hi, 0, 1, 2, 3, 4, 5, 6, 7);
                    o[et] = __builtin_amdgcn_mfma_f32_32x32x16_bf16(va, pbv, o[et], 0, 0, 0);
                }
                asm volatile("" ::: "memory");
            }
    }
    __syncthreads();
    LAS unsigned char* Ot = C.lds;
    {
        const float inv = 1.0f / lrun;
#pragma unroll
        for (int et = 0; et < 4; ++et)
#pragma unroll
            for (int g4 = 0; g4 < 4; ++g4) {
                const int e0 = 32 * et + 8 * g4 + 4 * h;
                u32x2 w; w.x = pk2(o[et][4 * g4 + 0] * inv, o[et][4 * g4 + 1] * inv); w.y = pk2(o[et][4 * g4 + 2] * inv, o[et][4 * g4 + 3] * inv);
                *(LAS u32x2*)(Ot + (32 * wid + r) * 272 + 2 * e0) = w;
            }
    }
    __syncthreads();
#pragma unroll 2
    for (int i = 0; i < 8; ++i) { const int id = tid + 512 * i, qi = id >> 4, c = id & 15; const size_t grow = (size_t)(P.qrow0 + qi);
        u32x4 w = *(const LAS u32x4*)(Ot + qi * 272 + 16 * c);
        { const u32x4 gw = *(const u32x4*)(P.gate + grow * P.ldq + 8 * c);
#pragma unroll
            for (int j = 0; j < 4; ++j) w[j] = pk2(bflo(w[j]) * silu(bflo(gw[j])), bfhi(w[j]) * silu(bfhi(gw[j]))); }
        *(u32x4*)(P.o + grow * P.ldo + 8 * c) = w;
        if (P.cdil) {
            const float l0 = P.clse[grow * 4], l1 = P.clse[((size_t)MR + grow) * 4], l2 = P.clse[((size_t)2 * MR + grow) * 4];
            const float mm = fmaxf(l0, fmaxf(l1, l2)); float w0 = __builtin_amdgcn_exp2f(l0 - mm), w1 = __builtin_amdgcn_exp2f(l1 - mm), w2 = __builtin_amdgcn_exp2f(l2 - mm); const float inv = 1.0f / (w0 + w1 + w2);
            w0 *= inv; w1 *= inv; w2 *= inv;
            const u32x4 a = *(const u32x4*)(P.cdil + grow * 512 + 8 * c), b = *(const u32x4*)(P.cdil + ((size_t)MR + grow) * 512 + 8 * c),
                        cc = *(const u32x4*)(P.cdil + ((size_t)2 * MR + grow) * 512 + 8 * c), gd = *(const u32x4*)(P.gate - 1024 + grow * P.ldq + 8 * c);
            u32x4 wo;
#pragma unroll
            for (int j = 0; j < 4; ++j) wo[j] = pk2((bflo(a[j]) * w0 + bflo(b[j]) * w1 + bflo(cc[j]) * w2) * silu(bflo(gd[j])), (bfhi(a[j]) * w0 + bfhi(b[j]) * w1 + bfhi(cc[j]) * w2) * silu(bfhi(gd[j])));
            *(u32x4*)(P.o - 512 + grow * P.ldo + 8 * c) = wo; } }
    __syncthreads();
}

struct SAttnP {
    const bf16_t* q; const float* gq;
    const float* kbase; long kstride; int nk;
    const bf16_t* knew; const bf16_t* vnew; const float* gk;
    float* newout;
    bf16_t* o; const bf16_t* gate; float* lse;
};
__device__ __forceinline__ void sattn_item(const Ctx& C, const SAttnP& P) {
    LAS float* sq = (LAS float*)C.lds;
    LAS float* kn = sq + 128;
    LAS float* vn = kn + 128;
    LAS float* sc = vn + 128;
    LAS float* red = sc + 320;
    int tid = C.tid; asm volatile("" : "+v"(tid));
    const int lane = tid & 63, wid = C.wid;
    const bool extra = P.knew != nullptr;
    const int hw = tid >> 5, l32 = tid & 31, nkh = P.nk >> 4;
    const int eg = tid & 31, kg = tid >> 5, per = P.nk >> 4;
    f32x4 kv[16], vv[16];
#pragma unroll
    for (int i = 0; i < 16; ++i) if (i < nkh) kv[i] = __builtin_nontemporal_load((const f32x4*)(P.kbase + (long)(hw + 16 * i) * P.kstride + 4 * l32));
    { const float* vp = P.kbase + 512 + 4 * eg + (long)(kg * per) * P.kstride;
#pragma unroll
        for (int i = 0; i < 16; ++i) if (i < per) vv[i] = __builtin_nontemporal_load((const f32x4*)(vp + (long)i * P.kstride)); }
    if (wid == 0) { const float a = bflo((unsigned)P.q[2 * lane]), b = bflo((unsigned)P.q[2 * lane + 1]);
        const float ss = wave_sum(a * a + b * b), rs = rsqrtf(ss * (1.0f / 128.0f) + EPS) * QSCALE;
        sq[2 * lane] = a * rs * P.gq[2 * lane]; sq[2 * lane + 1] = b * rs * P.gq[2 * lane + 1]; }
    if (wid == 1 && extra) { const float a = bflo((unsigned)P.knew[2 * lane]), b = bflo((unsigned)P.knew[2 * lane + 1]);
        const float ss = wave_sum(a * a + b * b), rs = rsqrtf(ss * (1.0f / 128.0f) + EPS);
        const float ka = a * rs * P.gk[2 * lane], kb = b * rs * P.gk[2 * lane + 1];
        kn[2 * lane] = ka; kn[2 * lane + 1] = kb; P.newout[2 * lane] = ka; P.newout[2 * lane + 1] = kb; }
    if (wid == 2 && extra) { const float a = bflo((unsigned)P.vnew[2 * lane]), b = bflo((unsigned)P.vnew[2 * lane + 1]);
        vn[2 * lane] = a; vn[2 * lane + 1] = b; P.newout[512 + 2 * lane] = a; P.newout[512 + 2 * lane + 1] = b; }
    __syncthreads();
    {
        const f32x4 qv = *(const LAS f32x4*)(sq + 4 * l32);
        float mine = 0.f;
#pragma unroll
        for (int i = 0; i < 16; ++i) if (i < nkh) { float d = (kv[i][0] * qv[0] + kv[i][1] * qv[1]) + (kv[i][2] * qv[2] + kv[i][3] * qv[3]);
            d = row16_sum(d); d += __shfl_xor(d, 16); if (l32 == i) mine = d; }
        if (l32 < nkh) sc[hw + 16 * l32] = mine;
    }
    if (wid == 7 && extra) { const float d = wave_sum(sq[2 * lane] * kn[2 * lane] + sq[2 * lane + 1] * kn[2 * lane + 1]); if (lane == 0) sc[P.nk] = d; }
    __syncthreads();
    const int ntot = P.nk + (extra ? 1 : 0);
    float m = -1e30f, l = 0.f;
    { float sv[5];
#pragma unroll
        for (int i = 0; i < 5; ++i) { const int j = lane + 64 * i; sv[i] = j < ntot ? sc[j] : -1e30f; m = fmaxf(m, sv[i]); }
        m = wave_max(m);
#pragma unroll
        for (int i = 0; i < 5; ++i) l += __builtin_amdgcn_exp2f(sv[i] - m);
        l = wave_sum(l); }
    const float inv = 1.0f / l;
    {
        f32x4 acc = {0.f, 0.f, 0.f, 0.f};
#pragma unroll
        for (int i = 0; i < 16; ++i) if (i < per) acc += vv[i] * (__builtin_amdgcn_exp2f(sc[kg * per + i] - m) * inv);
        if (extra && kg == 0) acc += *(const LAS f32x4*)(vn + 4 * eg) * (__builtin_amdgcn_exp2f(sc[P.nk] - m) * inv);
        *(LAS f32x4*)(red + kg * 128 + 4 * eg) = acc; }
    __syncthreads();
    if (tid < 128) { float v = 0.f;
#pragma unroll
        for (int g = 0; g < 16; ++g) v += red[g * 128 + tid];
        if (P.gate) v *= silu(bflo((unsigned)P.gate[tid]));
        P.o[tid] = (bf16_t)(pk2(v, 0.f) & 0xffffu); }
    if (tid == 0 && P.lse) P.lse[0] = m + log2f(l);
    __syncthreads();
}

__device__ __forceinline__ void mixer_attn(const Ctx& C, int l, int part) {
    const bool isb = l >= 2; const int bl = l - 2;
    const bf16_t* Z = (const bf16_t*)(C.ws + WS_Z); const bf16_t* KVB = (const bf16_t*)(C.ws + WS_KVB); bf16_t* ACT = (bf16_t*)(C.ws + WS_ACT);
    const bf16_t* MEMKV = (const bf16_t*)(C.ws + WS_MEMKV);
    bf16_t* DILO = (bf16_t*)(C.ws + WS_DILO); float* LSE = (float*)(C.ws + WS_LSE);
    const int ldz = NINB, mqoff = 2048, ldact = isb ? KOUTB : KOUTA, acol = isb ? 512 : 1024;
    const bf16_t* ZS = (const bf16_t*)(C.ws + WS_ZS);
    const int n_smem = part == 2 ? 0 : 128, n_sdil = part == 1 ? 384 : 0, n_pdil = part == 1 ? 1536 : 0, n_pmem = part == 1 ? 0 : 256;
    const int ntot = n_smem + n_sdil + n_pdil + n_pmem;
    const int vb = (C.G % 8 == 0) ? (C.bid % 8) * (C.G / 8) + C.bid / 8 : C.bid;
    for (int it = C.bid; it < n_smem + n_sdil; it += C.G) {
        {
            SAttnP P;
            if (it < n_smem) { const int b = it >> 2, h = it & 3; const size_t row = MP + b;
                P.q = isb ? Z + row * ldz + mqoff + h * 128 : ZS + (size_t)b * NINA + 4096 + h * 128; P.gq = C.in[22] + l * 128;
                P.kbase = C.in[2] + ((size_t)(l * NS + b) * MEML) * 1024 + h * 128; P.kstride = 1024; P.nk = 256;
                P.knew = nullptr; P.vnew = nullptr; P.gk = nullptr; P.newout = nullptr;
                P.o = ACT + row * ldact + acol + h * 128; P.gate = P.q + 512; P.lse = nullptr;
            } else { const int idx = it - n_smem, b = idx / 12, g = (idx / 4) % 3, h = idx & 3; const size_t row = MP + b;
                const int W = g == 0 ? 128 : (g == 1 ? 512 : 2048), d = g == 0 ? 1 : (g == 1 ? 4 : 16);
                const float* buf = g == 0 ? C.in[4] : (g == 1 ? C.in[5] : C.in[6]);
                P.q = Z + row * NINB + g * 512 + h * 128; P.gq = C.in[14] + (bl * 3 + g) * 128;
                P.kbase = buf + ((size_t)b * W + (W - d)) * 1024 + h * 128; P.kstride = -(long)d * 1024; P.nk = 128;
                P.knew = KVB + row * 3072 + g * 1024 + h * 128; P.vnew = P.knew + 512; P.gk = C.in[18] + g * 128;
                P.newout = C.out + (g == 0 ? O_DIL0S : (g == 1 ? O_DIL1S : O_DIL2S)) + (size_t)b * 1024 + h * 128;
                P.o = DILO + ((size_t)g * MR + row) * 512 + h * 128; P.gate = nullptr; P.lse = LSE + ((size_t)g * MR + row) * 4 + h; }
            sattn_item(C, P);
        }
    }
    if (part == 1) {
        u32x4 kw[8], vw[8]; bool have = false;
        for (int it = n_smem + n_sdil + vb; it < ntot; it += C.G) {
            AttnP P; const int idx = it - n_smem - n_sdil, combo = idx & 15, h = (idx >> 4) & 3, g = (idx >> 6) % 3, b = idx / 192;
            const int d = g == 0 ? 1 : (g == 1 ? 4 : 16), res = combo % d, n = combo / d, keep = g == 0 ? 128 : (g == 1 ? 512 : 2048);
            P.q = Z + g * 512 + h * 128; P.ldq = NINB; P.qrow0 = b * SEQ + n * 128 * d + res; P.qrstep = d;
            P.k = KVB + g * 1024 + h * 128; P.v = P.k + 512; P.ldk = 3072; P.krow0 = b * SEQ + (n - 1) * 128 * d + res; P.krstep = d;
            P.gq = C.in[14] + (bl * 3 + g) * 128; P.gk = C.in[18] + g * 128; P.mode = n == 0 ? 2 : 1;
            const int t128 = (n * 128) * d + res;
            const bool wr = (bl == 0) && (t128 >= SEQ - keep);
            P.kvout = C.out + (g == 0 ? O_DIL0P : (g == 1 ? O_DIL1P : O_DIL2P)) + ((size_t)b * keep + (wr ? t128 - (SEQ - keep) : 0)) * 1024 + h * 128;
            P.kv_jfrom = wr ? 128 : 256; P.kv_ostride = (size_t)d * 1024;
            P.o = DILO + (size_t)g * MR * 512 + h * 128; P.ldo = 512; P.gate = nullptr; P.lse = LSE + (size_t)g * MR * 4 + h; P.cdil = nullptr; P.clse = nullptr;
            NextKV nx; nx.valid = 0; nx.k = nullptr; nx.ldk = 3072; nx.krow0 = 0; nx.krstep = 0; nx.it0 = 0;
            { const int itn = it + C.G;
                if (itn < ntot) { const int j2 = itn - n_smem - n_sdil; nx.valid = 1;
                    const int combo2 = j2 & 15, h2 = (j2 >> 4) & 3, g2 = (j2 >> 6) % 3, b2 = j2 / 192, d2 = g2 == 0 ? 1 : (g2 == 1 ? 4 : 16), res2 = combo2 % d2, n2 = combo2 / d2;
                    nx.k = KVB + g2 * 1024 + h2 * 128; nx.krow0 = b2 * SEQ + (n2 - 1) * 128 * d2 + res2; nx.krstep = d2; nx.it0 = n2 == 0 ? 4 : 0; } }
            attn_item(C, P, kw, vw, have, nx);
            have = nx.valid != 0;
        }
    } else {
        u32x4 kw[8], vw[8]; bool have = false;
        for (int it = n_smem + n_sdil + vb; it < ntot; it += C.G) {
            AttnP P; const int idx = it - n_smem - n_sdil, b = idx >> 5, h = (idx >> 3) & 3, qblk = idx & 7;
            P.q = Z + mqoff + h * 128; P.ldq = ldz; P.qrow0 = b * SEQ + qblk * 256; P.qrstep = 1;
            P.k = MEMKV + l * 1024 + h * 128; P.v = P.k + 512; P.ldk = 4096; P.krow0 = b * MEML; P.krstep = 1;
            P.gq = C.in[22] + l * 128; P.gk = C.in[21] + l * 128; P.mode = 0;
            P.kvout = C.out + O_MEMKV + ((size_t)(l * NB + b) * MEML) * 1024 + h * 128; P.kv_jfrom = qblk == 0 ? 0 : 256; P.kv_ostride = 1024;
            P.o = ACT + acol + h * 128; P.ldo = ldact; P.gate = Z + mqoff + 512 + h * 128; P.lse = nullptr;
            P.cdil = part == 2 ? DILO + h * 128 : nullptr; P.clse = part == 2 ? LSE + h : nullptr;
            NextKV nx; nx.valid = 0; nx.k = nullptr; nx.ldk = 4096; nx.krow0 = 0; nx.krstep = 1; nx.it0 = 0;
            { const int itn = it + C.G;
                if (itn < ntot) { const int j2 = itn - n_smem - n_sdil, b2 = j2 >> 5, h2 = (j2 >> 3) & 3; nx.valid = 1;
                    nx.k = MEMKV + l * 1024 + h2 * 128; nx.krow0 = b2 * MEML; } }
            attn_item_wide(C, P, kw, vw, have, nx);
            have = nx.valid != 0;
        }
    }
}
__device__ __forceinline__ void mixer_conv(const Ctx& C, int a) {
    const bf16_t* Z = (const bf16_t*)(C.ws + WS_Z); bf16_t* ACT = (bf16_t*)(C.ws + WS_ACT); const bf16_t* ZS = (const bf16_t*)(C.ws + WS_ZS);
    const float* cw = C.in[10] + (size_t)a * 3 * D;
    for (int task = C.bid * 512 + C.tid; task < (MP / 16) * 128 + NS * 128; task += C.G * 512) {
        const bool smp = task >= (MP / 16) * 128;
        const int chunk = task & 127, col = 8 * chunk;
        float w0[8], w1[8], w2[8], u1[8], u2[8];
#pragma unroll
        for (int i = 0; i < 8; ++i) { w0[i] = cw[col + i]; w1[i] = cw[D + col + i]; w2[i] = cw[2 * D + col + i]; u1[i] = 0.f; u2[i] = 0.f; }
        if (smp) { const int b = (task - (MP / 16) * 128) >> 7;
            const float* st = C.in[3] + ((size_t)(a * NS + b) * 2) * D + col;
            float* cs = C.out + O_CONVS + ((size_t)(a * NS + b) * 2) * D + col;
            const bf16_t* zr = ZS + (size_t)b * NINA + (col >> 7) * 256 + (col & 127);
            const u32x4 hw = *(const u32x4*)zr, cw4 = *(const u32x4*)(zr + 128), bw = *(const u32x4*)(zr + 2048), gw = *(const u32x4*)(zr + 2048 + 128);
            float ov[8];
#pragma unroll
            for (int i = 0; i < 8; ++i) { const float hh = (i & 1) ? bfhi(hw[i >> 1]) : bflo(hw[i >> 1]), cc = (i & 1) ? bfhi(cw4[i >> 1]) : bflo(cw4[i >> 1]);
                const float bg = (i & 1) ? bfhi(bw[i >> 1]) : bflo(bw[i >> 1]), gg = (i & 1) ? bfhi(gw[i >> 1]) : bflo(gw[i >> 1]);
                const float s0 = st[i], s1 = st[D + i], u0 = hh * cc;
                ov[i] = silu(gg) * bg * (w0[i] * s0 + w1[i] * s1 + w2[i] * u0); cs[i] = s1; cs[D + i] = u0; }
            u32x4 w; w.x = pk2(ov[0], ov[1]); w.y = pk2(ov[2], ov[3]); w.z = pk2(ov[4], ov[5]); w.w = pk2(ov[6], ov[7]);
            *(u32x4*)(ACT + (size_t)(MP + b) * KOUTA + col) = w;
            continue; }
        const int t0 = (task >> 7) * 16;
        if ((t0 & (SEQ - 1)) != 0) {
            const u32x4 a1 = *(const u32x4*)(Z + (size_t)(t0 - 1) * NINB + col), a2 = *(const u32x4*)(Z + (size_t)(t0 - 2) * NINB + col);
#pragma unroll
            for (int i = 0; i < 4; ++i) { u1[2 * i] = bflo(a1[i]); u1[2 * i + 1] = bfhi(a1[i]); u2[2 * i] = bflo(a2[i]); u2[2 * i + 1] = bfhi(a2[i]); } }
#pragma unroll 4
        for (int rr = 0; rr < 16; ++rr) {
            const int t = t0 + rr; const bf16_t* zr = Z + (size_t)t * NINB + col;
            const u32x4 uw = *(const u32x4*)zr, gw = *(const u32x4*)(zr + 1024);
            float u0[8], ov[8];
#pragma unroll
            for (int i = 0; i < 4; ++i) { u0[2 * i] = bflo(uw[i]); u0[2 * i + 1] = bfhi(uw[i]); }
#pragma unroll
            for (int i = 0; i < 8; ++i) { const float gb = (i & 1) ? bfhi(gw[i >> 1]) : bflo(gw[i >> 1]); ov[i] = gb * (w0[i] * u2[i] + w1[i] * u1[i] + w2[i] * u0[i]); }
            u32x4 w; w.x = pk2(ov[0], ov[1]); w.y = pk2(ov[2], ov[3]); w.z = pk2(ov[4], ov[5]); w.w = pk2(ov[6], ov[7]);
            *(u32x4*)(ACT + (size_t)t * KOUTA + col) = w;
#pragma unroll
            for (int i = 0; i < 8; ++i) { u2[i] = u1[i]; u1[i] = u0[i]; }
        }
    }
}
__device__ __forceinline__ void mixer_b_combine(const Ctx& C, int row_lo) {
    const bf16_t* Z = (const bf16_t*)(C.ws + WS_Z); bf16_t* ACT = (bf16_t*)(C.ws + WS_ACT);
    const bf16_t* DILO = (const bf16_t*)(C.ws + WS_DILO); const float* LSE = (const float*)(C.ws + WS_LSE);
    for (int task = row_lo * 64 + C.bid * 512 + C.tid; task < MR * 64; task += C.G * 512) {
        const int row = task >> 6, chunk = task & 63, h = chunk >> 4;
        const float l0 = LSE[((size_t)0 * MR + row) * 4 + h], l1 = LSE[((size_t)1 * MR + row) * 4 + h], l2 = LSE[((size_t)2 * MR + row) * 4 + h];
        const float m = fmaxf(l0, fmaxf(l1, l2)); float w0 = exp2f(l0 - m), w1 = exp2f(l1 - m), w2 = exp2f(l2 - m); const float inv = 1.0f / (w0 + w1 + w2);
        w0 *= inv; w1 *= inv; w2 *= inv;
        const u32x4 a = *(const u32x4*)(DILO + ((size_t)0 * MR + row) * 512 + 8 * chunk), b = *(const u32x4*)(DILO + ((size_t)1 * MR + row) * 512 + 8 * chunk),
                    c = *(const u32x4*)(DILO + ((size_t)2 * MR + row) * 512 + 8 * chunk), gw = *(const u32x4*)(Z + (size_t)row * NINB + 1536 + 8 * chunk);
        u32x4 w;
#pragma unroll
        for (int i = 0; i < 4; ++i) { const float lo = (bflo(a[i]) * w0 + bflo(b[i]) * w1 + bflo(c[i]) * w2) * silu(bflo(gw[i]));
            const float hi = (bfhi(a[i]) * w0 + bfhi(b[i]) * w1 + bfhi(c[i]) * w2) * silu(bfhi(gw[i])); w[i] = pk2(lo, hi); }
        *(u32x4*)(ACT + (size_t)row * KOUTB + 8 * chunk) = w;
    }
}

struct GsP { const bf16_t* A; const bf16_t* Bt; int M, N; bf16_t* O; int ldc; const float* ss; int split_cols; size_t split_stride; int sample; float* convp; };
__device__ __forceinline__ void gemm_scale(const Ctx& C, const GsP& q) {
    pg8::Gemm g{q.A, q.Bt, q.M, q.N, D}; pg8::StaticOrder S; S.init(q.M, q.N, C.G, C.bid);
    LAS float* rst = (LAS float*)(C.lds + 131072);
    for (int i = C.tid >> 8; i < 8; i += 2) { pg8::Unit u; if (!S.next(i, u)) break; rst[i * 256 + (C.tid & 255)] = rsqrtf(q.ss[u.pm * 256 + (C.tid & 255)] * (1.0f / 1024.0f) + EPS); }
    __syncthreads();
    pg8::EpiScale E{q.O, q.ldc, rst, q.split_cols, q.split_stride, q.convp};
    pg8::gemm_phase<pg8::EpiScale>(C.lds, g, S, E, C.tid);
    if (q.sample)
        for (int tile = C.bid; tile < q.N / 32; tile += C.G)
            sgemm_tile(C, q.A + (size_t)MP * D, D, q.Bt, D, tile, nullptr, [&](int row, int col, float v) -> float {
                bf16_t* base = q.O; int cc = col; if (q.split_cols) { const int t = cc / q.split_cols; base += (size_t)t * q.split_stride; cc -= t * q.split_cols; }
                const float rs = rsqrtf(q.ss[MP + row] * (1.0f / 1024.0f) + EPS); const bf16_t o = (bf16_t)(pk2(v * rs, 0.f) & 0xffffu);
                if (q.convp) ((bf16_t*)(C.ws + WS_ZS))[(size_t)row * NINA + col] = o; else base[(size_t)(MP + row) * q.ldc + cc] = o; return 0.f; });
}
struct GrP { const bf16_t* A; const bf16_t* Bt; int K; bf16_t* xb; float* xout; float* ssn; };
__device__ __forceinline__ void gemm_resid(const Ctx& C, const GrP& q) {
    pg8::Gemm g{q.A, q.Bt, MP, D, q.K}; pg8::StaticOrder S; S.init(MP, D, C.G, C.bid);
    pg8::EpiResid E{q.xb, q.xout, q.ssn};
    pg8::gemm_phase<pg8::EpiResid>(C.lds, g, S, E, C.tid);
    for (int tile = C.bid; tile < D / 32; tile += C.G)
        sgemm_tile(C, q.A + (size_t)MP * q.K, q.K, q.Bt, q.K, tile, q.xout ? nullptr : q.ssn + MP, [&](int row, int col, float v) -> float {
            const size_t off = (size_t)(MP + row) * D + col; const float x = bflo((unsigned)q.xb[off]) + v;
            if (q.xout) q.xout[off] = x; else q.xb[off] = (bf16_t)(pk2(x, 0.f) & 0xffffu); return x * x; });
}

constexpr int N_STEPS = 18;
#ifndef KMASK
#define KMASK 63
#endif

__global__ void __launch_bounds__(512, 2) yoco_fwd(Params p) {
    extern __shared__ __attribute__((aligned(16))) unsigned char lds_raw[];
    Ctx C; C.in = p.in; C.out = p.out; C.ws = p.ws; C.lds = (LAS unsigned char*)lds_raw;
    C.tid = threadIdx.x; C.lane = C.tid & 63; C.wid = __builtin_amdgcn_readfirstlane(C.tid >> 6); C.G = gridDim.x; C.bid = blockIdx.x;
    cg::grid_group grid = cg::this_grid();
    if (C.tid < 2) ((LAS unsigned*)(C.lds + LDS_ST_OFF))[C.tid] = 0u;
    __syncthreads();
    (void)xcd_barrier_post((unsigned*)(p.ws + WS_CTL), (volatile LAS unsigned*)(C.lds + LDS_ST_OFF));
    for (int s = p.ph_lo; s < p.ph_hi; ++s) {
        unsigned char* wsb = p.ws; float* outb = p.out; asm volatile("" : "+s"(wsb), "+s"(outb));
        C.ws = wsb; C.out = outb;
        bf16_t* Wmem = (bf16_t*)(wsb + WS_WMEM); bf16_t* Wina = (bf16_t*)(wsb + WS_WINA); bf16_t* Wouta = (bf16_t*)(wsb + WS_WOUTA);
        bf16_t* Wkvb = (bf16_t*)(wsb + WS_WKVB); bf16_t* Winb1 = (bf16_t*)(wsb + WS_WINB1); bf16_t* Woutb = (bf16_t*)(wsb + WS_WOUTB);
        bf16_t* XB = (bf16_t*)(wsb + WS_XB); bf16_t* MEMN = (bf16_t*)(wsb + WS_MEMN); bf16_t* MEMKV = (bf16_t*)(wsb + WS_MEMKV);
        bf16_t* Z = (bf16_t*)(wsb + WS_Z); bf16_t* KVB = (bf16_t*)(wsb + WS_KVB); bf16_t* ACT = (bf16_t*)(wsb + WS_ACT);
        float* SS = (float*)(wsb + WS_SS); float* X = outb + O_Y;
        bool sync_after = true;
        if (s == 0) { for (int rep = 0; rep < ((RMASK & 1) ? 2 : 1); ++rep) p0_prologue(launder(C)); }
        else if (s == 1 || s == 2 || s == 6 || s == 10 || s == 14) {
            GsP q; q.split_cols = 0; q.split_stride = 0; q.sample = 1; q.convp = nullptr;
            if (s == 1) { q.A = MEMN; q.Bt = Wmem; q.M = 2048; q.N = 4096; q.O = MEMKV; q.ldc = 4096; q.ss = SS + 4 * SS_STRIDE; q.sample = 0; sync_after = false; }
            else if (s == 2) { q.A = XB; q.Bt = Wina; q.M = MP; q.N = NINA; q.O = Z; q.ldc = NINB; q.ss = SS; q.convp = outb + O_CONVP; }
            else if (s == 6) { q.A = XB; q.Bt = Wina + (size_t)NINA * D; q.M = MP; q.N = NINA; q.O = Z; q.ldc = NINB; q.ss = SS + SS_STRIDE; q.convp = outb + O_CONVP + (size_t)NB * 2 * D; }
            else if (s == 10) { q.A = XB; q.Bt = Wkvb; q.M = MP; q.N = NKVB; q.O = KVB; q.ldc = 3072; q.ss = SS + 2 * SS_STRIDE; q.split_cols = 3072; q.split_stride = (size_t)((WS_Z - WS_KVB) / 2); }
            else { q.A = XB; q.Bt = Winb1; q.M = MP; q.N = NINB; q.O = Z; q.ldc = NINB; q.ss = SS + 3 * SS_STRIDE; }
            for (int rep = 0; rep < ((RMASK & 2) ? 2 : 1); ++rep) gemm_scale(launder(C), q);
        } else if (s == 3 || s == 7 || s == 11 || s == 15 || s == 12 || s == 16) { for (int rep = 0; rep < (((RMASK & 4) || ((RMASK & 128) && s < 10) || ((RMASK & 256) && s > 10)) ? 2 : 1); ++rep) mixer_attn(launder(C), s == 3 ? 0 : (s == 7 ? 1 : (s < 14 ? 2 : 3)), s < 10 ? 0 : ((s == 11 || s == 15) ? 1 : 2));
            if (s == 12 || s == 16) mixer_b_combine(launder(C), MP); if (s == 3 || s == 7) sync_after = false; }
        else if (s == 4 || s == 8) { for (int rep = 0; rep < ((RMASK & 8) ? 2 : 1); ++rep) mixer_conv(launder(C), s == 4 ? 0 : 1); }
        else {
            GrP q; q.A = ACT; q.xb = XB; q.xout = nullptr;
            if (s == 5) { q.Bt = Wouta; q.K = KOUTA; q.ssn = SS + SS_STRIDE; }
            else if (s == 9) { q.Bt = Wouta + (size_t)D * KOUTA; q.K = KOUTA; q.ssn = SS + 2 * SS_STRIDE; }
            else if (s == 13) { q.Bt = Woutb; q.K = KOUTB; q.ssn = SS + 3 * SS_STRIDE; }
            else { q.Bt = Woutb + (size_t)D * KOUTB; q.K = KOUTB; q.xout = X; q.ssn = nullptr; }
            gemm_resid(launder(C), q);
        }
        if (sync_after && s + 1 < p.ph_hi) { if (p.ph_hi > 1000) grid.sync(); else { XcdBarrier xb; xb.bar = (unsigned*)(wsb + WS_CTL); xb.x = xb_xcc_id(); xb.st = (volatile LAS unsigned*)(C.lds + LDS_ST_OFF); xcd_barrier(xb); } }
    }
}

extern "C" void kernel_launch(void* const* d_in, const int* in_sizes, int n_in, void* d_out, int out_size, void* d_ws, size_t ws_size, hipStream_t stream) {
    static int grid = 0;
    if (grid == 0) {
        if (n_in != 23 || ws_size < WS_END) { fprintf(stderr, "kernel_launch: unexpected n_in %d or ws_size %zu\n", n_in, ws_size); grid = -1; return; }
        int dev = 0, cus = 0, per_cu = 0;
        hipGetDevice(&dev); hipDeviceGetAttribute(&cus, hipDeviceAttributeMultiprocessorCount, dev);
        if (hipFuncSetAttribute((const void*)yoco_fwd, hipFuncAttributeMaxDynamicSharedMemorySize, LDS_BYTES) != hipSuccess) { fprintf(stderr, "kernel_launch: hipFuncSetAttribute failed\n"); grid = -1; return; }
        if (hipOccupancyMaxActiveBlocksPerMultiprocessor(&per_cu, (const void*)yoco_fwd, 512, LDS_BYTES) != hipSuccess || per_cu < 1) { fprintf(stderr, "kernel_launch: occupancy query failed (%d)\n", per_cu); (void)hipGetLastError(); per_cu = 1; }
        grid = cus * (per_cu > 1 ? 1 : per_cu);
        if (grid > 256) grid = 256;
    }
    if (grid < 0) return;
    if (hipMemsetAsync((char*)d_ws + WS_CTL, 0, CTL_ZERO_BYTES, stream) != hipSuccess) { fprintf(stderr, "kernel_launch: memset of barrier words failed\n"); return; }
    Params p{};
    for (int i = 0; i < 23; ++i) p.in[i] = (const float*)d_in[i];
    p.out = (float*)d_out; p.ws = (unsigned char*)d_ws;
#if N_LAUNCH_MODE == 0
    p.ph_lo = 0; p.ph_hi = N_STEPS;
    void* args[] = {&p};
    hipError_t e = hipLaunchCooperativeKernel((const void*)yoco_fwd, dim3(grid), dim3(512), args, LDS_BYTES, stream);
    if (e != hipSuccess) fprintf(stderr, "cooperative launch failed: %s (grid %d)\n", hipGetErrorString(e), grid);
#else
    static const int cuts[] = {0, 1, 3, 5, 6, 7, 9, 10, 11, 12, 13, 14, 15, 16, 17, 18};
    for (int i = 0; i + 1 < (int)(sizeof(cuts) / sizeof(int)); ++i) { p.ph_lo = cuts[i]; p.ph_hi = cuts[i + 1]; hipLaunchKernelGGL(yoco_fwd, dim3(grid), dim3(512), LDS_BYTES, stream, p); }
#endif
}
```

```cpp
#include <hip/hip_runtime.h>
#include <hip/hip_cooperative_groups.h>
#include <cstdio>
namespace cg = cooperative_groups;

#ifndef N_LAUNCH_MODE
#define N_LAUNCH_MODE 0
#endif

#ifndef RMASK
#define RMASK 0
#endif

#define LAS __attribute__((address_space(3)))
typedef unsigned short bf16_t;
typedef short bf16x8 __attribute__((ext_vector_type(8)));
typedef short s16x4 __attribute__((ext_vector_type(4)));
typedef float f32x4 __attribute__((ext_vector_type(4)));
typedef float f32x16 __attribute__((ext_vector_type(16)));
typedef unsigned u32x4 __attribute__((ext_vector_type(4)));
typedef unsigned u32x2 __attribute__((ext_vector_type(2)));
typedef __bf16 bf16v2 __attribute__((ext_vector_type(2)));

constexpr int D = 1024, NB = 8, SEQ = 2048, MP = NB * SEQ, NS = 32, MR = MP + NS, MEML = 256;
constexpr int NINA = 5120, NKVB = 6144, NINB = 3072, KOUTA = 1536, KOUTB = 1024;
constexpr float EPS = 1e-6f;
constexpr float QSCALE = 0.08838834764831845f * 1.4426950408889634f;

constexpr size_t O_Y = 0, O_MEMKV = 16809984, O_CONVP = 25198592, O_CONVS = 25231360, O_DIL0P = 25362432, O_DIL1P = 26411008,
                 O_DIL2P = 30605312, O_DIL0S = 47382528, O_DIL1S = 47415296, O_DIL2S = 47448064;

constexpr size_t MiB = 1u << 20;
constexpr size_t WS_WMEM = 0, WS_WINA = 8 * MiB, WS_WOUTA = 28 * MiB, WS_WKVB = 34 * MiB, WS_WINB1 = 46 * MiB, WS_WOUTB = 52 * MiB,
                 WS_MEMN = 56 * MiB, WS_MEMKV = 60 * MiB, WS_XB = 76 * MiB, WS_SS = 110 * MiB, WS_Z = 112 * MiB, WS_KVB = 274 * MiB,
                 WS_ACT = 372 * MiB, WS_DILO = 422 * MiB, WS_LSE = 472 * MiB, WS_CTL = 474 * MiB, WS_ZS = 475 * MiB, WS_END = 476 * MiB;
constexpr size_t CTL_ZERO_BYTES = 16384;
constexpr int LDS_ST_OFF = 139264;
constexpr int SS_STRIDE = 16640;

constexpr int LDS_BYTES = 140 * 1024;

__device__ __forceinline__ unsigned pk2(float lo, float hi) { bf16v2 v = {(__bf16)lo, (__bf16)hi}; return __builtin_bit_cast(unsigned, v); }
__device__ __forceinline__ float bflo(unsigned w) { return __builtin_bit_cast(float, w << 16); }
__device__ __forceinline__ float bfhi(unsigned w) { return __builtin_bit_cast(float, w & 0xffff0000u); }
__device__ __forceinline__ float silu(float x) { return x * __builtin_amdgcn_rcpf(1.0f + __builtin_amdgcn_exp2f(x * -1.4426950408889634f)); }
__device__ __forceinline__ float row16_sum(float v) {
    v += __builtin_bit_cast(float, __builtin_amdgcn_mov_dpp(__builtin_bit_cast(int, v), 0xB1, 0xF, 0xF, true));
    v += __builtin_bit_cast(float, __builtin_amdgcn_mov_dpp(__builtin_bit_cast(int, v), 0x4E, 0xF, 0xF, true));
    v += __builtin_bit_cast(float, __builtin_amdgcn_mov_dpp(__builtin_bit_cast(int, v), 0x124, 0xF, 0xF, true));
    v += __builtin_bit_cast(float, __builtin_amdgcn_mov_dpp(__builtin_bit_cast(int, v), 0x128, 0xF, 0xF, true));
    return v;
}
__device__ __forceinline__ float wave_sum(float v) {
#pragma unroll
    for (int o = 1; o < 64; o <<= 1) v += __shfl_xor(v, o);
    return v;
}
__device__ __forceinline__ float wave_max(float v) {
#pragma unroll
    for (int o = 1; o < 64; o <<= 1) v = fmaxf(v, __shfl_xor(v, o));
    return v;
}

namespace pg8 {
constexpr int BM = 256, BK = 64, HALF = 128, HTB = HALF * BK * 2, STAGE_BYTES = 8 * HTB, NXCD = 8, WGM = 4;
__device__ __forceinline__ int lds_byte(int r, int c) { const int st = (r >> 4) * 2 + (c >> 5), rr = r & 15, cc = c & 31, ob = rr * 64 + cc * 2; return st * 1024 + (ob ^ (((ob >> 9) & 1) << 5)); }
__device__ __forceinline__ void stage_rc(int b, int& R, int& C) { const int st = b / 1024, sb = b % 1024, swz = sb ^ (((sb >> 9) & 1) << 5); R = (st >> 1) * 16 + swz / 64; C = (st & 1) * 32 + (swz % 64) / 2; }
__device__ __forceinline__ int perm32(int rho) { const int n = rho >> 4, i = rho & 15; return 8 * (i >> 2) + 4 * n + (i & 3); }
struct Unit { int pm, pn; };
struct Gemm { const bf16_t* A; const bf16_t* Bt; int M, N, K; };
struct StaticOrder {
    int nM, nN, nwg, G, c;
    __device__ void init(int M, int N, int G_, int c_) { nM = M / BM; nN = N / BM; nwg = nM * nN; G = G_; c = c_; }
    __device__ bool next(int i, Unit& u) const {
        const long L = (long)i * G + c; if (L >= nwg) return false;
        int wgid = (int)L; { const int q = nwg / NXCD, r = nwg % NXCD, xcd = wgid % NXCD, off = wgid / NXCD; wgid = (xcd < r ? xcd * (q + 1) : r * (q + 1) + (xcd - r) * q) + off; }
        const int nig = WGM * nN, gid = wgid / nig, fm = gid * WGM, gsz = (nM - fm) < WGM ? (nM - fm) : WGM;
        u.pm = fm + ((wgid % nig) % gsz); u.pn = (wgid % nig) / gsz; return true;
    }
};
struct EpiScale {
    bf16_t* O; int ldc; const LAS float* rst; int split_cols; size_t split_stride;
    float* convp;
    __device__ __forceinline__ void operator()(const f32x4 (&acc)[2][2][4][2], const Unit& u, int wr, int wc, int fr, int fq, int ui) const {
        const int row0 = u.pm * BM + wr * 64 + fr; int colt = u.pn * BM; bf16_t* base = O;
        if (split_cols) { const int t = colt / split_cols; base += (size_t)t * split_stride; colt -= t * split_cols; }
        float rsv[2][4];
        if (convp) { colt = u.pn < 16 ? (u.pn & 7) * 128 + (u.pn >> 3) * 1024 : u.pn * BM - 2048; }
        { const unsigned a = (unsigned)(size_t)(rst + ui * 256 + wr * 64 + fr);
          asm volatile("ds_read_b32 %0, %8\n\tds_read_b32 %1, %8 offset:64\n\tds_read_b32 %2, %8 offset:128\n\tds_read_b32 %3, %8 offset:192\n\t"
                       "ds_read_b32 %4, %8 offset:512\n\tds_read_b32 %5, %8 offset:576\n\tds_read_b32 %6, %8 offset:640\n\tds_read_b32 %7, %8 offset:704\n\ts_waitcnt lgkmcnt(0)"
                       : "=&v"(rsv[0][0]), "=&v"(rsv[0][1]), "=&v"(rsv[0][2]), "=&v"(rsv[0][3]), "=&v"(rsv[1][0]), "=&v"(rsv[1][1]), "=&v"(rsv[1][2]), "=&v"(rsv[1][3]) : "v"(a) : "memory"); }
        const int col0 = colt + wc * 32 + 8 * fq;
        if (convp && u.pn < 16) {
            const bool isu = u.pn < 8;
#pragma unroll
            for (int ai = 0; ai < 2; ++ai)
#pragma unroll
                for (int m = 0; m < 4; ++m) {
                    const int row = row0 + ai * HALF + m * 16; const float rs = rsv[ai][m];
                    f32x4 v0, v1;
                    if (isu) { v0 = acc[ai][0][m][0] * acc[ai][1][m][0] * (rs * rs); v1 = acc[ai][0][m][1] * acc[ai][1][m][1] * (rs * rs); }
                    else {
#pragma unroll
                        for (int j = 0; j < 4; ++j) { v0[j] = acc[ai][0][m][0][j] * rs * silu(acc[ai][1][m][0][j] * rs); v1[j] = acc[ai][0][m][1][j] * rs * silu(acc[ai][1][m][1][j] * rs); } }
                    u32x4 w; w.x = pk2(v0[0], v0[1]); w.y = pk2(v0[2], v0[3]); w.z = pk2(v1[0], v1[1]); w.w = pk2(v1[2], v1[3]);
                    *(u32x4*)(base + (size_t)row * ldc + col0) = w;
                    if (isu && (row & (SEQ - 1)) >= SEQ - 2) { float* cp = convp + ((size_t)(row >> 11) * 2 + ((row & (SEQ - 1)) - (SEQ - 2))) * D + col0; *(f32x4*)cp = v0; *(f32x4*)(cp + 4) = v1; }
                    asm volatile("" ::: "memory"); }
            return;
        }
#pragma unroll
        for (int ai = 0; ai < 2; ++ai)
#pragma unroll
            for (int m = 0; m < 4; ++m) {
                const int row = row0 + ai * HALF + m * 16;
                const float rs = rsv[ai][m];
                bf16_t* rowp = base + (size_t)row * ldc + col0;
#pragma unroll
                for (int bj = 0; bj < 2; ++bj) { const f32x4 v0 = acc[ai][bj][m][0] * rs, v1 = acc[ai][bj][m][1] * rs;
                    u32x4 w; w.x = pk2(v0[0], v0[1]); w.y = pk2(v0[2], v0[3]); w.z = pk2(v1[0], v1[1]); w.w = pk2(v1[2], v1[3]);
                    *(u32x4*)(rowp + bj * HALF) = w; }
                asm volatile("" ::: "memory"); }
    }
};
struct EpiResid {
    bf16_t* xb; float* xout; float* ssn;
    __device__ __forceinline__ void operator()(const f32x4 (&acc)[2][2][4][2], const Unit& u, int wr, int wc, int fr, int fq, int) const {
        const int row0 = u.pm * BM + wr * 64 + fr; const int col0 = u.pn * BM + wc * 32 + 8 * fq;
#pragma unroll
        for (int ai = 0; ai < 2; ++ai)
#pragma unroll
            for (int m = 0; m < 4; ++m) {
                const int row = row0 + ai * HALF + m * 16; float part = 0.f;
#pragma unroll
                for (int bj = 0; bj < 2; ++bj) { const size_t off = (size_t)row * D + col0 + bj * HALF;
                    const u32x4 xw = *(const u32x4*)(xb + off);
                    const f32x4 v0 = acc[ai][bj][m][0] + (f32x4){bflo(xw.x), bfhi(xw.x), bflo(xw.y), bfhi(xw.y)}, v1 = acc[ai][bj][m][1] + (f32x4){bflo(xw.z), bfhi(xw.z), bflo(xw.w), bfhi(xw.w)};
                    if (xout) { *(f32x4*)(xout + off) = v0; *(f32x4*)(xout + off + 4) = v1; }
                    else { u32x4 w; w.x = pk2(v0[0], v0[1]); w.y = pk2(v0[2], v0[3]); w.z = pk2(v1[0], v1[1]); w.w = pk2(v1[2], v1[3]); *(u32x4*)(xb + off) = w;
                        part += (v0[0] * v0[0] + v0[1] * v0[1]) + (v0[2] * v0[2] + v0[3] * v0[3]) + (v1[0] * v1[0] + v1[1] * v1[1]) + (v1[2] * v1[2] + v1[3] * v1[3]); } }
                if (!xout) { part += __shfl_xor(part, 16); part += __shfl_xor(part, 32); if (fq == 0) atomicAdd(ssn + row, part); }
                asm volatile("" ::: "memory"); }
    }
};

template <class Epi>
__device__ __forceinline__ void gemm_phase(LAS unsigned char* lds, const Gemm g, const StaticOrder& S, const Epi& E, const int tid) {
    const int wid = __builtin_amdgcn_readfirstlane(tid >> 6), lane = tid & 63, wr = wid >> 2, wc = wid & 3, fr = lane & 15, fq = lane >> 4;
    const int K = g.K, nt = K / BK;
    unsigned voffA[2], voffB[2];
#pragma unroll
    for (int i = 0; i < 2; ++i) { int R, C; stage_rc(tid * 16 + i * 8192, R, C); const int Rb = (R & ~31) + perm32(R & 31);
        voffA[i] = (unsigned)(R * K + C) * 2u; voffB[i] = (unsigned)(Rb * K + C) * 2u; }
    const size_t kstep = (size_t)(BK * 2);
    const size_t hstep = (size_t)HALF * K * 2;
    const size_t tstep = 2 * hstep;
    const unsigned ldsw = (unsigned)wid * 1024u;
    const int aoff = lds_byte(wr * 64 + fr, fq * 8), boff = lds_byte(wc * 32 + fr, fq * 8);
#define PG8_SA(b, h) (((b) * 2 + (h)) * HTB)
#define PG8_SB(b, h) ((4 + (b) * 2 + (h)) * HTB)
#define PG8_STAGE(bufoff, gbase, voff) do { _Pragma("unroll") for (int _i = 0; _i < 2; ++_i) \
        __builtin_amdgcn_global_load_lds((const unsigned*)((const char*)(gbase) + (voff)[_i]), (LAS unsigned*)(lds + (bufoff) + ldsw + _i * 8192), 16, 0, 0); } while (0)
#define PG8_LDA(dst, b, h) do { _Pragma("unroll") for (int m = 0; m < 4; ++m) _Pragma("unroll") for (int k = 0; k < 2; ++k) dst[m][k] = *(const LAS bf16x8*)(lds + PG8_SA(b, h) + aoff + m * 2048 + k * 1024); } while (0)
#define PG8_LDB(dst, b, h) do { _Pragma("unroll") for (int n = 0; n < 2; ++n) _Pragma("unroll") for (int k = 0; k < 2; ++k) dst[n][k] = *(const LAS bf16x8*)(lds + PG8_SB(b, h) + boff + n * 2048 + k * 1024); } while (0)
#define PG8_MMA(ai, bj, At, Bt) do { __builtin_amdgcn_s_setprio(1); _Pragma("unroll") for (int m = 0; m < 4; ++m) _Pragma("unroll") for (int n = 0; n < 2; ++n) _Pragma("unroll") for (int k = 0; k < 2; ++k) \
        acc[ai][bj][m][n] = __builtin_amdgcn_mfma_f32_16x16x32_bf16(Bt[n][k], At[m][k], acc[ai][bj][m][n], 0, 0, 0); __builtin_amdgcn_s_setprio(0); } while (0)
#define PG8_WAIT_V(n) asm volatile("s_waitcnt vmcnt(" #n ")" ::: "memory")
#define PG8_WAIT_L(n) asm volatile("s_waitcnt lgkmcnt(" #n ")" ::: "memory")
#define PG8_BAR __builtin_amdgcn_s_barrier()
#define PG8_SCHED __builtin_amdgcn_sched_barrier(0)
    Unit cur, nxt; int ui = 0;
    if (!S.next(0, cur)) return;
    f32x4 acc[2][2][4][2];
#pragma unroll
    for (int a = 0; a < 2; ++a)
#pragma unroll
        for (int b = 0; b < 2; ++b)
#pragma unroll
            for (int m = 0; m < 4; ++m)
#pragma unroll
                for (int n = 0; n < 2; ++n) acc[a][b][m][n] = (f32x4){0.f, 0.f, 0.f, 0.f};
    bf16x8 At[4][2], B0[2][2], B1[2][2];
    const char* cA = (const char*)g.A + (size_t)cur.pm * tstep; const char* cB = (const char*)g.Bt + (size_t)cur.pn * tstep;
    PG8_STAGE(PG8_SB(0, 0), cB, voffB); PG8_STAGE(PG8_SA(0, 0), cA, voffA); PG8_STAGE(PG8_SB(0, 1), cB + hstep, voffB); PG8_STAGE(PG8_SA(0, 1), cA + hstep, voffA);
    if (wr == 1) PG8_BAR;
    PG8_WAIT_V(4); PG8_BAR;
    PG8_STAGE(PG8_SB(1, 0), cB + kstep, voffB); PG8_STAGE(PG8_SA(1, 0), cA + kstep, voffA); PG8_STAGE(PG8_SB(1, 1), cB + hstep + kstep, voffB);
    PG8_WAIT_V(6); PG8_BAR;
    for (;;) {
        const bool has_next = S.next(ui + 1, nxt);
        const char* nA = has_next ? (const char*)g.A + (size_t)nxt.pm * tstep : cA; const char* nB = has_next ? (const char*)g.Bt + (size_t)nxt.pn * tstep : cB;
        for (int t = 0; t < nt; t += 2) {
            const bool last = (t == nt - 2);
            const char* a1 = cA + (size_t)(t + 1) * kstep;
            const char* a2 = last ? nA : cA + (size_t)(t + 2) * kstep; const char* b2 = last ? nB : cB + (size_t)(t + 2) * kstep;
            const char* a3 = a2 + kstep; const char* b3 = b2 + kstep;
            PG8_LDB(B0, 0, 0); PG8_SCHED; PG8_LDA(At, 0, 0); PG8_STAGE(PG8_SA(1, 1), a1 + hstep, voffA);
            PG8_WAIT_L(8); PG8_BAR; PG8_WAIT_L(0); PG8_MMA(0, 0, At, B0); PG8_BAR; PG8_SCHED;
            PG8_LDB(B1, 0, 1); PG8_STAGE(PG8_SB(0, 0), b2, voffB);
            PG8_BAR; PG8_WAIT_L(0); PG8_MMA(0, 1, At, B1); PG8_BAR;
            PG8_LDA(At, 0, 1); PG8_STAGE(PG8_SA(0, 0), a2, voffA);
            PG8_BAR; PG8_WAIT_L(0); PG8_MMA(1, 0, At, B0); PG8_BAR; PG8_SCHED;
            PG8_STAGE(PG8_SB(0, 1), b2 + hstep, voffB);
            PG8_WAIT_V(6); PG8_BAR; PG8_MMA(1, 1, At, B1); PG8_BAR;
            PG8_LDB(B0, 1, 0); PG8_SCHED; PG8_LDA(At, 1, 0); PG8_STAGE(PG8_SA(0, 1), a2 + hstep, voffA);
            PG8_WAIT_L(8); PG8_BAR; PG8_WAIT_L(0); PG8_MMA(0, 0, At, B0); PG8_BAR; PG8_SCHED;
            PG8_LDB(B1, 1, 1); PG8_STAGE(PG8_SB(1, 0), b3, voffB);
            PG8_BAR; PG8_WAIT_L(0); PG8_MMA(0, 1, At, B1); PG8_BAR;
            PG8_LDA(At, 1, 1); PG8_STAGE(PG8_SA(1, 0), a3, voffA);
            PG8_BAR; PG8_WAIT_L(0); PG8_MMA(1, 0, At, B0); PG8_BAR; PG8_SCHED;
            PG8_STAGE(PG8_SB(1, 1), b3 + hstep, voffB);
            PG8_WAIT_V(6); PG8_BAR; PG8_MMA(1, 1, At, B1); PG8_BAR;
        }
        E(acc, cur, wr, wc, fr, fq, ui);
        if (!has_next) break;
#pragma unroll
        for (int a = 0; a < 2; ++a)
#pragma unroll
            for (int b = 0; b < 2; ++b)
#pragma unroll
                for (int m = 0; m < 4; ++m)
#pragma unroll
                    for (int n = 0; n < 2; ++n) acc[a][b][m][n] = (f32x4){0.f, 0.f, 0.f, 0.f};
        cur = nxt; cA = nA; cB = nB; ++ui;
    }
    PG8_WAIT_V(0);
    if (wr == 0) PG8_BAR;
    PG8_BAR;
#undef PG8_SA
#undef PG8_SB
#undef PG8_STAGE
#undef PG8_LDA
#undef PG8_LDB
#undef PG8_MMA
#undef PG8_WAIT_V
#undef PG8_WAIT_L
#undef PG8_BAR
#undef PG8_SCHED
}
}

#define XB_TMO      128
#define XB_XCNT(j)  (256  + 64 * (j))
#define XB_XSUB(j)  (1280 + 64 * (j))
#define XB_XGEN(j)  (2304 + 64 * (j))
#define XB_TOP      3328
#define XB_TOPGEN   3392
#define XCD_BAR_WORDS 3456
#define XB_SPIN_CAP (1u << 18)

__device__ __forceinline__ unsigned xb_ld(unsigned* p)              { return __hip_atomic_load(p, __ATOMIC_RELAXED, __HIP_MEMORY_SCOPE_AGENT); }
__device__ __forceinline__ unsigned xb_add(unsigned* p, unsigned v) { return __hip_atomic_fetch_add(p, v, __ATOMIC_RELAXED, __HIP_MEMORY_SCOPE_AGENT); }
__device__ __forceinline__ unsigned xb_xcc_id() { return (unsigned)__builtin_amdgcn_s_getreg((3 << 11) | 20) & 0xFu; }
#define XB_SPIN(cond, bar) do { unsigned _sp = 0; while (cond) { __builtin_amdgcn_s_sleep(1); \
    if ((++_sp & 255u) == 0u) { if (xb_ld(&(bar)[XB_TMO])) break; if (_sp > XB_SPIN_CAP) { atomicAdd(&(bar)[XB_TMO], 1u); break; } } } } while (0)

struct XcdBarrier {
    unsigned* bar; unsigned x;
    volatile LAS unsigned* st;
};

__device__ __forceinline__ XcdBarrier xcd_barrier_post(unsigned* bar, volatile LAS unsigned* st) {
    XcdBarrier b; b.bar = bar; b.x = xb_xcc_id(); b.st = st;
    if (threadIdx.x == 0) (void)xb_add(&bar[XB_XCNT(b.x)], 1u);
    return b;
}
__device__ __forceinline__ void xcd_barrier_complete(unsigned* bar, unsigned x, unsigned& nloc, unsigned& nx) {
    const unsigned G = gridDim.x * gridDim.y * gridDim.z;
    unsigned sum, cnt, mine, sp = 0u;
    for (;;) {
        sum = 0u; cnt = 0u; mine = 0u;
#pragma unroll
        for (unsigned j = 0; j < 16; ++j) { const unsigned c = xb_ld(&bar[XB_XCNT(j)]); sum += c; cnt += (c > 0u) ? 1u : 0u; mine = (j == x) ? c : mine; }
        if (sum == G) break;
        __builtin_amdgcn_s_sleep(1);
        if ((++sp & 255u) == 0u) { if (xb_ld(&bar[XB_TMO])) break; if (sp > XB_SPIN_CAP) { atomicAdd(&bar[XB_TMO], 1u); break; } }
    }
    nloc = mine > 0u ? mine : 1u; nx = cnt > 0u ? cnt : 1u;
}

__device__ __forceinline__ void xcd_barrier(const XcdBarrier& b) {
    asm volatile("s_waitcnt vmcnt(0)" ::: "memory");
    __syncthreads();
    if (threadIdx.x == 0) {
        unsigned* bar = b.bar;
        __builtin_amdgcn_s_waitcnt(0);
        unsigned nloc = b.st[0], nx = b.st[1];
        if (nloc == 0u) { xcd_barrier_complete(bar, b.x, nloc, nx); b.st[0] = nloc; b.st[1] = nx; }
        const unsigned old = xb_add(&bar[XB_XSUB(b.x)], 1u);
        const unsigned gen = old / nloc;
        if (old + 1u == (gen + 1u) * nloc) {
            __builtin_amdgcn_fence(__ATOMIC_RELEASE, "agent");
            asm volatile("s_waitcnt vmcnt(0)" ::: "memory");
            const unsigned og = xb_add(&bar[XB_TOP], 1u);
            const unsigned tg = og / nx;
            if (og + 1u == (tg + 1u) * nx) xb_add(&bar[XB_TOPGEN], 1u);
            else XB_SPIN(xb_ld(&bar[XB_TOPGEN]) == tg, bar);
            __builtin_amdgcn_fence(__ATOMIC_ACQUIRE, "agent");
            xb_add(&bar[XB_XGEN(b.x)], 1u);
            asm volatile("s_waitcnt vmcnt(0)" ::: "memory");
        } else {
            XB_SPIN(xb_ld(&bar[XB_XGEN(b.x)]) == gen, bar);
            __builtin_amdgcn_fence(__ATOMIC_ACQUIRE, "agent");
            asm volatile("s_waitcnt vmcnt(0)" ::: "memory");
        }
    }
    __syncthreads();
}

struct Params {
    const float* in[23];
    float* out;
    unsigned char* ws;
    int ph_lo, ph_hi;
};

struct Ctx {
    const float* const* in; float* out; unsigned char* ws; LAS unsigned char* lds;
    int tid, lane, wid, G, bid;
};
__device__ __forceinline__ int fresh_tid(int wid) { unsigned z = 0u; asm volatile("" : "+v"(z)); return wid * 64 + (int)__builtin_amdgcn_mbcnt_hi(~0u, __builtin_amdgcn_mbcnt_lo(~0u, z)); }
__device__ __forceinline__ Ctx launder(const Ctx& C0) { Ctx C = C0;
    int w = C0.wid, g = C0.G, b = C0.bid; asm volatile("" : "+s"(w), "+s"(g), "+s"(b));
    unsigned z = 0u; asm volatile("" : "+v"(z));
    int t = w * 64 + (int)__builtin_amdgcn_mbcnt_hi(~0u, __builtin_amdgcn_mbcnt_lo(~0u, z));
    asm volatile("" : "+v"(t)); C.tid = t; C.lane = t & 63; C.wid = w; C.G = g; C.bid = b; return C; }

__device__ __forceinline__ int perm_a(int n) { if (n >= 4096) return n; const int part = n >> 10, j = n & 1023; return (part >> 1) * 2048 + (j >> 7) * 256 + (part & 1) * 128 + (j & 127); }
__device__ __forceinline__ void p0_transpose_item(const float* W, int K, int N, bf16_t* WT, int row_off, const float* gain, LAS float* scr, int item, int lane, bool pa = false) {
    const int nblk = N / 32, kb = item / nblk, nb = item % nblk, k0 = 64 * kb, n0 = 32 * nb;
    if (pa) row_off = perm_a(n0) - n0;
    float wv[32];
#pragma unroll
    for (int i = 0; i < 32; ++i) wv[i] = __builtin_nontemporal_load(W + (size_t)(k0 + 2 * i + (lane >> 5)) * N + n0 + (lane & 31));
    const float gl = gain ? gain[k0 + lane] : 1.0f;
#pragma unroll
    for (int i = 0; i < 32; ++i) { const int kk = 2 * i + (lane >> 5); const float gv = __shfl(gl, kk); scr[kk * 33 + (lane & 31)] = wv[i] * gv; }
    asm volatile("s_waitcnt lgkmcnt(0)" ::: "memory");
    const int c = lane & 7;
#pragma unroll
    for (int j = 0; j < 4; ++j) { const int n = (lane >> 3) + 8 * j; const LAS float* s = scr + (8 * c) * 33 + n;
        u32x4 o; o.x = pk2(s[0 * 33], s[1 * 33]); o.y = pk2(s[2 * 33], s[3 * 33]); o.z = pk2(s[4 * 33], s[5 * 33]); o.w = pk2(s[6 * 33], s[7 * 33]);
        *(u32x4*)(WT + (size_t)(row_off + n0 + n) * K + k0 + 8 * c) = o; }
    asm volatile("s_waitcnt lgkmcnt(0)" ::: "memory");
}
__device__ __forceinline__ void row_cvt_ss(const float* xrow, bf16_t* orow, float* ssp, int lane) {
    const f32x4* xr = (const f32x4*)xrow + lane; f32x4 v[4]; float s = 0.f;
#pragma unroll
    for (int j = 0; j < 4; ++j) { v[j] = xr[64 * j]; s += (v[j].x * v[j].x + v[j].y * v[j].y) + (v[j].z * v[j].z + v[j].w * v[j].w); }
    s = wave_sum(s);
    u32x2* o8 = (u32x2*)orow + lane;
#pragma unroll
    for (int j = 0; j < 4; ++j) { u32x2 w; w.x = pk2(v[j].x, v[j].y); w.y = pk2(v[j].z, v[j].w); o8[64 * j] = w; }
    if (lane == 0) *ssp = s;
}
__device__ __forceinline__ void p0_prologue(const Ctx& C) {
    LAS float* scr = (LAS float*)(C.lds + C.wid * 16384);
    const int gw = C.bid * 8 + C.wid, NGW = C.G * 8;
    bf16_t* Wmem = (bf16_t*)(C.ws + WS_WMEM); bf16_t* Wina = (bf16_t*)(C.ws + WS_WINA); bf16_t* Wouta = (bf16_t*)(C.ws + WS_WOUTA);
    bf16_t* Wkvb = (bf16_t*)(C.ws + WS_WKVB); bf16_t* Winb1 = (bf16_t*)(C.ws + WS_WINB1); bf16_t* Woutb = (bf16_t*)(C.ws + WS_WOUTB);
    constexpr int I_MEM = 16 * 32, I_INA = 16 * 160, I_OUTA = 24 * 32, I_KV = 16 * 96, I_INB = 16 * 96, I_OUTB = 16 * 32;
    constexpr int NITEMS = 4 * I_MEM + 2 * I_INA + 2 * I_OUTA + I_KV + 2 * I_INB + 2 * I_OUTB;
    for (int it = gw; it < NITEMS; it += NGW) {
        int r = it;
        if (r < 4 * I_MEM) { const int l = r / I_MEM; p0_transpose_item(C.in[20] + (size_t)l * D * 1024, D, 1024, Wmem, l * 1024, C.in[19] + l * D, scr, r % I_MEM, C.lane); continue; } r -= 4 * I_MEM;
        if (r < 2 * I_INA) { const int a = r / I_INA; p0_transpose_item(C.in[9] + (size_t)a * D * NINA, D, NINA, Wina + (size_t)a * NINA * D, 0, C.in[8] + a * D, scr, r % I_INA, C.lane, true); continue; } r -= 2 * I_INA;
        if (r < 2 * I_OUTA) { const int a = r / I_OUTA; p0_transpose_item(C.in[11] + (size_t)a * KOUTA * D, KOUTA, D, Wouta + (size_t)a * D * KOUTA, 0, nullptr, scr, r % I_OUTA, C.lane); continue; } r -= 2 * I_OUTA;
        if (r < I_KV) { p0_transpose_item(C.in[17], D, 3072, Wkvb, 0, C.in[16], scr, r, C.lane); continue; } r -= I_KV;
        if (r < 2 * I_INB) { const int bl = r / I_INB; p0_transpose_item(C.in[13] + (size_t)bl * D * NINB, D, NINB, bl ? Winb1 : Wkvb, bl ? 0 : 3072, C.in[12] + bl * D, scr, r % I_INB, C.lane); continue; } r -= 2 * I_INB;
        { const int bl = r / I_OUTB; p0_transpose_item(C.in[15] + (size_t)bl * KOUTB * D, KOUTB, D, Woutb + (size_t)bl * D * KOUTB, 0, nullptr, scr, r % I_OUTB, C.lane); }
    }
    bf16_t* XB = (bf16_t*)(C.ws + WS_XB); bf16_t* MEMN = (bf16_t*)(C.ws + WS_MEMN); float* SS = (float*)(C.ws + WS_SS);
    for (int m = 2 * gw; m < MR + 2048; m += 2 * NGW) {
        const float* src; bf16_t* dst; float* ssp;
        if (m < MP) { src = C.in[0] + (size_t)m * D; dst = XB + (size_t)m * D; ssp = SS + m; }
        else if (m < MR) { src = C.in[1] + (size_t)(m - MP) * D; dst = XB + (size_t)m * D; ssp = SS + m; }
        else { src = C.in[7] + (size_t)(m - MR) * D; dst = MEMN + (size_t)(m - MR) * D; ssp = SS + 4 * SS_STRIDE + (m - MR); }
        const f32x4* xr = (const f32x4*)src + C.lane; f32x4 v[8]; float s0 = 0.f, s1 = 0.f;
#pragma unroll
        for (int j = 0; j < 8; ++j) v[j] = __builtin_nontemporal_load(xr + 64 * j);
#pragma unroll
        for (int j = 0; j < 4; ++j) { s0 += (v[j].x * v[j].x + v[j].y * v[j].y) + (v[j].z * v[j].z + v[j].w * v[j].w); s1 += (v[4 + j].x * v[4 + j].x + v[4 + j].y * v[4 + j].y) + (v[4 + j].z * v[4 + j].z + v[4 + j].w * v[4 + j].w); }
        s0 = wave_sum(s0); s1 = wave_sum(s1);
        u32x2* o8 = (u32x2*)dst + C.lane;
#pragma unroll
        for (int j = 0; j < 8; ++j) { u32x2 w; w.x = pk2(v[j].x, v[j].y); w.y = pk2(v[j].z, v[j].w); o8[64 * j] = w; }
        if (C.lane == 0) { ssp[0] = s0; ssp[1] = s1; }
    }
    for (int i = C.bid * 512 + C.tid; i < 3 * SS_STRIDE; i += C.G * 512) SS[SS_STRIDE + i] = 0.f;
}

template <class F>
__device__ __forceinline__ void sgemm_tile(const Ctx& C, const bf16_t* A, int lda, const bf16_t* Bt, int K, int tile, float* ssrow, F epi) {
    LAS float* red = (LAS float*)C.lds;
    int lane = C.lane; asm volatile("" : "+v"(lane));
    const int r = lane & 31, h = lane >> 5, kc = K / 8, k0 = C.wid * kc, nst = kc / 16;
    f32x16 acc; for (int i = 0; i < 16; ++i) acc[i] = 0.f;
    const bf16_t* ap = A + (size_t)r * lda + k0 + 8 * h;
    const bf16_t* bp = Bt + (size_t)(tile * 32 + r) * K + k0 + 8 * h;
    bf16x8 av[12], bv[12];
#pragma unroll
    for (int s = 0; s < 12; ++s) if (s < nst) { av[s] = *(const bf16x8*)(ap + 16 * s); bv[s] = *(const bf16x8*)(bp + 16 * s); }
#pragma unroll
    for (int s = 0; s < 12; ++s) if (s < nst) acc = __builtin_amdgcn_mfma_f32_32x32x16_bf16(av[s], bv[s], acc, 0, 0, 0);
#pragma unroll
    for (int i = 0; i < 16; ++i) { const int row = (i & 3) + 8 * (i >> 2) + 4 * h; red[(C.wid * 32 + row) * 32 + r] = acc[i]; }
    __syncthreads();
#pragma unroll
    for (int rep = 0; rep < 2; ++rep) { const int idx = C.tid + 512 * rep; float v = 0.f;
#pragma unroll
        for (int w = 0; w < 8; ++w) v += red[w * 1024 + idx];
        float sq = epi(idx >> 5, tile * 32 + (idx & 31), v);
        if (ssrow) { sq += __shfl_xor(sq, 16); sq += __shfl_xor(sq, 8); sq += __shfl_xor(sq, 4); sq += __shfl_xor(sq, 2); sq += __shfl_xor(sq, 1);
            if ((lane & 31) == 0) atomicAdd(ssrow + (idx >> 5), sq); } }
    __syncthreads();
}

__device__ __forceinline__ unsigned off_b(unsigned row, unsigned ch) { return 256u * row + 16u * (ch ^ (((row & 3) << 2) | ((row >> 2) & 3))); }
struct AttnP {
    const bf16_t* q; int ldq, qrow0, qrstep;
    const bf16_t* k; const bf16_t* v; int ldk, krow0, krstep;
    const float* gq; const float* gk;
    int mode;
    float* kvout; int kv_jfrom; size_t kv_ostride;
    bf16_t* o; int ldo;
    const bf16_t* gate;
    float* lse;
    const bf16_t* cdil; const float* clse;
};
struct NextKV { const bf16_t* k; int ldk, krow0, krstep, it0, valid; };
__device__ __forceinline__ void attn_item(const Ctx& C, const AttnP& P, u32x4 (&kw)[8], u32x4 (&vw)[8], const bool have, const NextKV& nx) {
    const int tid = fresh_tid(C.wid);
    const int lane = tid & 63, wid = C.wid, r = lane & 31, h = lane >> 5, qb = wid & 3, kh = wid >> 2;
    LAS unsigned char* Kl = C.lds; LAS unsigned char* Vl = C.lds + 65536;
    bf16x8 qf[8];
    const int qrow = P.qrow0 + (32 * qb + r) * P.qrstep;
    {
        const int c = tid & 15, kr = tid >> 4, it0 = (P.mode == 2 ? 4 : 0);
        const bf16_t* qp = P.q + (size_t)qrow * P.ldq + 8 * h;
        u32x4 raw[8];
#pragma unroll
        for (int s = 0; s < 8; ++s) raw[s] = *(const u32x4*)(qp + 16 * s);
        if (!have) {
#pragma unroll
            for (int it = 0; it < 8; ++it) if (it >= it0) { const size_t row = (size_t)(P.krow0 + (kr + 32 * it) * P.krstep);
                kw[it] = *(const u32x4*)(P.k + row * P.ldk + 8 * c); vw[it] = *(const u32x4*)(P.v + row * P.ldk + 8 * c); } }
        float ss = 0.f;
#pragma unroll
        for (int s = 0; s < 8; ++s)
#pragma unroll
            for (int j = 0; j < 4; ++j) { const float a = bflo(raw[s][j]), b = bfhi(raw[s][j]); ss += a * a + b * b; }
        ss += __shfl_xor(ss, 32);
        const float rs = rsqrtf(ss * (1.0f / 128.0f) + EPS) * QSCALE;
#pragma unroll
        for (int s = 0; s < 8; ++s) {
            u32x4 w; w.x = pk2(bflo(raw[s][0]) * rs, bfhi(raw[s][0]) * rs); w.y = pk2(bflo(raw[s][1]) * rs, bfhi(raw[s][1]) * rs);
            w.z = pk2(bflo(raw[s][2]) * rs, bfhi(raw[s][2]) * rs); w.w = pk2(bflo(raw[s][3]) * rs, bfhi(raw[s][3]) * rs);
            qf[s] = __builtin_bit_cast(bf16x8, w); }
        const f32x4 gk0 = *(const f32x4*)(P.gk + 8 * c), gk1 = *(const f32x4*)(P.gk + 8 * c + 4);
        const f32x4 gq0 = *(const f32x4*)(P.gq + 8 * c), gq1 = *(const f32x4*)(P.gq + 8 * c + 4);
#pragma unroll
        for (int it = 0; it < 8; ++it) if (it >= it0) {
            const int j = kr + 32 * it;
            f32x4 k0 = {bflo(kw[it].x), bfhi(kw[it].x), bflo(kw[it].y), bfhi(kw[it].y)}, k1 = {bflo(kw[it].z), bfhi(kw[it].z), bflo(kw[it].w), bfhi(kw[it].w)};
            float s2 = (k0[0] * k0[0] + k0[1] * k0[1]) + (k0[2] * k0[2] + k0[3] * k0[3]) + (k1[0] * k1[0] + k1[1] * k1[1]) + (k1[2] * k1[2] + k1[3] * k1[3]);
            s2 = row16_sum(s2);
            const float rk = rsqrtf(s2 * (1.0f / 128.0f) + EPS);
            k0 = k0 * rk * gk0; k1 = k1 * rk * gk1;
            const f32x4 kq0 = k0 * gq0, kq1 = k1 * gq1;
            u32x4 w; w.x = pk2(kq0[0], kq0[1]); w.y = pk2(kq0[2], kq0[3]); w.z = pk2(kq1[0], kq1[1]); w.w = pk2(kq1[2], kq1[3]);
            *(LAS u32x4*)(Kl + off_b(j, c)) = w; *(LAS u32x4*)(Vl + off_b(j, c)) = vw[it];
            if (j >= P.kv_jfrom) { float* o = P.kvout + (size_t)(j - P.kv_jfrom) * P.kv_ostride + 8 * c;
                *(f32x4*)o = k0; *(f32x4*)(o + 4) = k1;
                *(f32x4*)(o + 512) = (f32x4){bflo(vw[it].x), bfhi(vw[it].x), bflo(vw[it].y), bfhi(vw[it].y)}; *(f32x4*)(o + 516) = (f32x4){bflo(vw[it].z), bfhi(vw[it].z), bflo(vw[it].w), bfhi(vw[it].w)}; }
        }
    }
    __syncthreads();
    f32x16 o[4]; float mrow = -1e30f, lrow = 0.f;
    const bool active = !(P.mode == 2 && kh == 0);
    u32x4 pb[4][2];
    if (active) {
        {
            f32x16 sacc[4];
            const unsigned xr = ((r & 3) << 2) | ((r >> 2) & 3);
            unsigned kaddr[8];
#pragma unroll
            for (int s = 0; s < 8; ++s) kaddr[s] = 256u * (128 * kh + r) + 16u * ((unsigned)(2 * s + h) ^ xr);
#pragma unroll
            for (int kt = 0; kt < 4; ++kt) { for (int i = 0; i < 16; ++i) sacc[kt][i] = -1e30f;
                if (P.mode == 0 || (kh ? kt <= qb : kt >= qb)) {
                    for (int i = 0; i < 16; ++i) sacc[kt][i] = 0.f;
#pragma unroll
                    for (int s = 0; s < 8; ++s) { const bf16x8 a = *(const LAS bf16x8*)(Kl + kaddr[s] + 8192 * kt); sacc[kt] = __builtin_amdgcn_mfma_f32_32x32x16_bf16(a, qf[s], sacc[kt], 0, 0, 0); } }
                asm volatile("" ::: "memory"); }
            const int qi = 32 * qb + r;
            if (P.mode != 0) {
#pragma unroll
                for (int kt = 0; kt < 4; ++kt)
#pragma unroll
                    for (int i = 0; i < 16; ++i) { const int kj = 32 * kt + (i & 3) + 8 * (i >> 2) + 4 * h; const bool valid = kh ? (kj <= qi) : (kj >= qi); sacc[kt][i] = valid ? sacc[kt][i] : -1e30f; }
            }
            float m = -1e30f;
#pragma unroll
            for (int kt = 0; kt < 4; ++kt)
#pragma unroll
                for (int i = 0; i < 16; ++i) m = fmaxf(m, sacc[kt][i]);
            m = fmaxf(m, __shfl_xor(m, 32));
            float l = 0.f;
#pragma unroll
            for (int kt = 0; kt < 4; ++kt)
#pragma unroll
                for (int s2 = 0; s2 < 2; ++s2) {
                    float pv[8];
#pragma unroll
                    for (int j = 0; j < 8; ++j) { pv[j] = __builtin_amdgcn_exp2f(sacc[kt][8 * s2 + j] - m); l += pv[j]; }
                    pb[kt][s2].x = pk2(pv[0], pv[1]); pb[kt][s2].y = pk2(pv[2], pv[3]); pb[kt][s2].z = pk2(pv[4], pv[5]); pb[kt][s2].w = pk2(pv[6], pv[7]);
                }
            l += __shfl_xor(l, 32);
            mrow = m; lrow = l;
        }
    }
    if (nx.valid) {
        const int c = tid & 15, kr = tid >> 4;
#pragma unroll
        for (int it = 0; it < 8; ++it) if (it >= nx.it0) { const size_t row = (size_t)(nx.krow0 + (kr + 32 * it) * nx.krstep);
            kw[it] = *(const u32x4*)(nx.k + row * nx.ldk + 8 * c); vw[it] = *(const u32x4*)(nx.k + 512 + row * nx.ldk + 8 * c); }
    }
#pragma unroll
    for (int et = 0; et < 4; ++et) for (int i = 0; i < 16; ++i) o[et][i] = 0.f;
    if (active) {
        const int q4 = (lane & 15) >> 2, p4 = lane & 3, blk = (lane >> 4) & 1, clow = 2 * blk + (p4 >> 1);
        unsigned vaddr[4][2];
#pragma unroll
        for (int et = 0; et < 4; ++et)
#pragma unroll
            for (int hi = 0; hi < 2; ++hi) vaddr[et][hi] = 256u * (128 * kh + 4 * h + q4 + 8 * hi) + 64u * (unsigned)(et ^ q4) + 16u * (unsigned)(clow ^ (h + 2 * hi)) + 8u * (p4 & 1);
#pragma unroll
        for (int kt = 0; kt < 4; ++kt)
#pragma unroll
            for (int s2 = 0; s2 < 2; ++s2) if (P.mode == 0 || (kh ? kt <= qb : kt >= qb)) {
                const bf16x8 pbv = __builtin_bit_cast(bf16x8, pb[kt][s2]);
#pragma unroll
                for (int et = 0; et < 4; ++et) {
                    const s16x4 lo = __builtin_amdgcn_ds_read_tr16_b64_v4i16((LAS s16x4*)(Vl + vaddr[et][0] + 8192 * kt + 4096 * s2));
                    const s16x4 hi = __builtin_amdgcn_ds_read_tr16_b64_v4i16((LAS s16x4*)(Vl + vaddr[et][1] + 8192 * kt + 4096 * s2));
                    const bf16x8 va = __builtin_shufflevector(lo, hi, 0, 1, 2, 3, 4, 5, 6, 7);
                    o[et] = __builtin_amdgcn_mfma_f32_32x32x16_bf16(va, pbv, o[et], 0, 0, 0);
                }
                asm volatile("" ::: "memory");
            }
    }
    __syncthreads();
    LAS float* Mo = (LAS float*)C.lds;
    LAS float* Mml = (LAS float*)(C.lds + 65536);
    if (kh == 1) {
#pragma unroll
        for (int et = 0; et < 4; ++et)
#pragma unroll
            for (int i = 0; i < 16; ++i) { const int e = 32 * et + (i & 3) + 8 * (i >> 2) + 4 * h; Mo[(qb * 128 + e) * 32 + r] = o[et][i]; }
        if (h == 0) { Mml[(qb * 2 + 0) * 32 + r] = mrow; Mml[(qb * 2 + 1) * 32 + r] = lrow; }
    }
    __syncthreads();
    LAS unsigned char* Ot = C.lds + 65536 + 2048;
    if (kh == 0) {
        const float m1 = Mml[(qb * 2 + 0) * 32 + r], l1 = Mml[(qb * 2 + 1) * 32 + r];
        const float m = fmaxf(mrow, m1), w0 = __builtin_amdgcn_exp2f(mrow - m), w1 = __builtin_amdgcn_exp2f(m1 - m), l = lrow * w0 + l1 * w1, inv = 1.0f / l;
        const float a0 = w0 * inv, a1 = w1 * inv;
#pragma unroll
        for (int et = 0; et < 4; ++et)
#pragma unroll
            for (int g4 = 0; g4 < 4; ++g4) {
                const int e0 = 32 * et + 8 * g4 + 4 * h;
                float v[4];
#pragma unroll
                for (int j = 0; j < 4; ++j) v[j] = o[et][4 * g4 + j] * a0 + Mo[(qb * 128 + e0 + j) * 32 + r] * a1;
                u32x2 w; w.x = pk2(v[0], v[1]); w.y = pk2(v[2], v[3]);
                *(LAS u32x2*)(Ot + (32 * qb + r) * 272 + 2 * e0) = w;
            }
        if (P.mode != 0 && h == 0) P.lse[(size_t)qrow * 4] = m + log2f(l);
    }
    __syncthreads();
#pragma unroll
    for (int i = 0; i < 4; ++i) { const int id = tid + 512 * i, qi = id >> 4, c = id & 15; const size_t grow = (size_t)(P.qrow0 + qi * P.qrstep);
        u32x4 w = *(const LAS u32x4*)(Ot + qi * 272 + 16 * c);
        if (P.mode == 0) { const u32x4 gw = *(const u32x4*)(P.gate + grow * P.ldq + 8 * c);
#pragma unroll
            for (int j = 0; j < 4; ++j) w[j] = pk2(bflo(w[j]) * silu(bflo(gw[j])), bfhi(w[j]) * silu(bfhi(gw[j]))); }
        *(u32x4*)(P.o + grow * P.ldo + 8 * c) = w;
        if (P.cdil) {
            const float l0 = P.clse[grow * 4], l1 = P.clse[((size_t)MR + grow) * 4], l2 = P.clse[((size_t)2 * MR + grow) * 4];
            const float mm = fmaxf(l0, fmaxf(l1, l2)); float w0 = __builtin_amdgcn_exp2f(l0 - mm), w1 = __builtin_amdgcn_exp2f(l1 - mm), w2 = __builtin_amdgcn_exp2f(l2 - mm); const float inv = 1.0f / (w0 + w1 + w2);
            w0 *= inv; w1 *= inv; w2 *= inv;
            const u32x4 a = *(const u32x4*)(P.cdil + grow * 512 + 8 * c), b = *(const u32x4*)(P.cdil + ((size_t)MR + grow) * 512 + 8 * c),
                        cc = *(const u32x4*)(P.cdil + ((size_t)2 * MR + grow) * 512 + 8 * c), gd = *(const u32x4*)(P.gate - 1024 + grow * P.ldq + 8 * c);
            u32x4 wo;
#pragma unroll
            for (int j = 0; j < 4; ++j) wo[j] = pk2((bflo(a[j]) * w0 + bflo(b[j]) * w1 + bflo(cc[j]) * w2) * silu(bflo(gd[j])), (bfhi(a[j]) * w0 + bfhi(b[j]) * w1 + bfhi(cc[j]) * w2) * silu(bfhi(gd[j])));
            *(u32x4*)(P.o - 512 + grow * P.ldo + 8 * c) = wo; } }
    __syncthreads();
}

__device__ __forceinline__ void attn_item_wide(const Ctx& C, const AttnP& P, u32x4 (&kw)[8], u32x4 (&vw)[8], const bool have, const NextKV& nx) {
    const int tid = fresh_tid(C.wid);
    const int lane = tid & 63, wid = C.wid, r = lane & 31, h = lane >> 5;
    LAS unsigned char* Kl = C.lds; LAS unsigned char* Vl = C.lds + 65536;
    bf16x8 qf[8];
    const int qrow = P.qrow0 + 32 * wid + r;
    {
        const int c = tid & 15, kr = tid >> 4;
        const bf16_t* qp = P.q + (size_t)qrow * P.ldq + 8 * h;
        u32x4 raw[8];
#pragma unroll
        for (int s = 0; s < 8; ++s) raw[s] = *(const u32x4*)(qp + 16 * s);
        if (!have) {
#pragma unroll
            for (int it = 0; it < 8; ++it) { const size_t row = (size_t)(P.krow0 + (kr + 32 * it) * P.krstep);
                kw[it] = *(const u32x4*)(P.k + row * P.ldk + 8 * c); vw[it] = *(const u32x4*)(P.v + row * P.ldk + 8 * c); } }
        float ss = 0.f;
#pragma unroll
        for (int s = 0; s < 8; ++s)
#pragma unroll
            for (int j = 0; j < 4; ++j) { const float a = bflo(raw[s][j]), b = bfhi(raw[s][j]); ss += a * a + b * b; }
        ss += __shfl_xor(ss, 32);
        const float rs = rsqrtf(ss * (1.0f / 128.0f) + EPS) * QSCALE;
#pragma unroll
        for (int s = 0; s < 8; ++s) {
            u32x4 w; w.x = pk2(bflo(raw[s][0]) * rs, bfhi(raw[s][0]) * rs); w.y = pk2(bflo(raw[s][1]) * rs, bfhi(raw[s][1]) * rs);
            w.z = pk2(bflo(raw[s][2]) * rs, bfhi(raw[s][2]) * rs); w.w = pk2(bflo(raw[s][3]) * rs, bfhi(raw[s][3]) * rs);
            qf[s] = __builtin_bit_cast(bf16x8, w); }
        const f32x4 gk0 = *(const f32x4*)(P.gk + 8 * c), gk1 = *(const f32x4*)(P.gk + 8 * c + 4);
        const f32x4 gq0 = *(const f32x4*)(P.gq + 8 * c), gq1 = *(const f32x4*)(P.gq + 8 * c + 4);
#pragma unroll
        for (int it = 0; it < 8; ++it) {
            const int j = kr + 32 * it;
            f32x4 k0 = {bflo(kw[it].x), bfhi(kw[it].x), bflo(kw[it].y), bfhi(kw[it].y)}, k1 = {bflo(kw[it].z), bfhi(kw[it].z), bflo(kw[it].w), bfhi(kw[it].w)};
            float s2 = (k0[0] * k0[0] + k0[1] * k0[1]) + (k0[2] * k0[2] + k0[3] * k0[3]) + (k1[0] * k1[0] + k1[1] * k1[1]) + (k1[2] * k1[2] + k1[3] * k1[3]);
            s2 = row16_sum(s2);
            const float rk = rsqrtf(s2 * (1.0f / 128.0f) + EPS);
            k0 = k0 * rk * gk0; k1 = k1 * rk * gk1;
            const f32x4 kq0 = k0 * gq0, kq1 = k1 * gq1;
            u32x4 w; w.x = pk2(kq0[0], kq0[1]); w.y = pk2(kq0[2], kq0[3]); w.z = pk2(kq1[0], kq1[1]); w.w = pk2(kq1[2], kq1[3]);
            *(LAS u32x4*)(Kl + off_b(j, c)) = w; *(LAS u32x4*)(Vl + off_b(j, c)) = vw[it];
            if (j >= P.kv_jfrom) { float* o = P.kvout + (size_t)(j - P.kv_jfrom) * P.kv_ostride + 8 * c;
                *(f32x4*)o = k0; *(f32x4*)(o + 4) = k1;
                *(f32x4*)(o + 512) = (f32x4){bflo(vw[it].x), bfhi(vw[it].x), bflo(vw[it].y), bfhi(vw[it].y)}; *(f32x4*)(o + 516) = (f32x4){bflo(vw[it].z), bfhi(vw[it].z), bflo(vw[it].w), bfhi(vw[it].w)}; }
        }
    }
    __syncthreads();
    f32x16 o[4]; float mrun = -1e30f, lrun = 0.f;
#pragma unroll
    for (int et = 0; et < 4; ++et) for (int i = 0; i < 16; ++i) o[et][i] = 0.f;
    const unsigned xr = ((r & 3) << 2) | ((r >> 2) & 3);
    const int q4 = (lane & 15) >> 2, p4 = lane & 3, blk = (lane >> 4) & 1, clow = 2 * blk + (p4 >> 1);
#pragma unroll
    for (int st = 0; st < 4; ++st) {
        u32x4 pb[2][2];
        {
            f32x16 sacc[2];
            unsigned kaddr[8];
#pragma unroll
            for (int s = 0; s < 8; ++s) kaddr[s] = 256u * (64 * st + r) + 16u * ((unsigned)(2 * s + h) ^ xr);
#pragma unroll
            for (int kt = 0; kt < 2; ++kt) { for (int i = 0; i < 16; ++i) sacc[kt][i] = 0.f;
#pragma unroll
                for (int s = 0; s < 8; ++s) { const bf16x8 a = *(const LAS bf16x8*)(Kl + kaddr[s] + 8192 * kt); sacc[kt] = __builtin_amdgcn_mfma_f32_32x32x16_bf16(a, qf[s], sacc[kt], 0, 0, 0); }
                asm volatile("" ::: "memory"); }
            float m = mrun;
#pragma unroll
            for (int kt = 0; kt < 2; ++kt)
#pragma unroll
                for (int i = 0; i < 16; ++i) m = fmaxf(m, sacc[kt][i]);
            m = fmaxf(m, __shfl_xor(m, 32));
            const float alpha = __builtin_amdgcn_exp2f(mrun - m);
            float l = 0.f;
#pragma unroll
            for (int kt = 0; kt < 2; ++kt)
#pragma unroll
                for (int s2 = 0; s2 < 2; ++s2) {
                    float pv[8];
#pragma unroll
                    for (int j = 0; j < 8; ++j) { pv[j] = __builtin_amdgcn_exp2f(sacc[kt][8 * s2 + j] - m); l += pv[j]; }
                    pb[kt][s2].x = pk2(pv[0], pv[1]); pb[kt][s2].y = pk2(pv[2], pv[3]); pb[kt][s2].z = pk2(pv[4], pv[5]); pb[kt][s2].w = pk2(pv[6], pv[7]);
                }
            l += __shfl_xor(l, 32);
            lrun = lrun * alpha + l; mrun = m;
#pragma unroll
            for (int et = 0; et < 4; ++et) o[et] = o[et] * alpha;
        }
        if (st == 3 && nx.valid) {
            const int c = tid & 15, kr = tid >> 4;
#pragma unroll
            for (int it = 0; it < 8; ++it) if (it >= nx.it0) { const size_t row = (size_t)(nx.krow0 + (kr + 32 * it) * nx.krstep);
                kw[it] = *(const u32x4*)(nx.k + row * nx.ldk + 8 * c); vw[it] = *(const u32x4*)(nx.k + 512 + row * nx.ldk + 8 * c); }
        }
        unsigned vaddr[4][2];
#pragma unroll
        for (int et = 0; et < 4; ++et)
#pragma unroll
            for (int hi = 0; hi < 2; ++hi) vaddr[et][hi] = 256u * (64 * st + 4 * h + q4 + 8 * hi) + 64u * (unsigned)(et ^ q4) + 16u * (unsigned)(clow ^ (h + 2 * hi)) + 8u * (p4 & 1);
#pragma unroll
        for (int kt = 0; kt < 2; ++kt)
#pragma unroll
            for (int s2 = 0; s2 < 2; ++s2) {
                const bf16x8 pbv = __builtin_bit_cast(bf16x8, pb[kt][s2]);
#pragma unroll
                for (int et = 0; et < 4; ++et) {
                    const s16x4 lo = __builtin_amdgcn_ds_read_tr16_b64_v4i16((LAS s16x4*)(Vl + vaddr[et][0] + 8192 * kt + 4096 * s2));
                    const s16x4 hi = __builtin_amdgcn_ds_read_tr16_b64_v4i16((LAS s16x4*)(Vl + vaddr[et][1] + 8192 * kt + 4096 * s2));
                    const bf16x8 va = __builtin_shufflevector(lo, hi, 0, 1, 2, 3, 4, 5, 6, 7);
                    o[et] = __builtin_amdgcn_mfma_f32_32x32x16_bf16(va, pbv, o[et], 0, 0, 0);
                }
                asm volatile("" ::: "memory");
            }
    }
    __syncthreads();
    LAS unsigned char* Ot = C.lds;
    {
        const float inv = 1.0f / lrun;
#pragma unroll
        for (int et = 0; et < 4; ++et)
#pragma unroll
            for (int g4 = 0; g4 < 4; ++g4) {
                const int e0 = 32 * et + 8 * g4 + 4 * h;
                u32x2 w; w.x = pk2(o[et][4 * g4 + 0] * inv, o[et][4 * g4 + 1] * inv); w.y = pk2(o[et][4 * g4 + 2] * inv, o[et][4 * g4 + 3] * inv);
                *(LAS u32x2*)(Ot + (32 * wid + r) * 272 + 2 * e0) = w;
            }
    }
    u32x4 gwv[8];
#pragma unroll
    for (int i = 0; i < 8; ++i) { const int id = tid + 512 * i, qi = id >> 4, c = id & 15; gwv[i] = *(const u32x4*)(P.gate + (size_t)(P.qrow0 + qi) * P.ldq + 8 * c); }
    __syncthreads();
#pragma unroll
    for (int i = 0; i < 8; ++i) { const int id = tid + 512 * i, qi = id >> 4, c = id & 15; const size_t grow = (size_t)(P.qrow0 + qi);
        u32x4 w = *(const LAS u32x4*)(Ot + qi * 272 + 16 * c);
        { const u32x4 gw = gwv[i];
#pragma unroll
            for (int j = 0; j < 4; ++j) w[j] = pk2(bflo(w[j]) * silu(bflo(gw[j])), bfhi(w[j]) * silu(bfhi(gw[j]))); }
        *(u32x4*)(P.o + grow * P.ldo + 8 * c) = w;
        if (P.cdil) {
            const float l0 = P.clse[grow * 4], l1 = P.clse[((size_t)MR + grow) * 4], l2 = P.clse[((size_t)2 * MR + grow) * 4];
            const float mm = fmaxf(l0, fmaxf(l1, l2)); float w0 = __builtin_amdgcn_exp2f(l0 - mm), w1 = __builtin_amdgcn_exp2f(l1 - mm), w2 = __builtin_amdgcn_exp2f(l2 - mm); const float inv = 1.0f / (w0 + w1 + w2);
            w0 *= inv; w1 *= inv; w2 *= inv;
            const u32x4 a = *(const u32x4*)(P.cdil + grow * 512 + 8 * c), b = *(const u32x4*)(P.cdil + ((size_t)MR + grow) * 512 + 8 * c),
                        cc = *(const u32x4*)(P.cdil + ((size_t)2 * MR + grow) * 512 + 8 * c), gd = *(const u32x4*)(P.gate - 1024 + grow * P.ldq + 8 * c);
            u32x4 wo;
#pragma unroll
            for (int j = 0; j < 4; ++j) wo[j] = pk2((bflo(a[j]) * w0 + bflo(b[j]) * w1 + bflo(cc[j]) * w2) * silu(bflo(gd[j])), (bfhi(a[j]) * w0 + bfhi(b[j]) * w1 + bfhi(cc[j]) * w2) * silu(bfhi(gd[j])));
            *(u32x4*)(P.o - 512 + grow * P.ldo + 8 * c) = wo; }
        asm volatile("" ::: "memory"); }
    __syncthreads();
}

struct SAttnP {
    const bf16_t* q; const float* gq;
    const float* kbase; long kstride; int nk;
    const bf16_t* knew; const bf16_t* vnew; const float* gk;
    float* newout;
    bf16_t* o; const bf16_t* gate; float* lse;
};
__device__ __forceinline__ void sattn_item(const Ctx& C, const SAttnP& P) {
    LAS float* sq = (LAS float*)C.lds;
    LAS float* kn = sq + 128;
    LAS float* vn = kn + 128;
    LAS float* sc = vn + 128;
    LAS float* red = sc + 320;
    const int tid = fresh_tid(C.wid);
    const int lane = tid & 63, wid = C.wid;
    const bool extra = P.knew != nullptr;
    const int hw = tid >> 5, l32 = tid & 31, nkh = P.nk >> 4;
    const int eg = tid & 31, kg = tid >> 5, per = P.nk >> 4;
    f32x4 kv[16], vv[16];
#pragma unroll
    for (int i = 0; i < 16; ++i) if (i < nkh) kv[i] = __builtin_nontemporal_load((const f32x4*)(P.kbase + (long)(hw + 16 * i) * P.kstride + 4 * l32));
    { const float* vp = P.kbase + 512 + 4 * eg + (long)(kg * per) * P.kstride;
#pragma unroll
        for (int i = 0; i < 16; ++i) if (i < per) vv[i] = __builtin_nontemporal_load((const f32x4*)(vp + (long)i * P.kstride)); }
    if (wid == 0) { const float a = bflo((unsigned)P.q[2 * lane]), b = bflo((unsigned)P.q[2 * lane + 1]);
        const float ss = wave_sum(a * a + b * b), rs = rsqrtf(ss * (1.0f / 128.0f) + EPS) * QSCALE;
        sq[2 * lane] = a * rs * P.gq[2 * lane]; sq[2 * lane + 1] = b * rs * P.gq[2 * lane + 1]; }
    if (wid == 1 && extra) { const float a = bflo((unsigned)P.knew[2 * lane]), b = bflo((unsigned)P.knew[2 * lane + 1]);
        const float ss = wave_sum(a * a + b * b), rs = rsqrtf(ss * (1.0f / 128.0f) + EPS);
        const float ka = a * rs * P.gk[2 * lane], kb = b * rs * P.gk[2 * lane + 1];
        kn[2 * lane] = ka; kn[2 * lane + 1] = kb; P.newout[2 * lane] = ka; P.newout[2 * lane + 1] = kb; }
    if (wid == 2 && extra) { const float a = bflo((unsigned)P.vnew[2 * lane]), b = bflo((unsigned)P.vnew[2 * lane + 1]);
        vn[2 * lane] = a; vn[2 * lane + 1] = b; P.newout[512 + 2 * lane] = a; P.newout[512 + 2 * lane + 1] = b; }
    __syncthreads();
    {
        const f32x4 qv = *(const LAS f32x4*)(sq + 4 * l32);
        float mine = 0.f;
#pragma unroll
        for (int i = 0; i < 16; ++i) if (i < nkh) { float d = (kv[i][0] * qv[0] + kv[i][1] * qv[1]) + (kv[i][2] * qv[2] + kv[i][3] * qv[3]);
            d = row16_sum(d); d += __shfl_xor(d, 16); if (l32 == i) mine = d; }
        if (l32 < nkh) sc[hw + 16 * l32] = mine;
    }
    if (wid == 7 && extra) { const float d = wave_sum(sq[2 * lane] * kn[2 * lane] + sq[2 * lane + 1] * kn[2 * lane + 1]); if (lane == 0) sc[P.nk] = d; }
    __syncthreads();
    const int ntot = P.nk + (extra ? 1 : 0);
    float m = -1e30f, l = 0.f;
    { float sv[5];
#pragma unroll
        for (int i = 0; i < 5; ++i) { const int j = lane + 64 * i; sv[i] = j < ntot ? sc[j] : -1e30f; m = fmaxf(m, sv[i]); }
        m = wave_max(m);
#pragma unroll
        for (int i = 0; i < 5; ++i) l += __builtin_amdgcn_exp2f(sv[i] - m);
        l = wave_sum(l); }
    const float inv = 1.0f / l;
    {
        f32x4 acc = {0.f, 0.f, 0.f, 0.f};
#pragma unroll
        for (int i = 0; i < 16; ++i) if (i < per) acc += vv[i] * (__builtin_amdgcn_exp2f(sc[kg * per + i] - m) * inv);
        if (extra && kg == 0) acc += *(const LAS f32x4*)(vn + 4 * eg) * (__builtin_amdgcn_exp2f(sc[P.nk] - m) * inv);
        *(LAS f32x4*)(red + kg * 128 + 4 * eg) = acc; }
    __syncthreads();
    if (tid < 128) { float v = 0.f;
#pragma unroll
        for (int g = 0; g < 16; ++g) v += red[g * 128 + tid];
        if (P.gate) v *= silu(bflo((unsigned)P.gate[tid]));
        P.o[tid] = (bf16_t)(pk2(v, 0.f) & 0xffffu); }
    if (tid == 0 && P.lse) P.lse[0] = m + log2f(l);
    __syncthreads();
}

__device__ __forceinline__ void mixer_attn(const Ctx& C, int l, int part) {
    const bool isb = l >= 2; const int bl = l - 2;
    const bf16_t* Z = (const bf16_t*)(C.ws + WS_Z); const bf16_t* KVB = (const bf16_t*)(C.ws + WS_KVB); bf16_t* ACT = (bf16_t*)(C.ws + WS_ACT);
    const bf16_t* MEMKV = (const bf16_t*)(C.ws + WS_MEMKV);
    bf16_t* DILO = (bf16_t*)(C.ws + WS_DILO); float* LSE = (float*)(C.ws + WS_LSE);
    const int ldz = NINB, mqoff = 2048, ldact = isb ? KOUTB : KOUTA, acol = isb ? 512 : 1024;
    const bf16_t* ZS = (const bf16_t*)(C.ws + WS_ZS);
    const int n_smem = part == 2 ? 0 : 128, n_sdil = part == 1 ? 384 : 0, n_pdil = part == 1 ? 1536 : 0, n_pmem = part == 1 ? 0 : 256;
    const int ntot = n_smem + n_sdil + n_pdil + n_pmem;
    const int vb = (C.G % 8 == 0) ? (C.bid % 8) * (C.G / 8) + C.bid / 8 : C.bid;
    for (int it = C.bid; it < n_smem + n_sdil; it += C.G) {
        {
            SAttnP P;
            if (it < n_smem) { const int b = it >> 2, h = it & 3; const size_t row = MP + b;
                P.q = isb ? Z + row * ldz + mqoff + h * 128 : ZS + (size_t)b * NINA + 4096 + h * 128; P.gq = C.in[22] + l * 128;
                P.kbase = C.in[2] + ((size_t)(l * NS + b) * MEML) * 1024 + h * 128; P.kstride = 1024; P.nk = 256;
                P.knew = nullptr; P.vnew = nullptr; P.gk = nullptr; P.newout = nullptr;
                P.o = ACT + row * ldact + acol + h * 128; P.gate = P.q + 512; P.lse = nullptr;
            } else { const int idx = it - n_smem, b = idx / 12, g = (idx / 4) % 3, h = idx & 3; const size_t row = MP + b;
                const int W = g == 0 ? 128 : (g == 1 ? 512 : 2048), d = g == 0 ? 1 : (g == 1 ? 4 : 16);
                const float* buf = g == 0 ? C.in[4] : (g == 1 ? C.in[5] : C.in[6]);
                P.q = Z + row * NINB + g * 512 + h * 128; P.gq = C.in[14] + (bl * 3 + g) * 128;
                P.kbase = buf + ((size_t)b * W + (W - d)) * 1024 + h * 128; P.kstride = -(long)d * 1024; P.nk = 128;
                P.knew = KVB + row * 3072 + g * 1024 + h * 128; P.vnew = P.knew + 512; P.gk = C.in[18] + g * 128;
                P.newout = C.out + (g == 0 ? O_DIL0S : (g == 1 ? O_DIL1S : O_DIL2S)) + (size_t)b * 1024 + h * 128;
                P.o = DILO + ((size_t)g * MR + row) * 512 + h * 128; P.gate = nullptr; P.lse = LSE + ((size_t)g * MR + row) * 4 + h; }
            sattn_item(C, P);
        }
    }
    if (part == 1) {
        u32x4 kw[8], vw[8]; bool have = false;
        for (int it = n_smem + n_sdil + vb; it < ntot; it += C.G) {
            AttnP P; const int idx = it - n_smem - n_sdil, combo = idx & 15, h = (idx >> 4) & 3, g = (idx >> 6) % 3, b = idx / 192;
            const int d = g == 0 ? 1 : (g == 1 ? 4 : 16), res = combo % d, n = combo / d, keep = g == 0 ? 128 : (g == 1 ? 512 : 2048);
            P.q = Z + g * 512 + h * 128; P.ldq = NINB; P.qrow0 = b * SEQ + n * 128 * d + res; P.qrstep = d;
            P.k = KVB + g * 1024 + h * 128; P.v = P.k + 512; P.ldk = 3072; P.krow0 = b * SEQ + (n - 1) * 128 * d + res; P.krstep = d;
            P.gq = C.in[14] + (bl * 3 + g) * 128; P.gk = C.in[18] + g * 128; P.mode = n == 0 ? 2 : 1;
            const int t128 = (n * 128) * d + res;
            const bool wr = (bl == 0) && (t128 >= SEQ - keep);
            P.kvout = C.out + (g == 0 ? O_DIL0P : (g == 1 ? O_DIL1P : O_DIL2P)) + ((size_t)b * keep + (wr ? t128 - (SEQ - keep) : 0)) * 1024 + h * 128;
            P.kv_jfrom = wr ? 128 : 256; P.kv_ostride = (size_t)d * 1024;
            P.o = DILO + (size_t)g * MR * 512 + h * 128; P.ldo = 512; P.gate = nullptr; P.lse = LSE + (size_t)g * MR * 4 + h; P.cdil = nullptr; P.clse = nullptr;
            NextKV nx; nx.valid = 0; nx.k = nullptr; nx.ldk = 3072; nx.krow0 = 0; nx.krstep = 0; nx.it0 = 0;
            { const int itn = it + C.G;
                if (itn < ntot) { const int j2 = itn - n_smem - n_sdil; nx.valid = 1;
                    const int combo2 = j2 & 15, h2 = (j2 >> 4) & 3, g2 = (j2 >> 6) % 3, b2 = j2 / 192, d2 = g2 == 0 ? 1 : (g2 == 1 ? 4 : 16), res2 = combo2 % d2, n2 = combo2 / d2;
                    nx.k = KVB + g2 * 1024 + h2 * 128; nx.krow0 = b2 * SEQ + (n2 - 1) * 128 * d2 + res2; nx.krstep = d2; nx.it0 = n2 == 0 ? 4 : 0; } }
            attn_item(C, P, kw, vw, have, nx);
            have = nx.valid != 0;
        }
    } else {
        u32x4 kw[8], vw[8]; bool have = false;
        for (int it = n_smem + n_sdil + vb; it < ntot; it += C.G) {
            AttnP P; const int idx = it - n_smem - n_sdil, b = idx >> 5, h = (idx >> 3) & 3, qblk = idx & 7;
            P.q = Z + mqoff + h * 128; P.ldq = ldz; P.qrow0 = b * SEQ + qblk * 256; P.qrstep = 1;
            P.k = MEMKV + l * 1024 + h * 128; P.v = P.k + 512; P.ldk = 4096; P.krow0 = b * MEML; P.krstep = 1;
            P.gq = C.in[22] + l * 128; P.gk = C.in[21] + l * 128; P.mode = 0;
            P.kvout = C.out + O_MEMKV + ((size_t)(l * NB + b) * MEML) * 1024 + h * 128; P.kv_jfrom = qblk == 0 ? 0 : 256; P.kv_ostride = 1024;
            P.o = ACT + acol + h * 128; P.ldo = ldact; P.gate = Z + mqoff + 512 + h * 128; P.lse = nullptr;
            P.cdil = part == 2 ? DILO + h * 128 : nullptr; P.clse = part == 2 ? LSE + h : nullptr;
            NextKV nx; nx.valid = 0; nx.k = nullptr; nx.ldk = 4096; nx.krow0 = 0; nx.krstep = 1; nx.it0 = 0;
            { const int itn = it + C.G;
                if (itn < ntot) { const int j2 = itn - n_smem - n_sdil, b2 = j2 >> 5, h2 = (j2 >> 3) & 3; nx.valid = 1;
                    nx.k = MEMKV + l * 1024 + h2 * 128; nx.krow0 = b2 * MEML; } }
            attn_item_wide(C, P, kw, vw, have, nx);
            have = nx.valid != 0;
        }
    }
}
__device__ __forceinline__ void mixer_conv(const Ctx& C, int a) {
    const bf16_t* Z = (const bf16_t*)(C.ws + WS_Z); bf16_t* ACT = (bf16_t*)(C.ws + WS_ACT); const bf16_t* ZS = (const bf16_t*)(C.ws + WS_ZS);
    const float* cw = C.in[10] + (size_t)a * 3 * D;
    for (int task = C.bid * 512 + C.tid; task < (MP / 16) * 128 + NS * 128; task += C.G * 512) {
        const bool smp = task >= (MP / 16) * 128;
        const int chunk = task & 127, col = 8 * chunk;
        float w0[8], w1[8], w2[8], u1[8], u2[8];
#pragma unroll
        for (int i = 0; i < 8; ++i) { w0[i] = cw[col + i]; w1[i] = cw[D + col + i]; w2[i] = cw[2 * D + col + i]; u1[i] = 0.f; u2[i] = 0.f; }
        if (smp) { const int b = (task - (MP / 16) * 128) >> 7;
            const float* st = C.in[3] + ((size_t)(a * NS + b) * 2) * D + col;
            float* cs = C.out + O_CONVS + ((size_t)(a * NS + b) * 2) * D + col;
            const bf16_t* zr = ZS + (size_t)b * NINA + (col >> 7) * 256 + (col & 127);
            const u32x4 hw = *(const u32x4*)zr, cw4 = *(const u32x4*)(zr + 128), bw = *(const u32x4*)(zr + 2048), gw = *(const u32x4*)(zr + 2048 + 128);
            float ov[8];
#pragma unroll
            for (int i = 0; i < 8; ++i) { const float hh = (i & 1) ? bfhi(hw[i >> 1]) : bflo(hw[i >> 1]), cc = (i & 1) ? bfhi(cw4[i >> 1]) : bflo(cw4[i >> 1]);
                const float bg = (i & 1) ? bfhi(bw[i >> 1]) : bflo(bw[i >> 1]), gg = (i & 1) ? bfhi(gw[i >> 1]) : bflo(gw[i >> 1]);
                const float s0 = st[i], s1 = st[D + i], u0 = hh * cc;
                ov[i] = silu(gg) * bg * (w0[i] * s0 + w1[i] * s1 + w2[i] * u0); cs[i] = s1; cs[D + i] = u0; }
            u32x4 w; w.x = pk2(ov[0], ov[1]); w.y = pk2(ov[2], ov[3]); w.z = pk2(ov[4], ov[5]); w.w = pk2(ov[6], ov[7]);
            *(u32x4*)(ACT + (size_t)(MP + b) * KOUTA + col) = w;
            continue; }
        const int t0 = (task >> 7) * 16;
        if ((t0 & (SEQ - 1)) != 0) {
            const u32x4 a1 = *(const u32x4*)(Z + (size_t)(t0 - 1) * NINB + col), a2 = *(const u32x4*)(Z + (size_t)(t0 - 2) * NINB + col);
#pragma unroll
            for (int i = 0; i < 4; ++i) { u1[2 * i] = bflo(a1[i]); u1[2 * i + 1] = bfhi(a1[i]); u2[2 * i] = bflo(a2[i]); u2[2 * i + 1] = bfhi(a2[i]); } }
#pragma unroll 4
        for (int rr = 0; rr < 16; ++rr) {
            const int t = t0 + rr; const bf16_t* zr = Z + (size_t)t * NINB + col;
            const u32x4 uw = *(const u32x4*)zr, gw = *(const u32x4*)(zr + 1024);
            float u0[8], ov[8];
#pragma unroll
            for (int i = 0; i < 4; ++i) { u0[2 * i] = bflo(uw[i]); u0[2 * i + 1] = bfhi(uw[i]); }
#pragma unroll
            for (int i = 0; i < 8; ++i) { const float gb = (i & 1) ? bfhi(gw[i >> 1]) : bflo(gw[i >> 1]); ov[i] = gb * (w0[i] * u2[i] + w1[i] * u1[i] + w2[i] * u0[i]); }
            u32x4 w; w.x = pk2(ov[0], ov[1]); w.y = pk2(ov[2], ov[3]); w.z = pk2(ov[4], ov[5]); w.w = pk2(ov[6], ov[7]);
            *(u32x4*)(ACT + (size_t)t * KOUTA + col) = w;
#pragma unroll
            for (int i = 0; i < 8; ++i) { u2[i] = u1[i]; u1[i] = u0[i]; }
        }
    }
}
__device__ __forceinline__ void mixer_b_combine(const Ctx& C, int row_lo) {
    const bf16_t* Z = (const bf16_t*)(C.ws + WS_Z); bf16_t* ACT = (bf16_t*)(C.ws + WS_ACT);
    const bf16_t* DILO = (const bf16_t*)(C.ws + WS_DILO); const float* LSE = (const float*)(C.ws + WS_LSE);
    for (int task = row_lo * 64 + C.bid * 512 + C.tid; task < MR * 64; task += C.G * 512) {
        const int row = task >> 6, chunk = task & 63, h = chunk >> 4;
        const float l0 = LSE[((size_t)0 * MR + row) * 4 + h], l1 = LSE[((size_t)1 * MR + row) * 4 + h], l2 = LSE[((size_t)2 * MR + row) * 4 + h];
        const float m = fmaxf(l0, fmaxf(l1, l2)); float w0 = exp2f(l0 - m), w1 = exp2f(l1 - m), w2 = exp2f(l2 - m); const float inv = 1.0f / (w0 + w1 + w2);
        w0 *= inv; w1 *= inv; w2 *= inv;
        const u32x4 a = *(const u32x4*)(DILO + ((size_t)0 * MR + row) * 512 + 8 * chunk), b = *(const u32x4*)(DILO + ((size_t)1 * MR + row) * 512 + 8 * chunk),
                    c = *(const u32x4*)(DILO + ((size_t)2 * MR + row) * 512 + 8 * chunk), gw = *(const u32x4*)(Z + (size_t)row * NINB + 1536 + 8 * chunk);
        u32x4 w;
#pragma unroll
        for (int i = 0; i < 4; ++i) { const float lo = (bflo(a[i]) * w0 + bflo(b[i]) * w1 + bflo(c[i]) * w2) * silu(bflo(gw[i]));
            const float hi = (bfhi(a[i]) * w0 + bfhi(b[i]) * w1 + bfhi(c[i]) * w2) * silu(bfhi(gw[i])); w[i] = pk2(lo, hi); }
        *(u32x4*)(ACT + (size_t)row * KOUTB + 8 * chunk) = w;
    }
}

struct GsP { const bf16_t* A; const bf16_t* Bt; int M, N; bf16_t* O; int ldc; const float* ss; int split_cols; size_t split_stride; int sample; float* convp; };
__device__ __forceinline__ void gemm_scale(const Ctx& C, const GsP& q) {
    pg8::Gemm g{q.A, q.Bt, q.M, q.N, D}; pg8::StaticOrder S; S.init(q.M, q.N, C.G, C.bid);
    LAS float* rst = (LAS float*)(C.lds + 131072);
    for (int i = C.tid >> 8; i < 8; i += 2) { pg8::Unit u; if (!S.next(i, u)) break; rst[i * 256 + (C.tid & 255)] = rsqrtf(q.ss[u.pm * 256 + (C.tid & 255)] * (1.0f / 1024.0f) + EPS); }
    __syncthreads();
    pg8::EpiScale E{q.O, q.ldc, rst, q.split_cols, q.split_stride, q.convp};
    pg8::gemm_phase<pg8::EpiScale>(C.lds, g, S, E, C.tid);
    if (q.sample)
        for (int tile = C.bid; tile < q.N / 32; tile += C.G)
            sgemm_tile(C, q.A + (size_t)MP * D, D, q.Bt, D, tile, nullptr, [&](int row, int col, float v) -> float {
                bf16_t* base = q.O; int cc = col; if (q.split_cols) { const int t = cc / q.split_cols; base += (size_t)t * q.split_stride; cc -= t * q.split_cols; }
                const float rs = rsqrtf(q.ss[MP + row] * (1.0f / 1024.0f) + EPS); const bf16_t o = (bf16_t)(pk2(v * rs, 0.f) & 0xffffu);
                if (q.convp) ((bf16_t*)(C.ws + WS_ZS))[(size_t)row * NINA + col] = o; else base[(size_t)(MP + row) * q.ldc + cc] = o; return 0.f; });
}
struct GrP { const bf16_t* A; const bf16_t* Bt; int K; bf16_t* xb; float* xout; float* ssn; };
__device__ __forceinline__ void gemm_resid(const Ctx& C, const GrP& q) {
    pg8::Gemm g{q.A, q.Bt, MP, D, q.K}; pg8::StaticOrder S; S.init(MP, D, C.G, C.bid);
    pg8::EpiResid E{q.xb, q.xout, q.ssn};
    pg8::gemm_phase<pg8::EpiResid>(C.lds, g, S, E, C.tid);
    for (int tile = C.bid; tile < D / 32; tile += C.G)
        sgemm_tile(C, q.A + (size_t)MP * q.K, q.K, q.Bt, q.K, tile, q.xout ? nullptr : q.ssn + MP, [&](int row, int col, float v) -> float {
            const size_t off = (size_t)(MP + row) * D + col; const float x = bflo((unsigned)q.xb[off]) + v;
            if (q.xout) q.xout[off] = x; else q.xb[off] = (bf16_t)(pk2(x, 0.f) & 0xffffu); return x * x; });
}

constexpr int N_STEPS = 18;
#ifndef KMASK
#define KMASK 63
#endif

__global__ void __launch_bounds__(512, 2) yoco_fwd(Params p) {
    extern __shared__ __attribute__((aligned(16))) unsigned char lds_raw[];
    Ctx C; C.in = p.in; C.out = p.out; C.ws = p.ws; C.lds = (LAS unsigned char*)lds_raw;
    C.tid = threadIdx.x; C.lane = C.tid & 63; C.wid = __builtin_amdgcn_readfirstlane(C.tid >> 6); C.G = gridDim.x; C.bid = blockIdx.x;
    cg::grid_group grid = cg::this_grid();
    if (C.tid < 2) ((LAS unsigned*)(C.lds + LDS_ST_OFF))[C.tid] = 0u;
    __syncthreads();
    (void)xcd_barrier_post((unsigned*)(p.ws + WS_CTL), (volatile LAS unsigned*)(C.lds + LDS_ST_OFF));
    for (int s = p.ph_lo; s < p.ph_hi; ++s) {
        unsigned char* wsb = p.ws; float* outb = p.out; asm volatile("" : "+s"(wsb), "+s"(outb));
        C.ws = wsb; C.out = outb;
        bf16_t* Wmem = (bf16_t*)(wsb + WS_WMEM); bf16_t* Wina = (bf16_t*)(wsb + WS_WINA); bf16_t* Wouta = (bf16_t*)(wsb + WS_WOUTA);
        bf16_t* Wkvb = (bf16_t*)(wsb + WS_WKVB); bf16_t* Winb1 = (bf16_t*)(wsb + WS_WINB1); bf16_t* Woutb = (bf16_t*)(wsb + WS_WOUTB);
        bf16_t* XB = (bf16_t*)(wsb + WS_XB); bf16_t* MEMN = (bf16_t*)(wsb + WS_MEMN); bf16_t* MEMKV = (bf16_t*)(wsb + WS_MEMKV);
        bf16_t* Z = (bf16_t*)(wsb + WS_Z); bf16_t* KVB = (bf16_t*)(wsb + WS_KVB); bf16_t* ACT = (bf16_t*)(wsb + WS_ACT);
        float* SS = (float*)(wsb + WS_SS); float* X = outb + O_Y;
        bool sync_after = true;
        if (s == 0) { for (int rep = 0; rep < ((RMASK & 1) ? 2 : 1); ++rep) p0_prologue(launder(C)); }
        else if (s == 1 || s == 2 || s == 6 || s == 10 || s == 14) {
            GsP q; q.split_cols = 0; q.split_stride = 0; q.sample = 1; q.convp = nullptr;
            if (s == 1) { q.A = MEMN; q.Bt = Wmem; q.M = 2048; q.N = 4096; q.O = MEMKV; q.ldc = 4096; q.ss = SS + 4 * SS_STRIDE; q.sample = 0; sync_after = false; }
            else if (s == 2) { q.A = XB; q.Bt = Wina; q.M = MP; q.N = NINA; q.O = Z; q.ldc = NINB; q.ss = SS; q.convp = outb + O_CONVP; }
            else if (s == 6) { q.A = XB; q.Bt = Wina + (size_t)NINA * D; q.M = MP; q.N = NINA; q.O = Z; q.ldc = NINB; q.ss = SS + SS_STRIDE; q.convp = outb + O_CONVP + (size_t)NB * 2 * D; }
            else if (s == 10) { q.A = XB; q.Bt = Wkvb; q.M = MP; q.N = NKVB; q.O = KVB; q.ldc = 3072; q.ss = SS + 2 * SS_STRIDE; q.split_cols = 3072; q.split_stride = (size_t)((WS_Z - WS_KVB) / 2); }
            else { q.A = XB; q.Bt = Winb1; q.M = MP; q.N = NINB; q.O = Z; q.ldc = NINB; q.ss = SS + 3 * SS_STRIDE; }
            for (int rep = 0; rep < ((RMASK & 2) ? 2 : 1); ++rep) gemm_scale(launder(C), q);
        } else if (s == 3 || s == 7 || s == 11 || s == 15 || s == 12 || s == 16) { for (int rep = 0; rep < (((RMASK & 4) || ((RMASK & 128) && s < 10) || ((RMASK & 256) && s > 10)) ? 2 : 1); ++rep) mixer_attn(launder(C), s == 3 ? 0 : (s == 7 ? 1 : (s < 14 ? 2 : 3)), s < 10 ? 0 : ((s == 11 || s == 15) ? 1 : 2));
            if (s == 12 || s == 16) mixer_b_combine(launder(C), MP); if (s == 3 || s == 7) sync_after = false; }
        else if (s == 4 || s == 8) { for (int rep = 0; rep < ((RMASK & 8) ? 2 : 1); ++rep) mixer_conv(launder(C), s == 4 ? 0 : 1); }
        else {
            GrP q; q.A = ACT; q.xb = XB; q.xout = nullptr;
            if (s == 5) { q.Bt = Wouta; q.K = KOUTA; q.ssn = SS + SS_STRIDE; }
            else if (s == 9) { q.Bt = Wouta + (size_t)D * KOUTA; q.K = KOUTA; q.ssn = SS + 2 * SS_STRIDE; }
            else if (s == 13) { q.Bt = Woutb; q.K = KOUTB; q.ssn = SS + 3 * SS_STRIDE; }
            else { q.Bt = Woutb + (size_t)D * KOUTB; q.K = KOUTB; q.xout = X; q.ssn = nullptr; }
            gemm_resid(launder(C), q);
        }
        if (sync_after && s + 1 < p.ph_hi) { if (p.ph_hi > 1000) grid.sync(); else { XcdBarrier xb; xb.bar = (unsigned*)(wsb + WS_CTL); xb.x = xb_xcc_id(); xb.st = (volatile LAS unsigned*)(C.lds + LDS_ST_OFF); xcd_barrier(xb); } }
    }
}

extern "C" void kernel_launch(void* const* d_in, const int* in_sizes, int n_in, void* d_out, int out_size, void* d_ws, size_t ws_size, hipStream_t stream) {
    static int grid = 0;
    if (grid == 0) {
        if (n_in != 23 || ws_size < WS_END) { fprintf(stderr, "kernel_launch: unexpected n_in %d or ws_size %zu\n", n_in, ws_size); grid = -1; return; }
        int dev = 0, cus = 0, per_cu = 0;
        hipGetDevice(&dev); hipDeviceGetAttribute(&cus, hipDeviceAttributeMultiprocessorCount, dev);
        if (hipFuncSetAttribute((const void*)yoco_fwd, hipFuncAttributeMaxDynamicSharedMemorySize, LDS_BYTES) != hipSuccess) { fprintf(stderr, "kernel_launch: hipFuncSetAttribute failed\n"); grid = -1; return; }
        if (hipOccupancyMaxActiveBlocksPerMultiprocessor(&per_cu, (const void*)yoco_fwd, 512, LDS_BYTES) != hipSuccess || per_cu < 1) { fprintf(stderr, "kernel_launch: occupancy query failed (%d)\n", per_cu); (void)hipGetLastError(); per_cu = 1; }
        grid = cus * (per_cu > 1 ? 1 : per_cu);
        if (grid > 256) grid = 256;
    }
    if (grid < 0) return;
    if (hipMemsetAsync((char*)d_ws + WS_CTL, 0, CTL_ZERO_BYTES, stream) != hipSuccess) { fprintf(stderr, "kernel_launch: memset of barrier words failed\n"); return; }
    Params p{};
    for (int i = 0; i < 23; ++i) p.in[i] = (const float*)d_in[i];
    p.out = (float*)d_out; p.ws = (unsigned char*)d_ws;
#if N_LAUNCH_MODE == 0
    p.ph_lo = 0; p.ph_hi = N_STEPS;
    void* args[] = {&p};
    hipError_t e = hipLaunchCooperativeKernel((const void*)yoco_fwd, dim3(grid), dim3(512), args, LDS_BYTES, stream);
    if (e != hipSuccess) fprintf(stderr, "cooperative launch failed: %s (grid %d)\n", hipGetErrorString(e), grid);
#else
    static const int cuts[] = {0, 1, 3, 5, 6, 7, 9, 10, 11, 12, 13, 14, 15, 16, 17, 18};
    for (int i = 0; i + 1 < (int)(sizeof(cuts) / sizeof(int)); ++i) { p.ph_lo = cuts[i]; p.ph_hi = cuts[i + 1]; hipLaunchKernelGGL(yoco_fwd, dim3(grid), dim3(512), LDS_BYTES, stream, p); }
#endif
}
```

```cpp
#include <hip/hip_runtime.h>
#include <hip/hip_cooperative_groups.h>
#include <cstdio>
namespace cg = cooperative_groups;

#ifndef N_LAUNCH_MODE
#define N_LAUNCH_MODE 0
#endif

#ifndef RMASK
#define RMASK 0
#endif

#define LAS __attribute__((address_space(3)))
typedef unsigned short bf16_t;
typedef short bf16x8 __attribute__((ext_vector_type(8)));
typedef short s16x4 __attribute__((ext_vector_type(4)));
typedef float f32x4 __attribute__((ext_vector_type(4)));
typedef float f32x16 __attribute__((ext_vector_type(16)));
typedef unsigned u32x4 __attribute__((ext_vector_type(4)));
typedef unsigned u32x2 __attribute__((ext_vector_type(2)));
typedef __bf16 bf16v2 __attribute__((ext_vector_type(2)));

constexpr int D = 1024, NB = 8, SEQ = 2048, MP = NB * SEQ, NS = 32, MR = MP + NS, MEML = 256;
constexpr int NINA = 5120, NKVB = 6144, NINB = 3072, KOUTA = 1536, KOUTB = 1024;
constexpr float EPS = 1e-6f;
constexpr float QSCALE = 0.08838834764831845f * 1.4426950408889634f;

constexpr size_t O_Y = 0, O_MEMKV = 16809984, O_CONVP = 25198592, O_CONVS = 25231360, O_DIL0P = 25362432, O_DIL1P = 26411008,
                 O_DIL2P = 30605312, O_DIL0S = 47382528, O_DIL1S = 47415296, O_DIL2S = 47448064;

constexpr size_t MiB = 1u << 20;
constexpr size_t WS_WMEM = 0, WS_WINA = 8 * MiB, WS_WOUTA = 28 * MiB, WS_WKVB = 34 * MiB, WS_WINB1 = 46 * MiB, WS_WOUTB = 52 * MiB,
                 WS_MEMN = 56 * MiB, WS_MEMKV = 60 * MiB, WS_XB = 76 * MiB, WS_SS = 110 * MiB, WS_Z = 112 * MiB, WS_KVB = 274 * MiB,
                 WS_ACT = 372 * MiB, WS_DILO = 422 * MiB, WS_LSE = 472 * MiB, WS_CTL = 474 * MiB, WS_ZS = 475 * MiB, WS_END = 476 * MiB;
constexpr size_t CTL_ZERO_BYTES = 16384;
constexpr int LDS_ST_OFF = 139264;
constexpr int SS_STRIDE = 16640;

constexpr int LDS_BYTES = 140 * 1024;

__device__ __forceinline__ unsigned pk2(float lo, float hi) { bf16v2 v = {(__bf16)lo, (__bf16)hi}; return __builtin_bit_cast(unsigned, v); }
__device__ __forceinline__ float bflo(unsigned w) { return __builtin_bit_cast(float, w << 16); }
__device__ __forceinline__ float bfhi(unsigned w) { return __builtin_bit_cast(float, w & 0xffff0000u); }
__device__ __forceinline__ float silu(float x) { return x * __builtin_amdgcn_rcpf(1.0f + __builtin_amdgcn_exp2f(x * -1.4426950408889634f)); }
__device__ __forceinline__ float row16_sum(float v) {
    v += __builtin_bit_cast(float, __builtin_amdgcn_mov_dpp(__builtin_bit_cast(int, v), 0xB1, 0xF, 0xF, true));
    v += __builtin_bit_cast(float, __builtin_amdgcn_mov_dpp(__builtin_bit_cast(int, v), 0x4E, 0xF, 0xF, true));
    v += __builtin_bit_cast(float, __builtin_amdgcn_mov_dpp(__builtin_bit_cast(int, v), 0x124, 0xF, 0xF, true));
    v += __builtin_bit_cast(float, __builtin_amdgcn_mov_dpp(__builtin_bit_cast(int, v), 0x128, 0xF, 0xF, true));
    return v;
}
__device__ __forceinline__ float wave_sum(float v) {
#pragma unroll
    for (int o = 1; o < 64; o <<= 1) v += __shfl_xor(v, o);
    return v;
}
__device__ __forceinline__ float wave_max(float v) {
#pragma unroll
    for (int o = 1; o < 64; o <<= 1) v = fmaxf(v, __shfl_xor(v, o));
    return v;
}

namespace pg8 {
constexpr int BM = 256, BK = 64, HALF = 128, HTB = HALF * BK * 2, STAGE_BYTES = 8 * HTB, NXCD = 8, WGM = 4;
__device__ __forceinline__ int lds_byte(int r, int c) { const int st = (r >> 4) * 2 + (c >> 5), rr = r & 15, cc = c & 31, ob = rr * 64 + cc * 2; return st * 1024 + (ob ^ (((ob >> 9) & 1) << 5)); }
__device__ __forceinline__ void stage_rc(int b, int& R, int& C) { const int st = b / 1024, sb = b % 1024, swz = sb ^ (((sb >> 9) & 1) << 5); R = (st >> 1) * 16 + swz / 64; C = (st & 1) * 32 + (swz % 64) / 2; }
__device__ __forceinline__ int perm32(int rho) { const int n = rho >> 4, i = rho & 15; return 8 * (i >> 2) + 4 * n + (i & 3); }
struct Unit { int pm, pn; };
struct Gemm { const bf16_t* A; const bf16_t* Bt; int M, N, K; };
struct StaticOrder {
    int nM, nN, nwg, G, c;
    __device__ void init(int M, int N, int G_, int c_) { nM = M / BM; nN = N / BM; nwg = nM * nN; G = G_; c = c_; }
    __device__ bool next(int i, Unit& u) const {
        const long L = (long)i * G + c; if (L >= nwg) return false;
        int wgid = (int)L; { const int q = nwg / NXCD, r = nwg % NXCD, xcd = wgid % NXCD, off = wgid / NXCD; wgid = (xcd < r ? xcd * (q + 1) : r * (q + 1) + (xcd - r) * q) + off; }
        const int nig = WGM * nN, gid = wgid / nig, fm = gid * WGM, gsz = (nM - fm) < WGM ? (nM - fm) : WGM;
        u.pm = fm + ((wgid % nig) % gsz); u.pn = (wgid % nig) / gsz; return true;
    }
};
struct EpiScale {
    bf16_t* O; int ldc; const LAS float* rst; int split_cols; size_t split_stride;
    float* convp;
    __device__ __forceinline__ void operator()(const f32x4 (&acc)[2][2][4][2], const Unit& u, int wr, int wc, int fr, int fq, int ui) const {
        const int row0 = u.pm * BM + wr * 64 + fr; int colt = u.pn * BM; bf16_t* base = O;
        if (split_cols) { const int t = colt / split_cols; base += (size_t)t * split_stride; colt -= t * split_cols; }
        float rsv[2][4];
        if (convp) { colt = u.pn < 16 ? (u.pn & 7) * 128 + (u.pn >> 3) * 1024 : u.pn * BM - 2048; }
        { const unsigned a = (unsigned)(size_t)(rst + ui * 256 + wr * 64 + fr);
          asm volatile("ds_read_b32 %0, %8\n\tds_read_b32 %1, %8 offset:64\n\tds_read_b32 %2, %8 offset:128\n\tds_read_b32 %3, %8 offset:192\n\t"
                       "ds_read_b32 %4, %8 offset:512\n\tds_read_b32 %5, %8 offset:576\n\tds_read_b32 %6, %8 offset:640\n\tds_read_b32 %7, %8 offset:704\n\ts_waitcnt lgkmcnt(0)"
                       : "=&v"(rsv[0][0]), "=&v"(rsv[0][1]), "=&v"(rsv[0][2]), "=&v"(rsv[0][3]), "=&v"(rsv[1][0]), "=&v"(rsv[1][1]), "=&v"(rsv[1][2]), "=&v"(rsv[1][3]) : "v"(a) : "memory"); }
        const int col0 = colt + wc * 32 + 8 * fq;
        if (convp && u.pn < 16) {
            const bool isu = u.pn < 8;
#pragma unroll
            for (int ai = 0; ai < 2; ++ai)
#pragma unroll
                for (int m = 0; m < 4; ++m) {
                    const int row = row0 + ai * HALF + m * 16; const float rs = rsv[ai][m];
                    f32x4 v0, v1;
                    if (isu) { v0 = acc[ai][0][m][0] * acc[ai][1][m][0] * (rs * rs); v1 = acc[ai][0][m][1] * acc[ai][1][m][1] * (rs * rs); }
                    else {
#pragma unroll
                        for (int j = 0; j < 4; ++j) { v0[j] = acc[ai][0][m][0][j] * rs * silu(acc[ai][1][m][0][j] * rs); v1[j] = acc[ai][0][m][1][j] * rs * silu(acc[ai][1][m][1][j] * rs); } }
                    u32x4 w; w.x = pk2(v0[0], v0[1]); w.y = pk2(v0[2], v0[3]); w.z = pk2(v1[0], v1[1]); w.w = pk2(v1[2], v1[3]);
                    *(u32x4*)(base + (size_t)row * ldc + col0) = w;
                    if (isu && (row & (SEQ - 1)) >= SEQ - 2) { float* cp = convp + ((size_t)(row >> 11) * 2 + ((row & (SEQ - 1)) - (SEQ - 2))) * D + col0; *(f32x4*)cp = v0; *(f32x4*)(cp + 4) = v1; }
                    asm volatile("" ::: "memory"); }
            return;
        }
#pragma unroll
        for (int ai = 0; ai < 2; ++ai)
#pragma unroll
            for (int m = 0; m < 4; ++m) {
                const int row = row0 + ai * HALF + m * 16;
                const float rs = rsv[ai][m];
                bf16_t* rowp = base + (size_t)row * ldc + col0;
#pragma unroll
                for (int bj = 0; bj < 2; ++bj) { const f32x4 v0 = acc[ai][bj][m][0] * rs, v1 = acc[ai][bj][m][1] * rs;
                    u32x4 w; w.x = pk2(v0[0], v0[1]); w.y = pk2(v0[2], v0[3]); w.z = pk2(v1[0], v1[1]); w.w = pk2(v1[2], v1[3]);
                    *(u32x4*)(rowp + bj * HALF) = w; }
                asm volatile("" ::: "memory"); }
    }
};
struct EpiResid {
    bf16_t* xb; float* xout; float* ssn;
    __device__ __forceinline__ void operator()(const f32x4 (&acc)[2][2][4][2], const Unit& u, int wr, int wc, int fr, int fq, int) const {
        const int row0 = u.pm * BM + wr * 64 + fr; const int col0 = u.pn * BM + wc * 32 + 8 * fq;
#pragma unroll
        for (int ai = 0; ai < 2; ++ai)
#pragma unroll
            for (int m = 0; m < 4; ++m) {
                const int row = row0 + ai * HALF + m * 16; float part = 0.f;
#pragma unroll
                for (int bj = 0; bj < 2; ++bj) { const size_t off = (size_t)row * D + col0 + bj * HALF;
                    const u32x4 xw = *(const u32x4*)(xb + off);
                    const f32x4 v0 = acc[ai][bj][m][0] + (f32x4){bflo(xw.x), bfhi(xw.x), bflo(xw.y), bfhi(xw.y)}, v1 = acc[ai][bj][m][1] + (f32x4){bflo(xw.z), bfhi(xw.z), bflo(xw.w), bfhi(xw.w)};
                    if (xout) { __builtin_nontemporal_store(v0, (f32x4*)(xout + off)); __builtin_nontemporal_store(v1, (f32x4*)(xout + off + 4)); }
                    else { u32x4 w; w.x = pk2(v0[0], v0[1]); w.y = pk2(v0[2], v0[3]); w.z = pk2(v1[0], v1[1]); w.w = pk2(v1[2], v1[3]); *(u32x4*)(xb + off) = w;
                        part += (v0[0] * v0[0] + v0[1] * v0[1]) + (v0[2] * v0[2] + v0[3] * v0[3]) + (v1[0] * v1[0] + v1[1] * v1[1]) + (v1[2] * v1[2] + v1[3] * v1[3]); } }
                if (!xout) { part += __shfl_xor(part, 16); part += __shfl_xor(part, 32); if (fq == 0) atomicAdd(ssn + row, part); }
                asm volatile("" ::: "memory"); }
    }
};

template <class Epi>
__device__ __forceinline__ void gemm_phase(LAS unsigned char* lds, const Gemm g, const StaticOrder& S, const Epi& E, const int tid) {
    const int wid = __builtin_amdgcn_readfirstlane(tid >> 6), lane = tid & 63, wr = wid >> 2, wc = wid & 3, fr = lane & 15, fq = lane >> 4;
    const int K = g.K, nt = K / BK;
    unsigned voffA[2], voffB[2];
#pragma unroll
    for (int i = 0; i < 2; ++i) { int R, C; stage_rc(tid * 16 + i * 8192, R, C); const int Rb = (R & ~31) + perm32(R & 31);
        voffA[i] = (unsigned)(R * K + C) * 2u; voffB[i] = (unsigned)(Rb * K + C) * 2u; }
    const size_t kstep = (size_t)(BK * 2);
    const size_t hstep = (size_t)HALF * K * 2;
    const size_t tstep = 2 * hstep;
    const unsigned ldsw = (unsigned)wid * 1024u;
    const int aoff = lds_byte(wr * 64 + fr, fq * 8), boff = lds_byte(wc * 32 + fr, fq * 8);
#define PG8_SA(b, h) (((b) * 2 + (h)) * HTB)
#define PG8_SB(b, h) ((4 + (b) * 2 + (h)) * HTB)
#define PG8_STAGE(bufoff, gbase, voff) do { _Pragma("unroll") for (int _i = 0; _i < 2; ++_i) \
        __builtin_amdgcn_global_load_lds((const unsigned*)((const char*)(gbase) + (voff)[_i]), (LAS unsigned*)(lds + (bufoff) + ldsw + _i * 8192), 16, 0, 0); } while (0)
#define PG8_LDA(dst, b, h) do { _Pragma("unroll") for (int m = 0; m < 4; ++m) _Pragma("unroll") for (int k = 0; k < 2; ++k) dst[m][k] = *(const LAS bf16x8*)(lds + PG8_SA(b, h) + aoff + m * 2048 + k * 1024); } while (0)
#define PG8_LDB(dst, b, h) do { _Pragma("unroll") for (int n = 0; n < 2; ++n) _Pragma("unroll") for (int k = 0; k < 2; ++k) dst[n][k] = *(const LAS bf16x8*)(lds + PG8_SB(b, h) + boff + n * 2048 + k * 1024); } while (0)
#define PG8_MMA(ai, bj, At, Bt) do { __builtin_amdgcn_s_setprio(1); _Pragma("unroll") for (int m = 0; m < 4; ++m) _Pragma("unroll") for (int n = 0; n < 2; ++n) _Pragma("unroll") for (int k = 0; k < 2; ++k) \
        acc[ai][bj][m][n] = __builtin_amdgcn_mfma_f32_16x16x32_bf16(Bt[n][k], At[m][k], acc[ai][bj][m][n], 0, 0, 0); __builtin_amdgcn_s_setprio(0); } while (0)
#define PG8_WAIT_V(n) asm volatile("s_waitcnt vmcnt(" #n ")" ::: "memory")
#define PG8_WAIT_L(n) asm volatile("s_waitcnt lgkmcnt(" #n ")" ::: "memory")
#define PG8_BAR __builtin_amdgcn_s_barrier()
#define PG8_SCHED __builtin_amdgcn_sched_barrier(0)
    Unit cur, nxt; int ui = 0;
    if (!S.next(0, cur)) return;
    f32x4 acc[2][2][4][2];
#pragma unroll
    for (int a = 0; a < 2; ++a)
#pragma unroll
        for (int b = 0; b < 2; ++b)
#pragma unroll
            for (int m = 0; m < 4; ++m)
#pragma unroll
                for (int n = 0; n < 2; ++n) acc[a][b][m][n] = (f32x4){0.f, 0.f, 0.f, 0.f};
    bf16x8 At[4][2], B0[2][2], B1[2][2];
    const char* cA = (const char*)g.A + (size_t)cur.pm * tstep; const char* cB = (const char*)g.Bt + (size_t)cur.pn * tstep;
    PG8_STAGE(PG8_SB(0, 0), cB, voffB); PG8_STAGE(PG8_SA(0, 0), cA, voffA); PG8_STAGE(PG8_SB(0, 1), cB + hstep, voffB); PG8_STAGE(PG8_SA(0, 1), cA + hstep, voffA);
    if (wr == 1) PG8_BAR;
    PG8_WAIT_V(4); PG8_BAR;
    PG8_STAGE(PG8_SB(1, 0), cB + kstep, voffB); PG8_STAGE(PG8_SA(1, 0), cA + kstep, voffA); PG8_STAGE(PG8_SB(1, 1), cB + hstep + kstep, voffB);
    PG8_WAIT_V(6); PG8_BAR;
    for (;;) {
        const bool has_next = S.next(ui + 1, nxt);
        const char* nA = has_next ? (const char*)g.A + (size_t)nxt.pm * tstep : cA; const char* nB = has_next ? (const char*)g.Bt + (size_t)nxt.pn * tstep : cB;
        for (int t = 0; t < nt; t += 2) {
            const bool last = (t == nt - 2);
            const char* a1 = cA + (size_t)(t + 1) * kstep;
            const char* a2 = last ? nA : cA + (size_t)(t + 2) * kstep; const char* b2 = last ? nB : cB + (size_t)(t + 2) * kstep;
            const char* a3 = a2 + kstep; const char* b3 = b2 + kstep;
            PG8_LDB(B0, 0, 0); PG8_SCHED; PG8_LDA(At, 0, 0); PG8_STAGE(PG8_SA(1, 1), a1 + hstep, voffA);
            PG8_WAIT_L(8); PG8_BAR; PG8_WAIT_L(0); PG8_MMA(0, 0, At, B0); PG8_BAR; PG8_SCHED;
            PG8_LDB(B1, 0, 1); PG8_STAGE(PG8_SB(0, 0), b2, voffB);
            PG8_BAR; PG8_WAIT_L(0); PG8_MMA(0, 1, At, B1); PG8_BAR;
            PG8_LDA(At, 0, 1); PG8_STAGE(PG8_SA(0, 0), a2, voffA);
            PG8_BAR; PG8_WAIT_L(0); PG8_MMA(1, 0, At, B0); PG8_BAR; PG8_SCHED;
            PG8_STAGE(PG8_SB(0, 1), b2 + hstep, voffB);
            PG8_WAIT_V(6); PG8_BAR; PG8_MMA(1, 1, At, B1); PG8_BAR;
            PG8_LDB(B0, 1, 0); PG8_SCHED; PG8_LDA(At, 1, 0); PG8_STAGE(PG8_SA(0, 1), a2 + hstep, voffA);
            PG8_WAIT_L(8); PG8_BAR; PG8_WAIT_L(0); PG8_MMA(0, 0, At, B0); PG8_BAR; PG8_SCHED;
            PG8_LDB(B1, 1, 1); PG8_STAGE(PG8_SB(1, 0), b3, voffB);
            PG8_BAR; PG8_WAIT_L(0); PG8_MMA(0, 1, At, B1); PG8_BAR;
            PG8_LDA(At, 1, 1); PG8_STAGE(PG8_SA(1, 0), a3, voffA);
            PG8_BAR; PG8_WAIT_L(0); PG8_MMA(1, 0, At, B0); PG8_BAR; PG8_SCHED;
            PG8_STAGE(PG8_SB(1, 1), b3 + hstep, voffB);
            PG8_WAIT_V(6); PG8_BAR; PG8_MMA(1, 1, At, B1); PG8_BAR;
        }
        E(acc, cur, wr, wc, fr, fq, ui);
        if (!has_next) break;
#pragma unroll
        for (int a = 0; a < 2; ++a)
#pragma unroll
            for (int b = 0; b < 2; ++b)
#pragma unroll
                for (int m = 0; m < 4; ++m)
#pragma unroll
                    for (int n = 0; n < 2; ++n) acc[a][b][m][n] = (f32x4){0.f, 0.f, 0.f, 0.f};
        cur = nxt; cA = nA; cB = nB; ++ui;
    }
    PG8_WAIT_V(0);
    if (wr == 0) PG8_BAR;
    PG8_BAR;
#undef PG8_SA
#undef PG8_SB
#undef PG8_STAGE
#undef PG8_LDA
#undef PG8_LDB
#undef PG8_MMA
#undef PG8_WAIT_V
#undef PG8_WAIT_L
#undef PG8_BAR
#undef PG8_SCHED
}
}

#define XB_TMO      128
#define XB_XCNT(j)  (256  + 64 * (j))
#define XB_XSUB(j)  (1280 + 64 * (j))
#define XB_XGEN(j)  (2304 + 64 * (j))
#define XB_TOP      3328
#define XB_TOPGEN   3392
#define XCD_BAR_WORDS 3456
#define XB_SPIN_CAP (1u << 18)

__device__ __forceinline__ unsigned xb_ld(unsigned* p)              { return __hip_atomic_load(p, __ATOMIC_RELAXED, __HIP_MEMORY_SCOPE_AGENT); }
__device__ __forceinline__ unsigned xb_add(unsigned* p, unsigned v) { return __hip_atomic_fetch_add(p, v, __ATOMIC_RELAXED, __HIP_MEMORY_SCOPE_AGENT); }
__device__ __forceinline__ unsigned xb_xcc_id() { return (unsigned)__builtin_amdgcn_s_getreg((3 << 11) | 20) & 0xFu; }
#define XB_SPIN(cond, bar) do { unsigned _sp = 0; while (cond) { __builtin_amdgcn_s_sleep(1); \
    if ((++_sp & 255u) == 0u) { if (xb_ld(&(bar)[XB_TMO])) break; if (_sp > XB_SPIN_CAP) { atomicAdd(&(bar)[XB_TMO], 1u); break; } } } } while (0)

struct XcdBarrier {
    unsigned* bar; unsigned x;
    volatile LAS unsigned* st;
};

__device__ __forceinline__ XcdBarrier xcd_barrier_post(unsigned* bar, volatile LAS unsigned* st) {
    XcdBarrier b; b.bar = bar; b.x = xb_xcc_id(); b.st = st;
    if (threadIdx.x == 0) (void)xb_add(&bar[XB_XCNT(b.x)], 1u);
    return b;
}
__device__ __forceinline__ void xcd_barrier_complete(unsigned* bar, unsigned x, unsigned& nloc, unsigned& nx) {
    const unsigned G = gridDim.x * gridDim.y * gridDim.z;
    unsigned sum, cnt, mine, sp = 0u;
    for (;;) {
        sum = 0u; cnt = 0u; mine = 0u;
#pragma unroll
        for (unsigned j = 0; j < 16; ++j) { const unsigned c = xb_ld(&bar[XB_XCNT(j)]); sum += c; cnt += (c > 0u) ? 1u : 0u; mine = (j == x) ? c : mine; }
        if (sum == G) break;
        __builtin_amdgcn_s_sleep(1);
        if ((++sp & 255u) == 0u) { if (xb_ld(&bar[XB_TMO])) break; if (sp > XB_SPIN_CAP) { atomicAdd(&bar[XB_TMO], 1u); break; } }
    }
    nloc = mine > 0u ? mine : 1u; nx = cnt > 0u ? cnt : 1u;
}

__device__ __forceinline__ void xcd_barrier(const XcdBarrier& b) {
    asm volatile("s_waitcnt vmcnt(0)" ::: "memory");
    __syncthreads();
    if (threadIdx.x == 0) {
        unsigned* bar = b.bar;
        __builtin_amdgcn_s_waitcnt(0);
        unsigned nloc = b.st[0], nx = b.st[1];
        if (nloc == 0u) { xcd_barrier_complete(bar, b.x, nloc, nx); b.st[0] = nloc; b.st[1] = nx; }
        const unsigned old = xb_add(&bar[XB_XSUB(b.x)], 1u);
        const unsigned gen = old / nloc;
        if (old + 1u == (gen + 1u) * nloc) {
            __builtin_amdgcn_fence(__ATOMIC_RELEASE, "agent");
            asm volatile("s_waitcnt vmcnt(0)" ::: "memory");
            const unsigned og = xb_add(&bar[XB_TOP], 1u);
            const unsigned tg = og / nx;
            if (og + 1u == (tg + 1u) * nx) xb_add(&bar[XB_TOPGEN], 1u);
            else XB_SPIN(xb_ld(&bar[XB_TOPGEN]) == tg, bar);
            __builtin_amdgcn_fence(__ATOMIC_ACQUIRE, "agent");
            xb_add(&bar[XB_XGEN(b.x)], 1u);
            asm volatile("s_waitcnt vmcnt(0)" ::: "memory");
        } else {
            XB_SPIN(xb_ld(&bar[XB_XGEN(b.x)]) == gen, bar);
            __builtin_amdgcn_fence(__ATOMIC_ACQUIRE, "agent");
            asm volatile("s_waitcnt vmcnt(0)" ::: "memory");
        }
    }
    __syncthreads();
}

struct Params {
    const float* in[23];
    float* out;
    unsigned char* ws;
    int ph_lo, ph_hi;
};

struct Ctx {
    const float* const* in; float* out; unsigned char* ws; LAS unsigned char* lds;
    int tid, lane, wid, G, bid;
};
__device__ __forceinline__ int fresh_tid(int wid) { unsigned z = 0u; asm volatile("" : "+v"(z)); return wid * 64 + (int)__builtin_amdgcn_mbcnt_hi(~0u, __builtin_amdgcn_mbcnt_lo(~0u, z)); }
__device__ __forceinline__ Ctx launder(const Ctx& C0) { Ctx C = C0;
    int w = C0.wid, g = C0.G, b = C0.bid; asm volatile("" : "+s"(w), "+s"(g), "+s"(b));
    unsigned z = 0u; asm volatile("" : "+v"(z));
    int t = w * 64 + (int)__builtin_amdgcn_mbcnt_hi(~0u, __builtin_amdgcn_mbcnt_lo(~0u, z));
    asm volatile("" : "+v"(t)); C.tid = t; C.lane = t & 63; C.wid = w; C.G = g; C.bid = b; return C; }

__device__ __forceinline__ int perm_a(int n) { if (n >= 4096) return n; const int part = n >> 10, j = n & 1023; return (part >> 1) * 2048 + (j >> 7) * 256 + (part & 1) * 128 + (j & 127); }
__device__ __forceinline__ void p0_transpose_item(const float* W, int K, int N, bf16_t* WT, int row_off, const float* gain, LAS float* scr, int item, int lane, bool pa = false) {
    const int nblk = N / 32, kb = item / nblk, nb = item % nblk, k0 = 64 * kb, n0 = 32 * nb;
    if (pa) row_off = perm_a(n0) - n0;
    float wv[32];
#pragma unroll
    for (int i = 0; i < 32; ++i) wv[i] = __builtin_nontemporal_load(W + (size_t)(k0 + 2 * i + (lane >> 5)) * N + n0 + (lane & 31));
    const float gl = gain ? gain[k0 + lane] : 1.0f;
#pragma unroll
    for (int i = 0; i < 32; ++i) { const int kk = 2 * i + (lane >> 5); const float gv = __shfl(gl, kk); scr[kk * 33 + (lane & 31)] = wv[i] * gv; }
    asm volatile("s_waitcnt lgkmcnt(0)" ::: "memory");
    const int c = lane & 7;
#pragma unroll
    for (int j = 0; j < 4; ++j) { const int n = (lane >> 3) + 8 * j; const LAS float* s = scr + (8 * c) * 33 + n;
        u32x4 o; o.x = pk2(s[0 * 33], s[1 * 33]); o.y = pk2(s[2 * 33], s[3 * 33]); o.z = pk2(s[4 * 33], s[5 * 33]); o.w = pk2(s[6 * 33], s[7 * 33]);
        *(u32x4*)(WT + (size_t)(row_off + n0 + n) * K + k0 + 8 * c) = o; }
    asm volatile("s_waitcnt lgkmcnt(0)" ::: "memory");
}
__device__ __forceinline__ void row_cvt_ss(const float* xrow, bf16_t* orow, float* ssp, int lane) {
    const f32x4* xr = (const f32x4*)xrow + lane; f32x4 v[4]; float s = 0.f;
#pragma unroll
    for (int j = 0; j < 4; ++j) { v[j] = xr[64 * j]; s += (v[j].x * v[j].x + v[j].y * v[j].y) + (v[j].z * v[j].z + v[j].w * v[j].w); }
    s = wave_sum(s);
    u32x2* o8 = (u32x2*)orow + lane;
#pragma unroll
    for (int j = 0; j < 4; ++j) { u32x2 w; w.x = pk2(v[j].x, v[j].y); w.y = pk2(v[j].z, v[j].w); o8[64 * j] = w; }
    if (lane == 0) *ssp = s;
}
__device__ __forceinline__ void p0_prologue(const Ctx& C) {
    LAS float* scr = (LAS float*)(C.lds + C.wid * 16384);
    const int gw = C.bid * 8 + C.wid, NGW = C.G * 8;
    bf16_t* Wmem = (bf16_t*)(C.ws + WS_WMEM); bf16_t* Wina = (bf16_t*)(C.ws + WS_WINA); bf16_t* Wouta = (bf16_t*)(C.ws + WS_WOUTA);
    bf16_t* Wkvb = (bf16_t*)(C.ws + WS_WKVB); bf16_t* Winb1 = (bf16_t*)(C.ws + WS_WINB1); bf16_t* Woutb = (bf16_t*)(C.ws + WS_WOUTB);
    constexpr int I_MEM = 16 * 32, I_INA = 16 * 160, I_OUTA = 24 * 32, I_KV = 16 * 96, I_INB = 16 * 96, I_OUTB = 16 * 32;
    constexpr int NITEMS = 4 * I_MEM + 2 * I_INA + 2 * I_OUTA + I_KV + 2 * I_INB + 2 * I_OUTB;
    for (int it = gw; it < NITEMS; it += NGW) {
        int r = it;
        if (r < 4 * I_MEM) { const int l = r / I_MEM; p0_transpose_item(C.in[20] + (size_t)l * D * 1024, D, 1024, Wmem, l * 1024, C.in[19] + l * D, scr, r % I_MEM, C.lane); continue; } r -= 4 * I_MEM;
        if (r < 2 * I_INA) { const int a = r / I_INA; p0_transpose_item(C.in[9] + (size_t)a * D * NINA, D, NINA, Wina + (size_t)a * NINA * D, 0, C.in[8] + a * D, scr, r % I_INA, C.lane, true); continue; } r -= 2 * I_INA;
        if (r < 2 * I_OUTA) { const int a = r / I_OUTA; p0_transpose_item(C.in[11] + (size_t)a * KOUTA * D, KOUTA, D, Wouta + (size_t)a * D * KOUTA, 0, nullptr, scr, r % I_OUTA, C.lane); continue; } r -= 2 * I_OUTA;
        if (r < I_KV) { p0_transpose_item(C.in[17], D, 3072, Wkvb, 0, C.in[16], scr, r, C.lane); continue; } r -= I_KV;
        if (r < 2 * I_INB) { const int bl = r / I_INB; p0_transpose_item(C.in[13] + (size_t)bl * D * NINB, D, NINB, bl ? Winb1 : Wkvb, bl ? 0 : 3072, C.in[12] + bl * D, scr, r % I_INB, C.lane); continue; } r -= 2 * I_INB;
        { const int bl = r / I_OUTB; p0_transpose_item(C.in[15] + (size_t)bl * KOUTB * D, KOUTB, D, Woutb + (size_t)bl * D * KOUTB, 0, nullptr, scr, r % I_OUTB, C.lane); }
    }
    bf16_t* XB = (bf16_t*)(C.ws + WS_XB); bf16_t* MEMN = (bf16_t*)(C.ws + WS_MEMN); float* SS = (float*)(C.ws + WS_SS);
    for (int m = 2 * gw; m < MR + 2048; m += 2 * NGW) {
        const float* src; bf16_t* dst; float* ssp;
        if (m < MP) { src = C.in[0] + (size_t)m * D; dst = XB + (size_t)m * D; ssp = SS + m; }
        else if (m < MR) { src = C.in[1] + (size_t)(m - MP) * D; dst = XB + (size_t)m * D; ssp = SS + m; }
        else { src = C.in[7] + (size_t)(m - MR) * D; dst = MEMN + (size_t)(m - MR) * D; ssp = SS + 4 * SS_STRIDE + (m - MR); }
        const f32x4* xr = (const f32x4*)src + C.lane; f32x4 v[8]; float s0 = 0.f, s1 = 0.f;
#pragma unroll
        for (int j = 0; j < 8; ++j) v[j] = __builtin_nontemporal_load(xr + 64 * j);
#pragma unroll
        for (int j = 0; j < 4; ++j) { s0 += (v[j].x * v[j].x + v[j].y * v[j].y) + (v[j].z * v[j].z + v[j].w * v[j].w); s1 += (v[4 + j].x * v[4 + j].x + v[4 + j].y * v[4 + j].y) + (v[4 + j].z * v[4 + j].z + v[4 + j].w * v[4 + j].w); }
        s0 = wave_sum(s0); s1 = wave_sum(s1);
        u32x2* o8 = (u32x2*)dst + C.lane;
#pragma unroll
        for (int j = 0; j < 8; ++j) { u32x2 w; w.x = pk2(v[j].x, v[j].y); w.y = pk2(v[j].z, v[j].w); o8[64 * j] = w; }
        if (C.lane == 0) { ssp[0] = s0; ssp[1] = s1; }
    }
    for (int i = C.bid * 512 + C.tid; i < 3 * SS_STRIDE; i += C.G * 512) SS[SS_STRIDE + i] = 0.f;
}

template <class F>
__device__ __forceinline__ void sgemm_tile(const Ctx& C, const bf16_t* A, int lda, const bf16_t* Bt, int K, int tile, float* ssrow, F epi) {
    LAS float* red = (LAS float*)C.lds;
    int lane = C.lane; asm volatile("" : "+v"(lane));
    const int r = lane & 31, h = lane >> 5, kc = K / 8, k0 = C.wid * kc, nst = kc / 16;
    f32x16 acc; for (int i = 0; i < 16; ++i) acc[i] = 0.f;
    const bf16_t* ap = A + (size_t)r * lda + k0 + 8 * h;
    const bf16_t* bp = Bt + (size_t)(tile * 32 + r) * K + k0 + 8 * h;
    bf16x8 av[12], bv[12];
#pragma unroll
    for (int s = 0; s < 12; ++s) if (s < nst) { av[s] = *(const bf16x8*)(ap + 16 * s); bv[s] = *(const bf16x8*)(bp + 16 * s); }
#pragma unroll
    for (int s = 0; s < 12; ++s) if (s < nst) acc = __builtin_amdgcn_mfma_f32_32x32x16_bf16(av[s], bv[s], acc, 0, 0, 0);
#pragma unroll
    for (int i = 0; i < 16; ++i) { const int row = (i & 3) + 8 * (i >> 2) + 4 * h; red[(C.wid * 32 + row) * 32 + r] = acc[i]; }
    __syncthreads();
#pragma unroll
    for (int rep = 0; rep < 2; ++rep) { const int idx = C.tid + 512 * rep; float v = 0.f;
#pragma unroll
        for (int w = 0; w < 8; ++w) v += red[w * 1024 + idx];
        float sq = epi(idx >> 5, tile * 32 + (idx & 31), v);
        if (ssrow) { sq += __shfl_xor(sq, 16); sq += __shfl_xor(sq, 8); sq += __shfl_xor(sq, 4); sq += __shfl_xor(sq, 2); sq += __shfl_xor(sq, 1);
            if ((lane & 31) == 0) atomicAdd(ssrow + (idx >> 5), sq); } }
    __syncthreads();
}

__device__ __forceinline__ unsigned off_b(unsigned row, unsigned ch) { return 256u * row + 16u * (ch ^ (((row & 3) << 2) | ((row >> 2) & 3))); }
struct AttnP {
    const bf16_t* q; int ldq, qrow0, qrstep;
    const bf16_t* k; const bf16_t* v; int ldk, krow0, krstep;
    const float* gq; const float* gk;
    int mode;
    float* kvout; int kv_jfrom; size_t kv_ostride;
    bf16_t* o; int ldo;
    const bf16_t* gate;
    float* lse;
    const bf16_t* cdil; const float* clse;
};
struct NextKV { const bf16_t* k; int ldk, krow0, krstep, it0, valid; };
__device__ __forceinline__ void attn_item(const Ctx& C, const AttnP& P, u32x4 (&kw)[8], u32x4 (&vw)[8], const bool have, const NextKV& nx) {
    const int tid = fresh_tid(C.wid);
    const int lane = tid & 63, wid = C.wid, r = lane & 31, h = lane >> 5, qb = wid & 3, kh = wid >> 2;
    LAS unsigned char* Kl = C.lds; LAS unsigned char* Vl = C.lds + 65536;
    bf16x8 qf[8];
    const int qrow = P.qrow0 + (32 * qb + r) * P.qrstep;
    {
        const int c = tid & 15, kr = tid >> 4, it0 = (P.mode == 2 ? 4 : 0);
        const bf16_t* qp = P.q + (size_t)qrow * P.ldq + 8 * h;
        u32x4 raw[8];
#pragma unroll
        for (int s = 0; s < 8; ++s) raw[s] = *(const u32x4*)(qp + 16 * s);
        if (!have) {
#pragma unroll
            for (int it = 0; it < 8; ++it) if (it >= it0) { const size_t row = (size_t)(P.krow0 + (kr + 32 * it) * P.krstep);
                kw[it] = *(const u32x4*)(P.k + row * P.ldk + 8 * c); vw[it] = *(const u32x4*)(P.v + row * P.ldk + 8 * c); } }
        float ss = 0.f;
#pragma unroll
        for (int s = 0; s < 8; ++s)
#pragma unroll
            for (int j = 0; j < 4; ++j) { const float a = bflo(raw[s][j]), b = bfhi(raw[s][j]); ss += a * a + b * b; }
        ss += __shfl_xor(ss, 32);
        const float rs = rsqrtf(ss * (1.0f / 128.0f) + EPS) * QSCALE;
#pragma unroll
        for (int s = 0; s < 8; ++s) {
            u32x4 w; w.x = pk2(bflo(raw[s][0]) * rs, bfhi(raw[s][0]) * rs); w.y = pk2(bflo(raw[s][1]) * rs, bfhi(raw[s][1]) * rs);
            w.z = pk2(bflo(raw[s][2]) * rs, bfhi(raw[s][2]) * rs); w.w = pk2(bflo(raw[s][3]) * rs, bfhi(raw[s][3]) * rs);
            qf[s] = __builtin_bit_cast(bf16x8, w); }
        const f32x4 gk0 = *(const f32x4*)(P.gk + 8 * c), gk1 = *(const f32x4*)(P.gk + 8 * c + 4);
        const f32x4 gq0 = *(const f32x4*)(P.gq + 8 * c), gq1 = *(const f32x4*)(P.gq + 8 * c + 4);
#pragma unroll
        for (int it = 0; it < 8; ++it) if (it >= it0) {
            const int j = kr + 32 * it;
            f32x4 k0 = {bflo(kw[it].x), bfhi(kw[it].x), bflo(kw[it].y), bfhi(kw[it].y)}, k1 = {bflo(kw[it].z), bfhi(kw[it].z), bflo(kw[it].w), bfhi(kw[it].w)};
            float s2 = (k0[0] * k0[0] + k0[1] * k0[1]) + (k0[2] * k0[2] + k0[3] * k0[3]) + (k1[0] * k1[0] + k1[1] * k1[1]) + (k1[2] * k1[2] + k1[3] * k1[3]);
            s2 = row16_sum(s2);
            const float rk = rsqrtf(s2 * (1.0f / 128.0f) + EPS);
            k0 = k0 * rk * gk0; k1 = k1 * rk * gk1;
            const f32x4 kq0 = k0 * gq0, kq1 = k1 * gq1;
            u32x4 w; w.x = pk2(kq0[0], kq0[1]); w.y = pk2(kq0[2], kq0[3]); w.z = pk2(kq1[0], kq1[1]); w.w = pk2(kq1[2], kq1[3]);
            *(LAS u32x4*)(Kl + off_b(j, c)) = w; *(LAS u32x4*)(Vl + off_b(j, c)) = vw[it];
            if (j >= P.kv_jfrom) { float* o = P.kvout + (size_t)(j - P.kv_jfrom) * P.kv_ostride + 8 * c;
                __builtin_nontemporal_store(k0, (f32x4*)o); __builtin_nontemporal_store(k1, (f32x4*)(o + 4));
                __builtin_nontemporal_store((f32x4){bflo(vw[it].x), bfhi(vw[it].x), bflo(vw[it].y), bfhi(vw[it].y)}, (f32x4*)(o + 512)); __builtin_nontemporal_store((f32x4){bflo(vw[it].z), bfhi(vw[it].z), bflo(vw[it].w), bfhi(vw[it].w)}, (f32x4*)(o + 516)); }
        }
    }
    __syncthreads();
    f32x16 o[4]; float mrow = -1e30f, lrow = 0.f;
    const bool active = !(P.mode == 2 && kh == 0);
    u32x4 pb[4][2];
    if (active) {
        {
            f32x16 sacc[4];
            const unsigned xr = ((r & 3) << 2) | ((r >> 2) & 3);
            unsigned kaddr[8];
#pragma unroll
            for (int s = 0; s < 8; ++s) kaddr[s] = 256u * (128 * kh + r) + 16u * ((unsigned)(2 * s + h) ^ xr);
#pragma unroll
            for (int kt = 0; kt < 4; ++kt) { for (int i = 0; i < 16; ++i) sacc[kt][i] = -1e30f;
                if (P.mode == 0 || (kh ? kt <= qb : kt >= qb)) {
                    for (int i = 0; i < 16; ++i) sacc[kt][i] = 0.f;
#pragma unroll
                    for (int s = 0; s < 8; ++s) { const bf16x8 a = *(const LAS bf16x8*)(Kl + kaddr[s] + 8192 * kt); sacc[kt] = __builtin_amdgcn_mfma_f32_32x32x16_bf16(a, qf[s], sacc[kt], 0, 0, 0); } }
                asm volatile("" ::: "memory"); }
            const int qi = 32 * qb + r;
            if (P.mode != 0) {
#pragma unroll
                for (int kt = 0; kt < 4; ++kt)
#pragma unroll
                    for (int i = 0; i < 16; ++i) { const int kj = 32 * kt + (i & 3) + 8 * (i >> 2) + 4 * h; const bool valid = kh ? (kj <= qi) : (kj >= qi); sacc[kt][i] = valid ? sacc[kt][i] : -1e30f; }
            }
            float m = -1e30f;
#pragma unroll
            for (int kt = 0; kt < 4; ++kt)
#pragma unroll
                for (int i = 0; i < 16; ++i) m = fmaxf(m, sacc[kt][i]);
            m = fmaxf(m, __shfl_xor(m, 32));
            float l = 0.f;
#pragma unroll
            for (int kt = 0; kt < 4; ++kt)
#pragma unroll
                for (int s2 = 0; s2 < 2; ++s2) {
                    float pv[8];
#pragma unroll
                    for (int j = 0; j < 8; ++j) { pv[j] = __builtin_amdgcn_exp2f(sacc[kt][8 * s2 + j] - m); l += pv[j]; }
                    pb[kt][s2].x = pk2(pv[0], pv[1]); pb[kt][s2].y = pk2(pv[2], pv[3]); pb[kt][s2].z = pk2(pv[4], pv[5]); pb[kt][s2].w = pk2(pv[6], pv[7]);
                }
            l += __shfl_xor(l, 32);
            mrow = m; lrow = l;
        }
    }
    if (nx.valid) {
        const int c = tid & 15, kr = tid >> 4;
#pragma unroll
        for (int it = 0; it < 8; ++it) if (it >= nx.it0) { const size_t row = (size_t)(nx.krow0 + (kr + 32 * it) * nx.krstep);
            kw[it] = *(const u32x4*)(nx.k + row * nx.ldk + 8 * c); vw[it] = *(const u32x4*)(nx.k + 512 + row * nx.ldk + 8 * c); }
    }
#pragma unroll
    for (int et = 0; et < 4; ++et) for (int i = 0; i < 16; ++i) o[et][i] = 0.f;
    if (active) {
        const int q4 = (lane & 15) >> 2, p4 = lane & 3, blk = (lane >> 4) & 1, clow = 2 * blk + (p4 >> 1);
        unsigned vaddr[4][2];
#pragma unroll
        for (int et = 0; et < 4; ++et)
#pragma unroll
            for (int hi = 0; hi < 2; ++hi) vaddr[et][hi] = 256u * (128 * kh + 4 * h + q4 + 8 * hi) + 64u * (unsigned)(et ^ q4) + 16u * (unsigned)(clow ^ (h + 2 * hi)) + 8u * (p4 & 1);
#pragma unroll
        for (int kt = 0; kt < 4; ++kt)
#pragma unroll
            for (int s2 = 0; s2 < 2; ++s2) if (P.mode == 0 || (kh ? kt <= qb : kt >= qb)) {
                const bf16x8 pbv = __builtin_bit_cast(bf16x8, pb[kt][s2]);
#pragma unroll
                for (int et = 0; et < 4; ++et) {
                    const s16x4 lo = __builtin_amdgcn_ds_read_tr16_b64_v4i16((LAS s16x4*)(Vl + vaddr[et][0] + 8192 * kt + 4096 * s2));
                    const s16x4 hi = __builtin_amdgcn_ds_read_tr16_b64_v4i16((LAS s16x4*)(Vl + vaddr[et][1] + 8192 * kt + 4096 * s2));
                    const bf16x8 va = __builtin_shufflevector(lo, hi, 0, 1, 2, 3, 4, 5, 6, 7);
                    o[et] = __builtin_amdgcn_mfma_f32_32x32x16_bf16(va, pbv, o[et], 0, 0, 0);
                }
                asm volatile("" ::: "memory");
            }
    }
    __syncthreads();
    LAS float* Mo = (LAS float*)C.lds;
    LAS float* Mml = (LAS float*)(C.lds + 65536);
    if (kh == 1) {
#pragma unroll
        for (int et = 0; et < 4; ++et)
#pragma unroll
            for (int i = 0; i < 16; ++i) { const int e = 32 * et + (i & 3) + 8 * (i >> 2) + 4 * h; Mo[(qb * 128 + e) * 32 + r] = o[et][i]; }
        if (h == 0) { Mml[(qb * 2 + 0) * 32 + r] = mrow; Mml[(qb * 2 + 1) * 32 + r] = lrow; }
    }
    __syncthreads();
    LAS unsigned char* Ot = C.lds + 65536 + 2048;
    if (kh == 0) {
        const float m1 = Mml[(qb * 2 + 0) * 32 + r], l1 = Mml[(qb * 2 + 1) * 32 + r];
        const float m = fmaxf(mrow, m1), w0 = __builtin_amdgcn_exp2f(mrow - m), w1 = __builtin_amdgcn_exp2f(m1 - m), l = lrow * w0 + l1 * w1, inv = 1.0f / l;
        const float a0 = w0 * inv, a1 = w1 * inv;
#pragma unroll
        for (int et = 0; et < 4; ++et)
#pragma unroll
            for (int g4 = 0; g4 < 4; ++g4) {
                const int e0 = 32 * et + 8 * g4 + 4 * h;
                float v[4];
#pragma unroll
                for (int j = 0; j < 4; ++j) v[j] = o[et][4 * g4 + j] * a0 + Mo[(qb * 128 + e0 + j) * 32 + r] * a1;
                u32x2 w; w.x = pk2(v[0], v[1]); w.y = pk2(v[2], v[3]);
                *(LAS u32x2*)(Ot + (32 * qb + r) * 272 + 2 * e0) = w;
            }
        if (P.mode != 0 && h == 0) P.lse[(size_t)qrow * 4] = m + log2f(l);
    }
    __syncthreads();
#pragma unroll
    for (int i = 0; i < 4; ++i) { const int id = tid + 512 * i, qi = id >> 4, c = id & 15; const size_t grow = (size_t)(P.qrow0 + qi * P.qrstep);
        u32x4 w = *(const LAS u32x4*)(Ot + qi * 272 + 16 * c);
        if (P.mode == 0) { const u32x4 gw = *(const u32x4*)(P.gate + grow * P.ldq + 8 * c);
#pragma unroll
            for (int j = 0; j < 4; ++j) w[j] = pk2(bflo(w[j]) * silu(bflo(gw[j])), bfhi(w[j]) * silu(bfhi(gw[j]))); }
        *(u32x4*)(P.o + grow * P.ldo + 8 * c) = w;
        if (P.cdil) {
            const float l0 = P.clse[grow * 4], l1 = P.clse[((size_t)MR + grow) * 4], l2 = P.clse[((size_t)2 * MR + grow) * 4];
            const float mm = fmaxf(l0, fmaxf(l1, l2)); float w0 = __builtin_amdgcn_exp2f(l0 - mm), w1 = __builtin_amdgcn_exp2f(l1 - mm), w2 = __builtin_amdgcn_exp2f(l2 - mm); const float inv = 1.0f / (w0 + w1 + w2);
            w0 *= inv; w1 *= inv; w2 *= inv;
            const u32x4 a = *(const u32x4*)(P.cdil + grow * 512 + 8 * c), b = *(const u32x4*)(P.cdil + ((size_t)MR + grow) * 512 + 8 * c),
                        cc = *(const u32x4*)(P.cdil + ((size_t)2 * MR + grow) * 512 + 8 * c), gd = *(const u32x4*)(P.gate - 1024 + grow * P.ldq + 8 * c);
            u32x4 wo;
#pragma unroll
            for (int j = 0; j < 4; ++j) wo[j] = pk2((bflo(a[j]) * w0 + bflo(b[j]) * w1 + bflo(cc[j]) * w2) * silu(bflo(gd[j])), (bfhi(a[j]) * w0 + bfhi(b[j]) * w1 + bfhi(cc[j]) * w2) * silu(bfhi(gd[j])));
            *(u32x4*)(P.o - 512 + grow * P.ldo + 8 * c) = wo; } }
    __syncthreads();
}

__device__ __forceinline__ void attn_item_wide(const Ctx& C, const AttnP& P, u32x4 (&kw)[8], u32x4 (&vw)[8], const bool have, const NextKV& nx) {
    const int tid = fresh_tid(C.wid);
    const int lane = tid & 63, wid = C.wid, r = lane & 31, h = lane >> 5;
    LAS unsigned char* Kl = C.lds; LAS unsigned char* Vl = C.lds + 65536;
    bf16x8 qf[8];
    const int qrow = P.qrow0 + 32 * wid + r;
    {
        const int c = tid & 15, kr = tid >> 4;
        const bf16_t* qp = P.q + (size_t)qrow * P.ldq + 8 * h;
        u32x4 raw[8];
#pragma unroll
        for (int s = 0; s < 8; ++s) raw[s] = *(const u32x4*)(qp + 16 * s);
        if (!have) {
#pragma unroll
            for (int it = 0; it < 8; ++it) { const size_t row = (size_t)(P.krow0 + (kr + 32 * it) * P.krstep);
                kw[it] = *(const u32x4*)(P.k + row * P.ldk + 8 * c); vw[it] = *(const u32x4*)(P.v + row * P.ldk + 8 * c); } }
        float ss = 0.f;
#pragma unroll
        for (int s = 0; s < 8; ++s)
#pragma unroll
            for (int j = 0; j < 4; ++j) { const float a = bflo(raw[s][j]), b = bfhi(raw[s][j]); ss += a * a + b * b; }
        ss += __shfl_xor(ss, 32);
        const float rs = rsqrtf(ss * (1.0f / 128.0f) + EPS) * QSCALE;
#pragma unroll
        for (int s = 0; s < 8; ++s) {
            u32x4 w; w.x = pk2(bflo(raw[s][0]) * rs, bfhi(raw[s][0]) * rs); w.y = pk2(bflo(raw[s][1]) * rs, bfhi(raw[s][1]) * rs);
            w.z = pk2(bflo(raw[s][2]) * rs, bfhi(raw[s][2]) * rs); w.w = pk2(bflo(raw[s][3]) * rs, bfhi(raw[s][3]) * rs);
            qf[s] = __builtin_bit_cast(bf16x8, w); }
        const f32x4 gk0 = *(const f32x4*)(P.gk + 8 * c), gk1 = *(const f32x4*)(P.gk + 8 * c + 4);
        const f32x4 gq0 = *(const f32x4*)(P.gq + 8 * c), gq1 = *(const f32x4*)(P.gq + 8 * c + 4);
#pragma unroll
        for (int it = 0; it < 8; ++it) {
            const int j = kr + 32 * it;
            f32x4 k0 = {bflo(kw[it].x), bfhi(kw[it].x), bflo(kw[it].y), bfhi(kw[it].y)}, k1 = {bflo(kw[it].z), bfhi(kw[it].z), bflo(kw[it].w), bfhi(kw[it].w)};
            float s2 = (k0[0] * k0[0] + k0[1] * k0[1]) + (k0[2] * k0[2] + k0[3] * k0[3]) + (k1[0] * k1[0] + k1[1] * k1[1]) + (k1[2] * k1[2] + k1[3] * k1[3]);
            s2 = row16_sum(s2);
            const float rk = rsqrtf(s2 * (1.0f / 128.0f) + EPS);
            k0 = k0 * rk * gk0; k1 = k1 * rk * gk1;
            const f32x4 kq0 = k0 * gq0, kq1 = k1 * gq1;
            u32x4 w; w.x = pk2(kq0[0], kq0[1]); w.y = pk2(kq0[2], kq0[3]); w.z = pk2(kq1[0], kq1[1]); w.w = pk2(kq1[2], kq1[3]);
            *(LAS u32x4*)(Kl + off_b(j, c)) = w; *(LAS u32x4*)(Vl + off_b(j, c)) = vw[it];
            if (j >= P.kv_jfrom) { float* o = P.kvout + (size_t)(j - P.kv_jfrom) * P.kv_ostride + 8 * c;
                __builtin_nontemporal_store(k0, (f32x4*)o); __builtin_nontemporal_store(k1, (f32x4*)(o + 4));
                __builtin_nontemporal_store((f32x4){bflo(vw[it].x), bfhi(vw[it].x), bflo(vw[it].y), bfhi(vw[it].y)}, (f32x4*)(o + 512)); __builtin_nontemporal_store((f32x4){bflo(vw[it].z), bfhi(vw[it].z), bflo(vw[it].w), bfhi(vw[it].w)}, (f32x4*)(o + 516)); }
        }
    }
    __syncthreads();
    f32x16 o[4]; float mrun = -1e30f, lrun = 0.f;
#pragma unroll
    for (int et = 0; et < 4; ++et) for (int i = 0; i < 16; ++i) o[et][i] = 0.f;
    const unsigned xr = ((r & 3) << 2) | ((r >> 2) & 3);
    const int q4 = (lane & 15) >> 2, p4 = lane & 3, blk = (lane >> 4) & 1, clow = 2 * blk + (p4 >> 1);
#pragma unroll
    for (int st = 0; st < 4; ++st) {
        u32x4 pb[2][2];
        {
            f32x16 sacc[2];
            unsigned kaddr[8];
#pragma unroll
            for (int s = 0; s < 8; ++s) kaddr[s] = 256u * (64 * st + r) + 16u * ((unsigned)(2 * s + h) ^ xr);
#pragma unroll
            for (int kt = 0; kt < 2; ++kt) { for (int i = 0; i < 16; ++i) sacc[kt][i] = 0.f;
#pragma unroll
                for (int s = 0; s < 8; ++s) { const bf16x8 a = *(const LAS bf16x8*)(Kl + kaddr[s] + 8192 * kt); sacc[kt] = __builtin_amdgcn_mfma_f32_32x32x16_bf16(a, qf[s], sacc[kt], 0, 0, 0); }
                asm volatile("" ::: "memory"); }
            float m = mrun;
#pragma unroll
            for (int kt = 0; kt < 2; ++kt)
#pragma unroll
                for (int i = 0; i < 16; ++i) m = fmaxf(m, sacc[kt][i]);
            m = fmaxf(m, __shfl_xor(m, 32));
            const float alpha = __builtin_amdgcn_exp2f(mrun - m);
            float l = 0.f;
#pragma unroll
            for (int kt = 0; kt < 2; ++kt)
#pragma unroll
                for (int s2 = 0; s2 < 2; ++s2) {
                    float pv[8];
#pragma unroll
                    for (int j = 0; j < 8; ++j) { pv[j] = __builtin_amdgcn_exp2f(sacc[kt][8 * s2 + j] - m); l += pv[j]; }
                    pb[kt][s2].x = pk2(pv[0], pv[1]); pb[kt][s2].y = pk2(pv[2], pv[3]); pb[kt][s2].z = pk2(pv[4], pv[5]); pb[kt][s2].w = pk2(pv[6], pv[7]);
                }
            l += __shfl_xor(l, 32);
            lrun = lrun * alpha + l; mrun = m;
#pragma unroll
            for (int et = 0; et < 4; ++et) o[et] = o[et] * alpha;
        }
        if (st == 3 && nx.valid) {
            const int c = tid & 15, kr = tid >> 4;
#pragma unroll
            for (int it = 0; it < 8; ++it) if (it >= nx.it0) { const size_t row = (size_t)(nx.krow0 + (kr + 32 * it) * nx.krstep);
                kw[it] = *(const u32x4*)(nx.k + row * nx.ldk + 8 * c); vw[it] = *(const u32x4*)(nx.k + 512 + row * nx.ldk + 8 * c); }
        }
        unsigned vaddr[4][2];
#pragma unroll
        for (int et = 0; et < 4; ++et)
#pragma unroll
            for (int hi = 0; hi < 2; ++hi) vaddr[et][hi] = 256u * (64 * st + 4 * h + q4 + 8 * hi) + 64u * (unsigned)(et ^ q4) + 16u * (unsigned)(clow ^ (h + 2 * hi)) + 8u * (p4 & 1);
#pragma unroll
        for (int kt = 0; kt < 2; ++kt)
#pragma unroll
            for (int s2 = 0; s2 < 2; ++s2) {
                const bf16x8 pbv = __builtin_bit_cast(bf16x8, pb[kt][s2]);
#pragma unroll
                for (int et = 0; et < 4; ++et) {
                    const s16x4 lo = __builtin_amdgcn_ds_read_tr16_b64_v4i16((LAS s16x4*)(Vl + vaddr[et][0] + 8192 * kt + 4096 * s2));
                    const s16x4 hi = __builtin_amdgcn_ds_read_tr16_b64_v4i16((LAS s16x4*)(Vl + vaddr[et][1] + 8192 * kt + 4096 * s2));
                    const bf16x8 va = __builtin_shufflevector(lo, hi, 0, 1, 2, 3, 4, 5, 6, 7);
                    o[et] = __builtin_amdgcn_mfma_f32_32x32x16_bf16(va, pbv, o[et], 0, 0, 0);
                }
                asm volatile("" ::: "memory");
            }
    }
    __syncthreads();
    LAS unsigned char* Ot = C.lds;
    {
        const float inv = 1.0f / lrun;
#pragma unroll
        for (int et = 0; et < 4; ++et)
#pragma unroll
            for (int g4 = 0; g4 < 4; ++g4) {
                const int e0 = 32 * et + 8 * g4 + 4 * h;
                u32x2 w; w.x = pk2(o[et][4 * g4 + 0] * inv, o[et][4 * g4 + 1] * inv); w.y = pk2(o[et][4 * g4 + 2] * inv, o[et][4 * g4 + 3] * inv);
                *(LAS u32x2*)(Ot + (32 * wid + r) * 272 + 2 * e0) = w;
            }
    }
    u32x4 gwv[8];
#pragma unroll
    for (int i = 0; i < 8; ++i) { const int id = tid + 512 * i, qi = id >> 4, c = id & 15; gwv[i] = *(const u32x4*)(P.gate + (size_t)(P.qrow0 + qi) * P.ldq + 8 * c); }
    __syncthreads();
#pragma unroll
    for (int i = 0; i < 8; ++i) { const int id = tid + 512 * i, qi = id >> 4, c = id & 15; const size_t grow = (size_t)(P.qrow0 + qi);
        u32x4 w = *(const LAS u32x4*)(Ot + qi * 272 + 16 * c);
        { const u32x4 gw = gwv[i];
#pragma unroll
            for (int j = 0; j < 4; ++j) w[j] = pk2(bflo(w[j]) * silu(bflo(gw[j])), bfhi(w[j]) * silu(bfhi(gw[j]))); }
        *(u32x4*)(P.o + grow * P.ldo + 8 * c) = w;
        if (P.cdil) {
            const float l0 = P.clse[grow * 4], l1 = P.clse[((size_t)MR + grow) * 4], l2 = P.clse[((size_t)2 * MR + grow) * 4];
            const float mm = fmaxf(l0, fmaxf(l1, l2)); float w0 = __builtin_amdgcn_exp2f(l0 - mm), w1 = __builtin_amdgcn_exp2f(l1 - mm), w2 = __builtin_amdgcn_exp2f(l2 - mm); const float inv = 1.0f / (w0 + w1 + w2);
            w0 *= inv; w1 *= inv; w2 *= inv;
            const u32x4 a = *(const u32x4*)(P.cdil + grow * 512 + 8 * c), b = *(const u32x4*)(P.cdil + ((size_t)MR + grow) * 512 + 8 * c),
                        cc = *(const u32x4*)(P.cdil + ((size_t)2 * MR + grow) * 512 + 8 * c), gd = *(const u32x4*)(P.gate - 1024 + grow * P.ldq + 8 * c);
            u32x4 wo;
#pragma unroll
            for (int j = 0; j < 4; ++j) wo[j] = pk2((bflo(a[j]) * w0 + bflo(b[j]) * w1 + bflo(cc[j]) * w2) * silu(bflo(gd[j])), (bfhi(a[j]) * w0 + bfhi(b[j]) * w1 + bfhi(cc[j]) * w2) * silu(bfhi(gd[j])));
            *(u32x4*)(P.o - 512 + grow * P.ldo + 8 * c) = wo; }
        asm volatile("" ::: "memory"); }
    __syncthreads();
}

struct SAttnP {
    const bf16_t* q; const float* gq;
    const float* kbase; long kstride; int nk;
    const bf16_t* knew; const bf16_t* vnew; const float* gk;
    float* newout;
    bf16_t* o; const bf16_t* gate; float* lse;
};
__device__ __forceinline__ void sattn_item(const Ctx& C, const SAttnP& P) {
    LAS float* sq = (LAS float*)C.lds;
    LAS float* kn = sq + 128;
    LAS float* vn = kn + 128;
    LAS float* sc = vn + 128;
    LAS float* red = sc + 320;
    const int tid = fresh_tid(C.wid);
    const int lane = tid & 63, wid = C.wid;
    const bool extra = P.knew != nullptr;
    const int hw = tid >> 5, l32 = tid & 31, nkh = P.nk >> 4;
    const int eg = tid & 31, kg = tid >> 5, per = P.nk >> 4;
    f32x4 kv[16], vv[16];
#pragma unroll
    for (int i = 0; i < 16; ++i) if (i < nkh) kv[i] = __builtin_nontemporal_load((const f32x4*)(P.kbase + (long)(hw + 16 * i) * P.kstride + 4 * l32));
    { const float* vp = P.kbase + 512 + 4 * eg + (long)(kg * per) * P.kstride;
#pragma unroll
        for (int i = 0; i < 16; ++i) if (i < per) vv[i] = __builtin_nontemporal_load((const f32x4*)(vp + (long)i * P.kstride)); }
    if (wid == 0) { const float a = bflo((unsigned)P.q[2 * lane]), b = bflo((unsigned)P.q[2 * lane + 1]);
        const float ss = wave_sum(a * a + b * b), rs = rsqrtf(ss * (1.0f / 128.0f) + EPS) * QSCALE;
        sq[2 * lane] = a * rs * P.gq[2 * lane]; sq[2 * lane + 1] = b * rs * P.gq[2 * lane + 1]; }
    if (wid == 1 && extra) { const float a = bflo((unsigned)P.knew[2 * lane]), b = bflo((unsigned)P.knew[2 * lane + 1]);
        const float ss = wave_sum(a * a + b * b), rs = rsqrtf(ss * (1.0f / 128.0f) + EPS);
        const float ka = a * rs * P.gk[2 * lane], kb = b * rs * P.gk[2 * lane + 1];
        kn[2 * lane] = ka; kn[2 * lane + 1] = kb; P.newout[2 * lane] = ka; P.newout[2 * lane + 1] = kb; }
    if (wid == 2 && extra) { const float a = bflo((unsigned)P.vnew[2 * lane]), b = bflo((unsigned)P.vnew[2 * lane + 1]);
        vn[2 * lane] = a; vn[2 * lane + 1] = b; P.newout[512 + 2 * lane] = a; P.newout[512 + 2 * lane + 1] = b; }
    __syncthreads();
    {
        const f32x4 qv = *(const LAS f32x4*)(sq + 4 * l32);
        float mine = 0.f;
#pragma unroll
        for (int i = 0; i < 16; ++i) if (i < nkh) { float d = (kv[i][0] * qv[0] + kv[i][1] * qv[1]) + (kv[i][2] * qv[2] + kv[i][3] * qv[3]);
            d = row16_sum(d); d += __shfl_xor(d, 16); if (l32 == i) mine = d; }
        if (l32 < nkh) sc[hw + 16 * l32] = mine;
    }
    if (wid == 7 && extra) { const float d = wave_sum(sq[2 * lane] * kn[2 * lane] + sq[2 * lane + 1] * kn[2 * lane + 1]); if (lane == 0) sc[P.nk] = d; }
    __syncthreads();
    const int ntot = P.nk + (extra ? 1 : 0);
    float m = -1e30f, l = 0.f;
    { float sv[5];
#pragma unroll
        for (int i = 0; i < 5; ++i) { const int j = lane + 64 * i; sv[i] = j < ntot ? sc[j] : -1e30f; m = fmaxf(m, sv[i]); }
        m = wave_max(m);
#pragma unroll
        for (int i = 0; i < 5; ++i) l += __builtin_amdgcn_exp2f(sv[i] - m);
        l = wave_sum(l); }
    const float inv = 1.0f / l;
    {
        f32x4 acc = {0.f, 0.f, 0.f, 0.f};
#pragma unroll
        for (int i = 0; i < 16; ++i) if (i < per) acc += vv[i] * (__builtin_amdgcn_exp2f(sc[kg * per + i] - m) * inv);
        if (extra && kg == 0) acc += *(const LAS f32x4*)(vn + 4 * eg) * (__builtin_amdgcn_exp2f(sc[P.nk] - m) * inv);
        *(LAS f32x4*)(red + kg * 128 + 4 * eg) = acc; }
    __syncthreads();
    if (tid < 128) { float v = 0.f;
#pragma unroll
        for (int g = 0; g < 16; ++g) v += red[g * 128 + tid];
        if (P.gate) v *= silu(bflo((unsigned)P.gate[tid]));
        P.o[tid] = (bf16_t)(pk2(v, 0.f) & 0xffffu); }
    if (tid == 0 && P.lse) P.lse[0] = m + log2f(l);
    __syncthreads();
}

__device__ __forceinline__ void mixer_attn(const Ctx& C, int l, int part) {
    const bool isb = l >= 2; const int bl = l - 2;
    const bf16_t* Z = (const bf16_t*)(C.ws + WS_Z); const bf16_t* KVB = (const bf16_t*)(C.ws + WS_KVB); bf16_t* ACT = (bf16_t*)(C.ws + WS_ACT);
    const bf16_t* MEMKV = (const bf16_t*)(C.ws + WS_MEMKV);
    bf16_t* DILO = (bf16_t*)(C.ws + WS_DILO); float* LSE = (float*)(C.ws + WS_LSE);
    const int ldz = NINB, mqoff = 2048, ldact = isb ? KOUTB : KOUTA, acol = isb ? 512 : 1024;
    const bf16_t* ZS = (const bf16_t*)(C.ws + WS_ZS);
    const int n_smem = part == 2 ? 0 : 128, n_sdil = part == 1 ? 384 : 0, n_pdil = part == 1 ? 1536 : 0, n_pmem = part == 1 ? 0 : 256;
    const int ntot = n_smem + n_sdil + n_pdil + n_pmem;
    const int vb = (C.G % 8 == 0) ? (C.bid % 8) * (C.G / 8) + C.bid / 8 : C.bid;
    for (int it = C.bid; it < n_smem + n_sdil; it += C.G) {
        {
            SAttnP P;
            if (it < n_smem) { const int b = it >> 2, h = it & 3; const size_t row = MP + b;
                P.q = isb ? Z + row * ldz + mqoff + h * 128 : ZS + (size_t)b * NINA + 4096 + h * 128; P.gq = C.in[22] + l * 128;
                P.kbase = C.in[2] + ((size_t)(l * NS + b) * MEML) * 1024 + h * 128; P.kstride = 1024; P.nk = 256;
                P.knew = nullptr; P.vnew = nullptr; P.gk = nullptr; P.newout = nullptr;
                P.o = ACT + row * ldact + acol + h * 128; P.gate = P.q + 512; P.lse = nullptr;
            } else { const int idx = it - n_smem, b = idx / 12, g = (idx / 4) % 3, h = idx & 3; const size_t row = MP + b;
                const int W = g == 0 ? 128 : (g == 1 ? 512 : 2048), d = g == 0 ? 1 : (g == 1 ? 4 : 16);
                const float* buf = g == 0 ? C.in[4] : (g == 1 ? C.in[5] : C.in[6]);
                P.q = Z + row * NINB + g * 512 + h * 128; P.gq = C.in[14] + (bl * 3 + g) * 128;
                P.kbase = buf + ((size_t)b * W + (W - d)) * 1024 + h * 128; P.kstride = -(long)d * 1024; P.nk = 128;
                P.knew = KVB + row * 3072 + g * 1024 + h * 128; P.vnew = P.knew + 512; P.gk = C.in[18] + g * 128;
                P.newout = C.out + (g == 0 ? O_DIL0S : (g == 1 ? O_DIL1S : O_DIL2S)) + (size_t)b * 1024 + h * 128;
                P.o = DILO + ((size_t)g * MR + row) * 512 + h * 128; P.gate = nullptr; P.lse = LSE + ((size_t)g * MR + row) * 4 + h; }
            sattn_item(C, P);
        }
    }
    if (part == 1) {
        u32x4 kw[8], vw[8]; bool have = false;
        for (int it = n_smem + n_sdil + vb; it < ntot; it += C.G) {
            AttnP P; const int idx = it - n_smem - n_sdil, combo = idx & 15, h = (idx >> 4) & 3, g = (idx >> 6) % 3, b = idx / 192;
            const int d = g == 0 ? 1 : (g == 1 ? 4 : 16), res = combo % d, n = combo / d, keep = g == 0 ? 128 : (g == 1 ? 512 : 2048);
            P.q = Z + g * 512 + h * 128; P.ldq = NINB; P.qrow0 = b * SEQ + n * 128 * d + res; P.qrstep = d;
            P.k = KVB + g * 1024 + h * 128; P.v = P.k + 512; P.ldk = 3072; P.krow0 = b * SEQ + (n - 1) * 128 * d + res; P.krstep = d;
            P.gq = C.in[14] + (bl * 3 + g) * 128; P.gk = C.in[18] + g * 128; P.mode = n == 0 ? 2 : 1;
            const int t128 = (n * 128) * d + res;
            const bool wr = (bl == 0) && (t128 >= SEQ - keep);
            P.kvout = C.out + (g == 0 ? O_DIL0P : (g == 1 ? O_DIL1P : O_DIL2P)) + ((size_t)b * keep + (wr ? t128 - (SEQ - keep) : 0)) * 1024 + h * 128;
            P.kv_jfrom = wr ? 128 : 256; P.kv_ostride = (size_t)d * 1024;
            P.o = DILO + (size_t)g * MR * 512 + h * 128; P.ldo = 512; P.gate = nullptr; P.lse = LSE + (size_t)g * MR * 4 + h; P.cdil = nullptr; P.clse = nullptr;
            NextKV nx; nx.valid = 0; nx.k = nullptr; nx.ldk = 3072; nx.krow0 = 0; nx.krstep = 0; nx.it0 = 0;
            { const int itn = it + C.G;
                if (itn < ntot) { const int j2 = itn - n_smem - n_sdil; nx.valid = 1;
                    const int combo2 = j2 & 15, h2 = (j2 >> 4) & 3, g2 = (j2 >> 6) % 3, b2 = j2 / 192, d2 = g2 == 0 ? 1 : (g2 == 1 ? 4 : 16), res2 = combo2 % d2, n2 = combo2 / d2;
                    nx.k = KVB + g2 * 1024 + h2 * 128; nx.krow0 = b2 * SEQ + (n2 - 1) * 128 * d2 + res2; nx.krstep = d2; nx.it0 = n2 == 0 ? 4 : 0; } }
            attn_item(C, P, kw, vw, have, nx);
            have = nx.valid != 0;
        }
    } else {
        u32x4 kw[8], vw[8]; bool have = false;
        for (int it = n_smem + n_sdil + vb; it < ntot; it += C.G) {
            AttnP P; const int idx = it - n_smem - n_sdil, b = idx >> 5, h = (idx >> 3) & 3, qblk = idx & 7;
            P.q = Z + mqoff + h * 128; P.ldq = ldz; P.qrow0 = b * SEQ + qblk * 256; P.qrstep = 1;
            P.k = MEMKV + l * 1024 + h * 128; P.v = P.k + 512; P.ldk = 4096; P.krow0 = b * MEML; P.krstep = 1;
            P.gq = C.in[22] + l * 128; P.gk = C.in[21] + l * 128; P.mode = 0;
            P.kvout = C.out + O_MEMKV + ((size_t)(l * NB + b) * MEML) * 1024 + h * 128; P.kv_jfrom = qblk == 0 ? 0 : 256; P.kv_ostride = 1024;
            P.o = ACT + acol + h * 128; P.ldo = ldact; P.gate = Z + mqoff + 512 + h * 128; P.lse = nullptr;
            P.cdil = part == 2 ? DILO + h * 128 : nullptr; P.clse = part == 2 ? LSE + h : nullptr;
            NextKV nx; nx.valid = 0; nx.k = nullptr; nx.ldk = 4096; nx.krow0 = 0; nx.krstep = 1; nx.it0 = 0;
            { const int itn = it + C.G;
                if (itn < ntot) { const int j2 = itn - n_smem - n_sdil, b2 = j2 >> 5, h2 = (j2 >> 3) & 3; nx.valid = 1;
                    nx.k = MEMKV + l * 1024 + h2 * 128; nx.krow0 = b2 * MEML; } }
            attn_item_wide(C, P, kw, vw, have, nx);
            have = nx.valid != 0;
        }
    }
}
__device__ __forceinline__ void mixer_conv(const Ctx& C, int a) {
    const bf16_t* Z = (const bf16_t*)(C.ws + WS_Z); bf16_t* ACT = (bf16_t*)(C.ws + WS_ACT); const bf16_t* ZS = (const bf16_t*)(C.ws + WS_ZS);
    const float* cw = C.in[10] + (size_t)a * 3 * D;
    for (int task = C.bid * 512 + C.tid; task < (MP / 16) * 128 + NS * 128; task += C.G * 512) {
        const bool smp = task >= (MP / 16) * 128;
        const int chunk = task & 127, col = 8 * chunk;
        float w0[8], w1[8], w2[8], u1[8], u2[8];
#pragma unroll
        for (int i = 0; i < 8; ++i) { w0[i] = cw[col + i]; w1[i] = cw[D + col + i]; w2[i] = cw[2 * D + col + i]; u1[i] = 0.f; u2[i] = 0.f; }
        if (smp) { const int b = (task - (MP / 16) * 128) >> 7;
            const float* st = C.in[3] + ((size_t)(a * NS + b) * 2) * D + col;
            float* cs = C.out + O_CONVS + ((size_t)(a * NS + b) * 2) * D + col;
            const bf16_t* zr = ZS + (size_t)b * NINA + (col >> 7) * 256 + (col & 127);
            const u32x4 hw = *(const u32x4*)zr, cw4 = *(const u32x4*)(zr + 128), bw = *(const u32x4*)(zr + 2048), gw = *(const u32x4*)(zr + 2048 + 128);
            float ov[8];
#pragma unroll
            for (int i = 0; i < 8; ++i) { const float hh = (i & 1) ? bfhi(hw[i >> 1]) : bflo(hw[i >> 1]), cc = (i & 1) ? bfhi(cw4[i >> 1]) : bflo(cw4[i >> 1]);
                const float bg = (i & 1) ? bfhi(bw[i >> 1]) : bflo(bw[i >> 1]), gg = (i & 1) ? bfhi(gw[i >> 1]) : bflo(gw[i >> 1]);
                const float s0 = st[i], s1 = st[D + i], u0 = hh * cc;
                ov[i] = silu(gg) * bg * (w0[i] * s0 + w1[i] * s1 + w2[i] * u0); cs[i] = s1; cs[D + i] = u0; }
            u32x4 w; w.x = pk2(ov[0], ov[1]); w.y = pk2(ov[2], ov[3]); w.z = pk2(ov[4], ov[5]); w.w = pk2(ov[6], ov[7]);
            *(u32x4*)(ACT + (size_t)(MP + b) * KOUTA + col) = w;
            continue; }
        const int t0 = (task >> 7) * 16;
        if ((t0 & (SEQ - 1)) != 0) {
            const u32x4 a1 = *(const u32x4*)(Z + (size_t)(t0 - 1) * NINB + col), a2 = *(const u32x4*)(Z + (size_t)(t0 - 2) * NINB + col);
#pragma unroll
            for (int i = 0; i < 4; ++i) { u1[2 * i] = bflo(a1[i]); u1[2 * i + 1] = bfhi(a1[i]); u2[2 * i] = bflo(a2[i]); u2[2 * i + 1] = bfhi(a2[i]); } }
#pragma unroll 4
        for (int rr = 0; rr < 16; ++rr) {
            const int t = t0 + rr; const bf16_t* zr = Z + (size_t)t * NINB + col;
            const u32x4 uw = *(const u32x4*)zr, gw = *(const u32x4*)(zr + 1024);
            float u0[8], ov[8];
#pragma unroll
            for (int i = 0; i < 4; ++i) { u0[2 * i] = bflo(uw[i]); u0[2 * i + 1] = bfhi(uw[i]); }
#pragma unroll
            for (int i = 0; i < 8; ++i) { const float gb = (i & 1) ? bfhi(gw[i >> 1]) : bflo(gw[i >> 1]); ov[i] = gb * (w0[i] * u2[i] + w1[i] * u1[i] + w2[i] * u0[i]); }
            u32x4 w; w.x = pk2(ov[0], ov[1]); w.y = pk2(ov[2], ov[3]); w.z = pk2(ov[4], ov[5]); w.w = pk2(ov[6], ov[7]);
            *(u32x4*)(ACT + (size_t)t * KOUTA + col) = w;
#pragma unroll
            for (int i = 0; i < 8; ++i) { u2[i] = u1[i]; u1[i] = u0[i]; }
        }
    }
}
__device__ __forceinline__ void mixer_b_combine(const Ctx& C, int row_lo) {
    const bf16_t* Z = (const bf16_t*)(C.ws + WS_Z); bf16_t* ACT = (bf16_t*)(C.ws + WS_ACT);
    const bf16_t* DILO = (const bf16_t*)(C.ws + WS_DILO); const float* LSE = (const float*)(C.ws + WS_LSE);
    for (int task = row_lo * 64 + C.bid * 512 + C.tid; task < MR * 64; task += C.G * 512) {
        const int row = task >> 6, chunk = task & 63, h = chunk >> 4;
        const float l0 = LSE[((size_t)0 * MR + row) * 4 + h], l1 = LSE[((size_t)1 * MR + row) * 4 + h], l2 = LSE[((size_t)2 * MR + row) * 4 + h];
        const float m = fmaxf(l0, fmaxf(l1, l2)); float w0 = exp2f(l0 - m), w1 = exp2f(l1 - m), w2 = exp2f(l2 - m); const float inv = 1.0f / (w0 + w1 + w2);
        w0 *= inv; w1 *= inv; w2 *= inv;
        const u32x4 a = *(const u32x4*)(DILO + ((size_t)0 * MR + row) * 512 + 8 * chunk), b = *(const u32x4*)(DILO + ((size_t)1 * MR + row) * 512 + 8 * chunk),
                    c = *(const u32x4*)(DILO + ((size_t)2 * MR + row) * 512 + 8 * chunk), gw = *(const u32x4*)(Z + (size_t)row * NINB + 1536 + 8 * chunk);
        u32x4 w;
#pragma unroll
        for (int i = 0; i < 4; ++i) { const float lo = (bflo(a[i]) * w0 + bflo(b[i]) * w1 + bflo(c[i]) * w2) * silu(bflo(gw[i]));
            const float hi = (bfhi(a[i]) * w0 + bfhi(b[i]) * w1 + bfhi(c[i]) * w2) * silu(bfhi(gw[i])); w[i] = pk2(lo, hi); }
        *(u32x4*)(ACT + (size_t)row * KOUTB + 8 * chunk) = w;
    }
}

struct GsP { const bf16_t* A; const bf16_t* Bt; int M, N; bf16_t* O; int ldc; const float* ss; int split_cols; size_t split_stride; int sample; float* convp; };
__device__ __forceinline__ void gemm_scale(const Ctx& C, const GsP& q) {
    pg8::Gemm g{q.A, q.Bt, q.M, q.N, D}; pg8::StaticOrder S; S.init(q.M, q.N, C.G, C.bid);
    LAS float* rst = (LAS float*)(C.lds + 131072);
    for (int i = C.tid >> 8; i < 8; i += 2) { pg8::Unit u; if (!S.next(i, u)) break; rst[i * 256 + (C.tid & 255)] = rsqrtf(q.ss[u.pm * 256 + (C.tid & 255)] * (1.0f / 1024.0f) + EPS); }
    __syncthreads();
    pg8::EpiScale E{q.O, q.ldc, rst, q.split_cols, q.split_stride, q.convp};
    pg8::gemm_phase<pg8::EpiScale>(C.lds, g, S, E, C.tid);
    if (q.sample)
        for (int tile = C.bid; tile < q.N / 32; tile += C.G)
            sgemm_tile(C, q.A + (size_t)MP * D, D, q.Bt, D, tile, nullptr, [&](int row, int col, float v) -> float {
                bf16_t* base = q.O; int cc = col; if (q.split_cols) { const int t = cc / q.split_cols; base += (size_t)t * q.split_stride; cc -= t * q.split_cols; }
                const float rs = rsqrtf(q.ss[MP + row] * (1.0f / 1024.0f) + EPS); const bf16_t o = (bf16_t)(pk2(v * rs, 0.f) & 0xffffu);
                if (q.convp) ((bf16_t*)(C.ws + WS_ZS))[(size_t)row * NINA + col] = o; else base[(size_t)(MP + row) * q.ldc + cc] = o; return 0.f; });
}
struct GrP { const bf16_t* A; const bf16_t* Bt; int K; bf16_t* xb; float* xout; float* ssn; };
__device__ __forceinline__ void gemm_resid(const Ctx& C, const GrP& q) {
    pg8::Gemm g{q.A, q.Bt, MP, D, q.K}; pg8::StaticOrder S; S.init(MP, D, C.G, C.bid);
    pg8::EpiResid E{q.xb, q.xout, q.ssn};
    pg8::gemm_phase<pg8::EpiResid>(C.lds, g, S, E, C.tid);
    for (int tile = C.bid; tile < D / 32; tile += C.G)
        sgemm_tile(C, q.A + (size_t)MP * q.K, q.K, q.Bt, q.K, tile, q.xout ? nullptr : q.ssn + MP, [&](int row, int col, float v) -> float {
            const size_t off = (size_t)(MP + row) * D + col; const float x = bflo((unsigned)q.xb[off]) + v;
            if (q.xout) q.xout[off] = x; else q.xb[off] = (bf16_t)(pk2(x, 0.f) & 0xffffu); return x * x; });
}

constexpr int N_STEPS = 18;
#ifndef KMASK
#define KMASK 63
#endif

__global__ void __launch_bounds__(512, 2) yoco_fwd(Params p) {
    extern __shared__ __attribute__((aligned(16))) unsigned char lds_raw[];
    Ctx C; C.in = p.in; C.out = p.out; C.ws = p.ws; C.lds = (LAS unsigned char*)lds_raw;
    C.tid = threadIdx.x; C.lane = C.tid & 63; C.wid = __builtin_amdgcn_readfirstlane(C.tid >> 6); C.G = gridDim.x; C.bid = blockIdx.x;
    cg::grid_group grid = cg::this_grid();
    if (C.tid < 2) ((LAS unsigned*)(C.lds + LDS_ST_OFF))[C.tid] = 0u;
    __syncthreads();
    (void)xcd_barrier_post((unsigned*)(p.ws + WS_CTL), (volatile LAS unsigned*)(C.lds + LDS_ST_OFF));
    for (int s = p.ph_lo; s < p.ph_hi; ++s) {
        unsigned char* wsb = p.ws; float* outb = p.out; asm volatile("" : "+s"(wsb), "+s"(outb));
        C.ws = wsb; C.out = outb;
        bf16_t* Wmem = (bf16_t*)(wsb + WS_WMEM); bf16_t* Wina = (bf16_t*)(wsb + WS_WINA); bf16_t* Wouta = (bf16_t*)(wsb + WS_WOUTA);
        bf16_t* Wkvb = (bf16_t*)(wsb + WS_WKVB); bf16_t* Winb1 = (bf16_t*)(wsb + WS_WINB1); bf16_t* Woutb = (bf16_t*)(wsb + WS_WOUTB);
        bf16_t* XB = (bf16_t*)(wsb + WS_XB); bf16_t* MEMN = (bf16_t*)(wsb + WS_MEMN); bf16_t* MEMKV = (bf16_t*)(wsb + WS_MEMKV);
        bf16_t* Z = (bf16_t*)(wsb + WS_Z); bf16_t* KVB = (bf16_t*)(wsb + WS_KVB); bf16_t* ACT = (bf16_t*)(wsb + WS_ACT);
        float* SS = (float*)(wsb + WS_SS); float* X = outb + O_Y;
        bool sync_after = true;
        if (s == 0) { for (int rep = 0; rep < ((RMASK & 1) ? 2 : 1); ++rep) p0_prologue(launder(C)); }
        else if (s == 1 || s == 2 || s == 6 || s == 10 || s == 14) {
            GsP q; q.split_cols = 0; q.split_stride = 0; q.sample = 1; q.convp = nullptr;
            if (s == 1) { q.A = MEMN; q.Bt = Wmem; q.M = 2048; q.N = 4096; q.O = MEMKV; q.ldc = 4096; q.ss = SS + 4 * SS_STRIDE; q.sample = 0; sync_after = false; }
            else if (s == 2) { q.A = XB; q.Bt = Wina; q.M = MP; q.N = NINA; q.O = Z; q.ldc = NINB; q.ss = SS; q.convp = outb + O_CONVP; }
            else if (s == 6) { q.A = XB; q.Bt = Wina + (size_t)NINA * D; q.M = MP; q.N = NINA; q.O = Z; q.ldc = NINB; q.ss = SS + SS_STRIDE; q.convp = outb + O_CONVP + (size_t)NB * 2 * D; }
            else if (s == 10) { q.A = XB; q.Bt = Wkvb; q.M = MP; q.N = NKVB; q.O = KVB; q.ldc = 3072; q.ss = SS + 2 * SS_STRIDE; q.split_cols = 3072; q.split_stride = (size_t)((WS_Z - WS_KVB) / 2); }
            else { q.A = XB; q.Bt = Winb1; q.M = MP; q.N = NINB; q.O = Z; q.ldc = NINB; q.ss = SS + 3 * SS_STRIDE; }
            for (int rep = 0; rep < ((RMASK & 2) ? 2 : 1); ++rep) gemm_scale(launder(C), q);
        } else if (s == 3 || s == 7 || s == 11 || s == 15 || s == 12 || s == 16) { for (int rep = 0; rep < (((RMASK & 4) || ((RMASK & 128) && s < 10) || ((RMASK & 256) && s > 10)) ? 2 : 1); ++rep) mixer_attn(launder(C), s == 3 ? 0 : (s == 7 ? 1 : (s < 14 ? 2 : 3)), s < 10 ? 0 : ((s == 11 || s == 15) ? 1 : 2));
            if (s == 12 || s == 16) mixer_b_combine(launder(C), MP); if (s == 3 || s == 7) sync_after = false; }
        else if (s == 4 || s == 8) { for (int rep = 0; rep < ((RMASK & 8) ? 2 : 1); ++rep) mixer_conv(launder(C), s == 4 ? 0 : 1); }
        else {
            GrP q; q.A = ACT; q.xb = XB; q.xout = nullptr;
            if (s == 5) { q.Bt = Wouta; q.K = KOUTA; q.ssn = SS + SS_STRIDE; }
            else if (s == 9) { q.Bt = Wouta + (size_t)D * KOUTA; q.K = KOUTA; q.ssn = SS + 2 * SS_STRIDE; }
            else if (s == 13) { q.Bt = Woutb; q.K = KOUTB; q.ssn = SS + 3 * SS_STRIDE; }
            else { q.Bt = Woutb + (size_t)D * KOUTB; q.K = KOUTB; q.xout = X; q.ssn = nullptr; }
            gemm_resid(launder(C), q);
        }
        if (sync_after && s + 1 < p.ph_hi) { if (p.ph_hi > 1000) grid.sync(); else { XcdBarrier xb; xb.bar = (unsigned*)(wsb + WS_CTL); xb.x = xb_xcc_id(); xb.st = (volatile LAS unsigned*)(C.lds + LDS_ST_OFF); xcd_barrier(xb); } }
    }
}

extern "C" void kernel_launch(void* const* d_in, const int* in_sizes, int n_in, void* d_out, int out_size, void* d_ws, size_t ws_size, hipStream_t stream) {
    static int grid = 0;
    if (grid == 0) {
        if (n_in != 23 || ws_size < WS_END) { fprintf(stderr, "kernel_launch: unexpected n_in %d or ws_size %zu\n", n_in, ws_size); grid = -1; return; }
        int dev = 0, cus = 0, per_cu = 0;
        hipGetDevice(&dev); hipDeviceGetAttribute(&cus, hipDeviceAttributeMultiprocessorCount, dev);
        if (hipFuncSetAttribute((const void*)yoco_fwd, hipFuncAttributeMaxDynamicSharedMemorySize, LDS_BYTES) != hipSuccess) { fprintf(stderr, "kernel_launch: hipFuncSetAttribute failed\n"); grid = -1; return; }
        if (hipOccupancyMaxActiveBlocksPerMultiprocessor(&per_cu, (const void*)yoco_fwd, 512, LDS_BYTES) != hipSuccess || per_cu < 1) { fprintf(stderr, "kernel_launch: occupancy query failed (%d)\n", per_cu); (void)hipGetLastError(); per_cu = 1; }
        grid = cus * (per_cu > 1 ? 1 : per_cu);
        if (grid > 256) grid = 256;
    }
    if (grid < 0) return;
    if (hipMemsetAsync((char*)d_ws + WS_CTL, 0, CTL_ZERO_BYTES, stream) != hipSuccess) { fprintf(stderr, "kernel_launch: memset of barrier words failed\n"); return; }
    Params p{};
    for (int i = 0; i < 23; ++i) p.in[i] = (const float*)d_in[i];
    p.out = (float*)d_out; p.ws = (unsigned char*)d_ws;
#if N_LAUNCH_MODE == 0
    p.ph_lo = 0; p.ph_hi = N_STEPS;
    void* args[] = {&p};
    hipError_t e = hipLaunchCooperativeKernel((const void*)yoco_fwd, dim3(grid), dim3(512), args, LDS_BYTES, stream);
    if (e != hipSuccess) fprintf(stderr, "cooperative launch failed: %s (grid %d)\n", hipGetErrorString(e), grid);
#else
    static const int cuts[] = {0, 1, 3, 5, 6, 7, 9, 10, 11, 12, 13, 14, 15, 16, 17, 18};
    for (int i = 0; i + 1 < (int)(sizeof(cuts) / sizeof(int)); ++i) { p.ph_lo = cuts[i]; p.ph_hi = cuts[i + 1]; hipLaunchKernelGGL(yoco_fwd, dim3(grid), dim3(512), LDS_BYTES, stream, p); }
#endif
}
```

```cpp
#include <hip/hip_runtime.h>
#include <hip/hip_cooperative_groups.h>
#include <cstdio>
namespace cg = cooperative_groups;

#ifndef N_LAUNCH_MODE
#define N_LAUNCH_MODE 0
#endif

#ifndef RMASK
#define RMASK 0
#endif

#define LAS __attribute__((address_space(3)))
typedef unsigned short bf16_t;
typedef short bf16x8 __attribute__((ext_vector_type(8)));
typedef short s16x4 __attribute__((ext_vector_type(4)));
typedef float f32x4 __attribute__((ext_vector_type(4)));
typedef float f32x16 __attribute__((ext_vector_type(16)));
typedef unsigned u32x4 __attribute__((ext_vector_type(4)));
typedef unsigned u32x2 __attribute__((ext_vector_type(2)));
typedef __bf16 bf16v2 __attribute__((ext_vector_type(2)));

constexpr int D = 1024, NB = 8, SEQ = 2048, MP = NB * SEQ, NS = 32, MR = MP + NS, MEML = 256;
constexpr int NINA = 5120, NKVB = 6144, NINB = 3072, KOUTA = 1536, KOUTB = 1024;
constexpr float EPS = 1e-6f;
constexpr float QSCALE = 0.08838834764831845f * 1.4426950408889634f;

constexpr size_t O_Y = 0, O_MEMKV = 16809984, O_CONVP = 25198592, O_CONVS = 25231360, O_DIL0P = 25362432, O_DIL1P = 26411008,
                 O_DIL2P = 30605312, O_DIL0S = 47382528, O_DIL1S = 47415296, O_DIL2S = 47448064;

constexpr size_t MiB = 1u << 20;
constexpr size_t WS_WMEM = 0, WS_WINA = 8 * MiB, WS_WOUTA = 28 * MiB, WS_WKVB = 34 * MiB, WS_WINB1 = 46 * MiB, WS_WOUTB = 52 * MiB,
                 WS_MEMN = 56 * MiB, WS_MEMKV = 60 * MiB, WS_XB = 76 * MiB, WS_SS = 110 * MiB, WS_Z = 112 * MiB, WS_KVB = 274 * MiB,
                 WS_ACT = 372 * MiB, WS_DILO = 422 * MiB, WS_LSE = 472 * MiB, WS_CTL = 474 * MiB, WS_ZS = 475 * MiB, WS_END = 476 * MiB;
constexpr size_t CTL_ZERO_BYTES = 16384;
constexpr int LDS_ST_OFF = 139264;
constexpr int SS_STRIDE = 16640;

constexpr int LDS_BYTES = 140 * 1024;

__device__ __forceinline__ unsigned pk2(float lo, float hi) { bf16v2 v = {(__bf16)lo, (__bf16)hi}; return __builtin_bit_cast(unsigned, v); }
__device__ __forceinline__ float bflo(unsigned w) { return __builtin_bit_cast(float, w << 16); }
__device__ __forceinline__ float bfhi(unsigned w) { return __builtin_bit_cast(float, w & 0xffff0000u); }
__device__ __forceinline__ float silu(float x) { return x * __builtin_amdgcn_rcpf(1.0f + __builtin_amdgcn_exp2f(x * -1.4426950408889634f)); }
__device__ __forceinline__ float row16_sum(float v) {
    v += __builtin_bit_cast(float, __builtin_amdgcn_mov_dpp(__builtin_bit_cast(int, v), 0xB1, 0xF, 0xF, true));
    v += __builtin_bit_cast(float, __builtin_amdgcn_mov_dpp(__builtin_bit_cast(int, v), 0x4E, 0xF, 0xF, true));
    v += __builtin_bit_cast(float, __builtin_amdgcn_mov_dpp(__builtin_bit_cast(int, v), 0x124, 0xF, 0xF, true));
    v += __builtin_bit_cast(float, __builtin_amdgcn_mov_dpp(__builtin_bit_cast(int, v), 0x128, 0xF, 0xF, true));
    return v;
}
__device__ __forceinline__ float wave_sum(float v) {
#pragma unroll
    for (int o = 1; o < 64; o <<= 1) v += __shfl_xor(v, o);
    return v;
}
__device__ __forceinline__ float wave_max(float v) {
#pragma unroll
    for (int o = 1; o < 64; o <<= 1) v = fmaxf(v, __shfl_xor(v, o));
    return v;
}

namespace pg8 {
constexpr int BM = 256, BK = 64, HALF = 128, HTB = HALF * BK * 2, STAGE_BYTES = 8 * HTB, NXCD = 8, WGM = 4;
__device__ __forceinline__ int lds_byte(int r, int c) { const int st = (r >> 4) * 2 + (c >> 5), rr = r & 15, cc = c & 31, ob = rr * 64 + cc * 2; return st * 1024 + (ob ^ (((ob >> 9) & 1) << 5)); }
__device__ __forceinline__ void stage_rc(int b, int& R, int& C) { const int st = b / 1024, sb = b % 1024, swz = sb ^ (((sb >> 9) & 1) << 5); R = (st >> 1) * 16 + swz / 64; C = (st & 1) * 32 + (swz % 64) / 2; }
__device__ __forceinline__ int perm32(int rho) { const int n = rho >> 4, i = rho & 15; return 8 * (i >> 2) + 4 * n + (i & 3); }
struct Unit { int pm, pn; };
struct Gemm { const bf16_t* A; const bf16_t* Bt; int M, N, K; };
struct StaticOrder {
    int nM, nN, nwg, G, c;
    __device__ void init(int M, int N, int G_, int c_) { nM = M / BM; nN = N / BM; nwg = nM * nN; G = G_; c = c_; }
    __device__ bool next(int i, Unit& u) const {
        const long L = (long)i * G + c; if (L >= nwg) return false;
        int wgid = (int)L; { const int q = nwg / NXCD, r = nwg % NXCD, xcd = wgid % NXCD, off = wgid / NXCD; wgid = (xcd < r ? xcd * (q + 1) : r * (q + 1) + (xcd - r) * q) + off; }
        const int nig = WGM * nN, gid = wgid / nig, fm = gid * WGM, gsz = (nM - fm) < WGM ? (nM - fm) : WGM;
        u.pm = fm + ((wgid % nig) % gsz); u.pn = (wgid % nig) / gsz; return true;
    }
};
struct EpiScale {
    bf16_t* O; int ldc; const LAS float* rst; int split_cols; size_t split_stride;
    float* convp;
    __device__ __forceinline__ void operator()(const f32x4 (&acc)[2][2][4][2], const Unit& u, int wr, int wc, int fr, int fq, int ui) const {
        const int row0 = u.pm * BM + wr * 64 + fr; int colt = u.pn * BM; bf16_t* base = O;
        if (split_cols) { const int t = colt / split_cols; base += (size_t)t * split_stride; colt -= t * split_cols; }
        float rsv[2][4];
        if (convp) { colt = u.pn < 16 ? (u.pn & 7) * 128 + (u.pn >> 3) * 1024 : u.pn * BM - 2048; }
        { const unsigned a = (unsigned)(size_t)(rst + ui * 256 + wr * 64 + fr);
          asm volatile("ds_read_b32 %0, %8\n\tds_read_b32 %1, %8 offset:64\n\tds_read_b32 %2, %8 offset:128\n\tds_read_b32 %3, %8 offset:192\n\t"
                       "ds_read_b32 %4, %8 offset:512\n\tds_read_b32 %5, %8 offset:576\n\tds_read_b32 %6, %8 offset:640\n\tds_read_b32 %7, %8 offset:704\n\ts_waitcnt lgkmcnt(0)"
                       : "=&v"(rsv[0][0]), "=&v"(rsv[0][1]), "=&v"(rsv[0][2]), "=&v"(rsv[0][3]), "=&v"(rsv[1][0]), "=&v"(rsv[1][1]), "=&v"(rsv[1][2]), "=&v"(rsv[1][3]) : "v"(a) : "memory"); }
        const int col0 = colt + wc * 32 + 8 * fq;
        if (convp && u.pn < 16) {
            const bool isu = u.pn < 8;
#pragma unroll
            for (int ai = 0; ai < 2; ++ai)
#pragma unroll
                for (int m = 0; m < 4; ++m) {
                    const int row = row0 + ai * HALF + m * 16; const float rs = rsv[ai][m];
                    f32x4 v0, v1;
                    if (isu) { v0 = acc[ai][0][m][0] * acc[ai][1][m][0] * (rs * rs); v1 = acc[ai][0][m][1] * acc[ai][1][m][1] * (rs * rs); }
                    else {
#pragma unroll
                        for (int j = 0; j < 4; ++j) { v0[j] = acc[ai][0][m][0][j] * rs * silu(acc[ai][1][m][0][j] * rs); v1[j] = acc[ai][0][m][1][j] * rs * silu(acc[ai][1][m][1][j] * rs); } }
                    u32x4 w; w.x = pk2(v0[0], v0[1]); w.y = pk2(v0[2], v0[3]); w.z = pk2(v1[0], v1[1]); w.w = pk2(v1[2], v1[3]);
                    *(u32x4*)(base + (size_t)row * ldc + col0) = w;
                    if (isu && (row & (SEQ - 1)) >= SEQ - 2) { float* cp = convp + ((size_t)(row >> 11) * 2 + ((row & (SEQ - 1)) - (SEQ - 2))) * D + col0; *(f32x4*)cp = v0; *(f32x4*)(cp + 4) = v1; }
                    asm volatile("" ::: "memory"); }
            return;
        }
#pragma unroll
        for (int ai = 0; ai < 2; ++ai)
#pragma unroll
            for (int m = 0; m < 4; ++m) {
                const int row = row0 + ai * HALF + m * 16;
                const float rs = rsv[ai][m];
                bf16_t* rowp = base + (size_t)row * ldc + col0;
#pragma unroll
                for (int bj = 0; bj < 2; ++bj) { const f32x4 v0 = acc[ai][bj][m][0] * rs, v1 = acc[ai][bj][m][1] * rs;
                    u32x4 w; w.x = pk2(v0[0], v0[1]); w.y = pk2(v0[2], v0[3]); w.z = pk2(v1[0], v1[1]); w.w = pk2(v1[2], v1[3]);
                    *(u32x4*)(rowp + bj * HALF) = w; }
                asm volatile("" ::: "memory"); }
    }
};
struct EpiResid {
    bf16_t* xb; float* xout; float* ssn;
    __device__ __forceinline__ void operator()(const f32x4 (&acc)[2][2][4][2], const Unit& u, int wr, int wc, int fr, int fq, int) const {
        const int row0 = u.pm * BM + wr * 64 + fr; const int col0 = u.pn * BM + wc * 32 + 8 * fq;
#pragma unroll
        for (int ai = 0; ai < 2; ++ai)
#pragma unroll
            for (int m = 0; m < 4; ++m) {
                const int row = row0 + ai * HALF + m * 16; float part = 0.f;
#pragma unroll
                for (int bj = 0; bj < 2; ++bj) { const size_t off = (size_t)row * D + col0 + bj * HALF;
                    const u32x4 xw = *(const u32x4*)(xb + off);
                    const f32x4 v0 = acc[ai][bj][m][0] + (f32x4){bflo(xw.x), bfhi(xw.x), bflo(xw.y), bfhi(xw.y)}, v1 = acc[ai][bj][m][1] + (f32x4){bflo(xw.z), bfhi(xw.z), bflo(xw.w), bfhi(xw.w)};
                    if (xout) { __builtin_nontemporal_store(v0, (f32x4*)(xout + off)); __builtin_nontemporal_store(v1, (f32x4*)(xout + off + 4)); }
                    else { u32x4 w; w.x = pk2(v0[0], v0[1]); w.y = pk2(v0[2], v0[3]); w.z = pk2(v1[0], v1[1]); w.w = pk2(v1[2], v1[3]); *(u32x4*)(xb + off) = w;
                        part += (v0[0] * v0[0] + v0[1] * v0[1]) + (v0[2] * v0[2] + v0[3] * v0[3]) + (v1[0] * v1[0] + v1[1] * v1[1]) + (v1[2] * v1[2] + v1[3] * v1[3]); } }
                if (!xout) { part += __shfl_xor(part, 16); part += __shfl_xor(part, 32); if (fq == 0) atomicAdd(ssn + row, part); }
                asm volatile("" ::: "memory"); }
    }
};

template <class Epi>
__device__ __forceinline__ void gemm_phase(LAS unsigned char* lds, const Gemm g, const StaticOrder& S, const Epi& E, const int tid) {
    const int wid = __builtin_amdgcn_readfirstlane(tid >> 6), lane = tid & 63, wr = wid >> 2, wc = wid & 3, fr = lane & 15, fq = lane >> 4;
    const int K = g.K, nt = K / BK;
    unsigned voffA[2], voffB[2];
#pragma unroll
    for (int i = 0; i < 2; ++i) { int R, C; stage_rc(tid * 16 + i * 8192, R, C); const int Rb = (R & ~31) + perm32(R & 31);
        voffA[i] = (unsigned)(R * K + C) * 2u; voffB[i] = (unsigned)(Rb * K + C) * 2u; }
    const size_t kstep = (size_t)(BK * 2);
    const size_t hstep = (size_t)HALF * K * 2;
    const size_t tstep = 2 * hstep;
    const unsigned ldsw = (unsigned)wid * 1024u;
    const int aoff = lds_byte(wr * 64 + fr, fq * 8), boff = lds_byte(wc * 32 + fr, fq * 8);
#define PG8_SA(b, h) (((b) * 2 + (h)) * HTB)
#define PG8_SB(b, h) ((4 + (b) * 2 + (h)) * HTB)
#define PG8_STAGE(bufoff, gbase, voff) do { _Pragma("unroll") for (int _i = 0; _i < 2; ++_i) \
        __builtin_amdgcn_global_load_lds((const unsigned*)((const char*)(gbase) + (voff)[_i]), (LAS unsigned*)(lds + (bufoff) + ldsw + _i * 8192), 16, 0, 0); } while (0)
#define PG8_LDA(dst, b, h) do { _Pragma("unroll") for (int m = 0; m < 4; ++m) _Pragma("unroll") for (int k = 0; k < 2; ++k) dst[m][k] = *(const LAS bf16x8*)(lds + PG8_SA(b, h) + aoff + m * 2048 + k * 1024); } while (0)
#define PG8_LDB(dst, b, h) do { _Pragma("unroll") for (int n = 0; n < 2; ++n) _Pragma("unroll") for (int k = 0; k < 2; ++k) dst[n][k] = *(const LAS bf16x8*)(lds + PG8_SB(b, h) + boff + n * 2048 + k * 1024); } while (0)
#define PG8_MMA(ai, bj, At, Bt) do { __builtin_amdgcn_s_setprio(1); _Pragma("unroll") for (int m = 0; m < 4; ++m) _Pragma("unroll") for (int n = 0; n < 2; ++n) _Pragma("unroll") for (int k = 0; k < 2; ++k) \
        acc[ai][bj][m][n] = __builtin_amdgcn_mfma_f32_16x16x32_bf16(Bt[n][k], At[m][k], acc[ai][bj][m][n], 0, 0, 0); __builtin_amdgcn_s_setprio(0); } while (0)
#define PG8_WAIT_V(n) asm volatile("s_waitcnt vmcnt(" #n ")" ::: "memory")
#define PG8_WAIT_L(n) asm volatile("s_waitcnt lgkmcnt(" #n ")" ::: "memory")
#define PG8_BAR __builtin_amdgcn_s_barrier()
#define PG8_SCHED __builtin_amdgcn_sched_barrier(0)
    Unit cur, nxt; int ui = 0;
    if (!S.next(0, cur)) return;
    f32x4 acc[2][2][4][2];
#pragma unroll
    for (int a = 0; a < 2; ++a)
#pragma unroll
        for (int b = 0; b < 2; ++b)
#pragma unroll
            for (int m = 0; m < 4; ++m)
#pragma unroll
                for (int n = 0; n < 2; ++n) acc[a][b][m][n] = (f32x4){0.f, 0.f, 0.f, 0.f};
    bf16x8 At[4][2], B0[2][2], B1[2][2];
    const char* cA = (const char*)g.A + (size_t)cur.pm * tstep; const char* cB = (const char*)g.Bt + (size_t)cur.pn * tstep;
    PG8_STAGE(PG8_SB(0, 0), cB, voffB); PG8_STAGE(PG8_SA(0, 0), cA, voffA); PG8_STAGE(PG8_SB(0, 1), cB + hstep, voffB); PG8_STAGE(PG8_SA(0, 1), cA + hstep, voffA);
    if (wr == 1) PG8_BAR;
    PG8_WAIT_V(4); PG8_BAR;
    PG8_STAGE(PG8_SB(1, 0), cB + kstep, voffB); PG8_STAGE(PG8_SA(1, 0), cA + kstep, voffA); PG8_STAGE(PG8_SB(1, 1), cB + hstep + kstep, voffB);
    PG8_WAIT_V(6); PG8_BAR;
    for (;;) {
        const bool has_next = S.next(ui + 1, nxt);
        const char* nA = has_next ? (const char*)g.A + (size_t)nxt.pm * tstep : cA; const char* nB = has_next ? (const char*)g.Bt + (size_t)nxt.pn * tstep : cB;
        for (int t = 0; t < nt; t += 2) {
            const bool last = (t == nt - 2);
            const char* a1 = cA + (size_t)(t + 1) * kstep;
            const char* a2 = last ? nA : cA + (size_t)(t + 2) * kstep; const char* b2 = last ? nB : cB + (size_t)(t + 2) * kstep;
            const char* a3 = a2 + kstep; const char* b3 = b2 + kstep;
            PG8_LDB(B0, 0, 0); PG8_SCHED; PG8_LDA(At, 0, 0); PG8_STAGE(PG8_SA(1, 1), a1 + hstep, voffA);
            PG8_WAIT_L(8); PG8_BAR; PG8_WAIT_L(0); PG8_MMA(0, 0, At, B0); PG8_BAR; PG8_SCHED;
            PG8_LDB(B1, 0, 1); PG8_STAGE(PG8_SB(0, 0), b2, voffB);
            PG8_BAR; PG8_WAIT_L(0); PG8_MMA(0, 1, At, B1); PG8_BAR;
            PG8_LDA(At, 0, 1); PG8_STAGE(PG8_SA(0, 0), a2, voffA);
            PG8_BAR; PG8_WAIT_L(0); PG8_MMA(1, 0, At, B0); PG8_BAR; PG8_SCHED;
            PG8_STAGE(PG8_SB(0, 1), b2 + hstep, voffB);
            PG8_WAIT_V(6); PG8_BAR; PG8_MMA(1, 1, At, B1); PG8_BAR;
            PG8_LDB(B0, 1, 0); PG8_SCHED; PG8_LDA(At, 1, 0); PG8_STAGE(PG8_SA(0, 1), a2 + hstep, voffA);
            PG8_WAIT_L(8); PG8_BAR; PG8_WAIT_L(0); PG8_MMA(0, 0, At, B0); PG8_BAR; PG8_SCHED;
            PG8_LDB(B1, 1, 1); PG8_STAGE(PG8_SB(1, 0), b3, voffB);
            PG8_BAR; PG8_WAIT_L(0); PG8_MMA(0, 1, At, B1); PG8_BAR;
            PG8_LDA(At, 1, 1); PG8_STAGE(PG8_SA(1, 0), a3, voffA);
            PG8_BAR; PG8_WAIT_L(0); PG8_MMA(1, 0, At, B0); PG8_BAR; PG8_SCHED;
            PG8_STAGE(PG8_SB(1, 1), b3 + hstep, voffB);
            PG8_WAIT_V(6); PG8_BAR; PG8_MMA(1, 1, At, B1); PG8_BAR;
        }
        E(acc, cur, wr, wc, fr, fq, ui);
        if (!has_next) break;
#pragma unroll
        for (int a = 0; a < 2; ++a)
#pragma unroll
            for (int b = 0; b < 2; ++b)
#pragma unroll
                for (int m = 0; m < 4; ++m)
#pragma unroll
                    for (int n = 0; n < 2; ++n) acc[a][b][m][n] = (f32x4){0.f, 0.f, 0.f, 0.f};
        cur = nxt; cA = nA; cB = nB; ++ui;
    }
    PG8_WAIT_V(0);
    if (wr == 0) PG8_BAR;
    PG8_BAR;
#undef PG8_SA
#undef PG8_SB
#undef PG8_STAGE
#undef PG8_LDA
#undef PG8_LDB
#undef PG8_MMA
#undef PG8_WAIT_V
#undef PG8_WAIT_L
#undef PG8_BAR
#undef PG8_SCHED
}
}

#define XB_TMO      128
#define XB_XCNT(j)  (256  + 64 * (j))
#define XB_XSUB(j)  (1280 + 64 * (j))
#define XB_XGEN(j)  (2304 + 64 * (j))
#define XB_TOP      3328
#define XB_TOPGEN   3392
#define XCD_BAR_WORDS 3456
#define XB_SPIN_CAP (1u << 18)

__device__ __forceinline__ unsigned xb_ld(unsigned* p)              { return __hip_atomic_load(p, __ATOMIC_RELAXED, __HIP_MEMORY_SCOPE_AGENT); }
__device__ __forceinline__ unsigned xb_add(unsigned* p, unsigned v) { return __hip_atomic_fetch_add(p, v, __ATOMIC_RELAXED, __HIP_MEMORY_SCOPE_AGENT); }
__device__ __forceinline__ unsigned xb_xcc_id() { return (unsigned)__builtin_amdgcn_s_getreg((3 << 11) | 20) & 0xFu; }
#define XB_SPIN(cond, bar) do { unsigned _sp = 0; while (cond) { __builtin_amdgcn_s_sleep(1); \
    if ((++_sp & 255u) == 0u) { if (xb_ld(&(bar)[XB_TMO])) break; if (_sp > XB_SPIN_CAP) { atomicAdd(&(bar)[XB_TMO], 1u); break; } } } } while (0)

struct XcdBarrier {
    unsigned* bar; unsigned x;
    volatile LAS unsigned* st;
};

__device__ __forceinline__ XcdBarrier xcd_barrier_post(unsigned* bar, volatile LAS unsigned* st) {
    XcdBarrier b; b.bar = bar; b.x = xb_xcc_id(); b.st = st;
    if (threadIdx.x == 0) (void)xb_add(&bar[XB_XCNT(b.x)], 1u);
    return b;
}
__device__ __forceinline__ void xcd_barrier_complete(unsigned* bar, unsigned x, unsigned& nloc, unsigned& nx) {
    const unsigned G = gridDim.x * gridDim.y * gridDim.z;
    unsigned sum, cnt, mine, sp = 0u;
    for (;;) {
        sum = 0u; cnt = 0u; mine = 0u;
#pragma unroll
        for (unsigned j = 0; j < 16; ++j) { const unsigned c = xb_ld(&bar[XB_XCNT(j)]); sum += c; cnt += (c > 0u) ? 1u : 0u; mine = (j == x) ? c : mine; }
        if (sum == G) break;
        __builtin_amdgcn_s_sleep(1);
        if ((++sp & 255u) == 0u) { if (xb_ld(&bar[XB_TMO])) break; if (sp > XB_SPIN_CAP) { atomicAdd(&bar[XB_TMO], 1u); break; } }
    }
    nloc = mine > 0u ? mine : 1u; nx = cnt > 0u ? cnt : 1u;
}

__device__ __forceinline__ void xcd_barrier(const XcdBarrier& b) {
    asm volatile("s_waitcnt vmcnt(0)" ::: "memory");
    __syncthreads();
    if (threadIdx.x == 0) {
        unsigned* bar = b.bar;
        __builtin_amdgcn_s_waitcnt(0);
        unsigned nloc = b.st[0], nx = b.st[1];
        if (nloc == 0u) { xcd_barrier_complete(bar, b.x, nloc, nx); b.st[0] = nloc; b.st[1] = nx; }
        const unsigned old = xb_add(&bar[XB_XSUB(b.x)], 1u);
        const unsigned gen = old / nloc;
        if (old + 1u == (gen + 1u) * nloc) {
            __builtin_amdgcn_fence(__ATOMIC_RELEASE, "agent");
            asm volatile("s_waitcnt vmcnt(0)" ::: "memory");
            const unsigned og = xb_add(&bar[XB_TOP], 1u);
            const unsigned tg = og / nx;
            if (og + 1u == (tg + 1u) * nx) xb_add(&bar[XB_TOPGEN], 1u);
            else XB_SPIN(xb_ld(&bar[XB_TOPGEN]) == tg, bar);
            __builtin_amdgcn_fence(__ATOMIC_ACQUIRE, "agent");
            xb_add(&bar[XB_XGEN(b.x)], 1u);
            asm volatile("s_waitcnt vmcnt(0)" ::: "memory");
        } else {
            XB_SPIN(xb_ld(&bar[XB_XGEN(b.x)]) == gen, bar);
            __builtin_amdgcn_fence(__ATOMIC_ACQUIRE, "agent");
            asm volatile("s_waitcnt vmcnt(0)" ::: "memory");
        }
    }
    __syncthreads();
}

struct Params {
    const float* in[23];
    float* out;
    unsigned char* ws;
    int ph_lo, ph_hi;
};

struct Ctx {
    const float* const* in; float* out; unsigned char* ws; LAS unsigned char* lds;
    int tid, lane, wid, G, bid;
};
__device__ __forceinline__ int fresh_tid(int wid) { unsigned z = 0u; asm volatile("" : "+v"(z)); return wid * 64 + (int)__builtin_amdgcn_mbcnt_hi(~0u, __builtin_amdgcn_mbcnt_lo(~0u, z)); }
__device__ __forceinline__ Ctx launder(const Ctx& C0) { Ctx C = C0;
    int w = C0.wid, g = C0.G, b = C0.bid; asm volatile("" : "+s"(w), "+s"(g), "+s"(b));
    unsigned z = 0u; asm volatile("" : "+v"(z));
    int t = w * 64 + (int)__builtin_amdgcn_mbcnt_hi(~0u, __builtin_amdgcn_mbcnt_lo(~0u, z));
    asm volatile("" : "+v"(t)); C.tid = t; C.lane = t & 63; C.wid = w; C.G = g; C.bid = b; return C; }

__device__ __forceinline__ int perm_a(int n) { if (n >= 4096) return n; const int part = n >> 10, j = n & 1023; return (part >> 1) * 2048 + (j >> 7) * 256 + (part & 1) * 128 + (j & 127); }
__device__ __forceinline__ void p0_transpose_item(const float* W, int K, int N, bf16_t* WT, int row_off, const float* gain, LAS float* scr, int item, int lane, bool pa = false) {
    const int nblk = N / 32, kb = item / nblk, nb = item % nblk, k0 = 64 * kb, n0 = 32 * nb;
    if (pa) row_off = perm_a(n0) - n0;
    float wv[32];
#pragma unroll
    for (int i = 0; i < 32; ++i) wv[i] = __builtin_nontemporal_load(W + (size_t)(k0 + 2 * i + (lane >> 5)) * N + n0 + (lane & 31));
    const float gl = gain ? gain[k0 + lane] : 1.0f;
#pragma unroll
    for (int i = 0; i < 32; ++i) { const int kk = 2 * i + (lane >> 5); const float gv = __shfl(gl, kk); scr[kk * 33 + (lane & 31)] = wv[i] * gv; }
    asm volatile("s_waitcnt lgkmcnt(0)" ::: "memory");
    const int c = lane & 7;
#pragma unroll
    for (int j = 0; j < 4; ++j) { const int n = (lane >> 3) + 8 * j; const LAS float* s = scr + (8 * c) * 33 + n;
        u32x4 o; o.x = pk2(s[0 * 33], s[1 * 33]); o.y = pk2(s[2 * 33], s[3 * 33]); o.z = pk2(s[4 * 33], s[5 * 33]); o.w = pk2(s[6 * 33], s[7 * 33]);
        *(u32x4*)(WT + (size_t)(row_off + n0 + n) * K + k0 + 8 * c) = o; }
    asm volatile("s_waitcnt lgkmcnt(0)" ::: "memory");
}
__device__ __forceinline__ void row_cvt_ss(const float* xrow, bf16_t* orow, float* ssp, int lane) {
    const f32x4* xr = (const f32x4*)xrow + lane; f32x4 v[4]; float s = 0.f;
#pragma unroll
    for (int j = 0; j < 4; ++j) { v[j] = xr[64 * j]; s += (v[j].x * v[j].x + v[j].y * v[j].y) + (v[j].z * v[j].z + v[j].w * v[j].w); }
    s = wave_sum(s);
    u32x2* o8 = (u32x2*)orow + lane;
#pragma unroll
    for (int j = 0; j < 4; ++j) { u32x2 w; w.x = pk2(v[j].x, v[j].y); w.y = pk2(v[j].z, v[j].w); o8[64 * j] = w; }
    if (lane == 0) *ssp = s;
}
constexpr int I_MEM = 16 * 32, I_INA = 16 * 160, I_OUTA = 24 * 32, I_KV = 16 * 96, I_INB = 16 * 96, I_OUTB = 16 * 32;
constexpr int P0_NITEMS = 4 * I_MEM + 2 * I_INA + 2 * I_OUTA + I_KV + 2 * I_INB + 2 * I_OUTB, P0_EARLY = 4 * I_MEM + 2 * I_INA + 2 * I_OUTA;
__device__ __forceinline__ void p0_weights(const Ctx& C, int lo, int hi, int gw, int ngw) {
    LAS float* scr = (LAS float*)(C.lds + C.wid * 16384);
    bf16_t* Wmem = (bf16_t*)(C.ws + WS_WMEM); bf16_t* Wina = (bf16_t*)(C.ws + WS_WINA); bf16_t* Wouta = (bf16_t*)(C.ws + WS_WOUTA);
    bf16_t* Wkvb = (bf16_t*)(C.ws + WS_WKVB); bf16_t* Winb1 = (bf16_t*)(C.ws + WS_WINB1); bf16_t* Woutb = (bf16_t*)(C.ws + WS_WOUTB);
    for (int it = lo + gw; it < hi; it += ngw) {
        int r = it;
        if (r < 4 * I_MEM) { const int l = r / I_MEM; p0_transpose_item(C.in[20] + (size_t)l * D * 1024, D, 1024, Wmem, l * 1024, C.in[19] + l * D, scr, r % I_MEM, C.lane); continue; } r -= 4 * I_MEM;
        if (r < 2 * I_INA) { const int a = r / I_INA; p0_transpose_item(C.in[9] + (size_t)a * D * NINA, D, NINA, Wina + (size_t)a * NINA * D, 0, C.in[8] + a * D, scr, r % I_INA, C.lane, true); continue; } r -= 2 * I_INA;
        if (r < 2 * I_OUTA) { const int a = r / I_OUTA; p0_transpose_item(C.in[11] + (size_t)a * KOUTA * D, KOUTA, D, Wouta + (size_t)a * D * KOUTA, 0, nullptr, scr, r % I_OUTA, C.lane); continue; } r -= 2 * I_OUTA;
        if (r < I_KV) { p0_transpose_item(C.in[17], D, 3072, Wkvb, 0, C.in[16], scr, r, C.lane); continue; } r -= I_KV;
        if (r < 2 * I_INB) { const int bl = r / I_INB; p0_transpose_item(C.in[13] + (size_t)bl * D * NINB, D, NINB, bl ? Winb1 : Wkvb, bl ? 0 : 3072, C.in[12] + bl * D, scr, r % I_INB, C.lane); continue; } r -= 2 * I_INB;
        { const int bl = r / I_OUTB; p0_transpose_item(C.in[15] + (size_t)bl * KOUTB * D, KOUTB, D, Woutb + (size_t)bl * D * KOUTB, 0, nullptr, scr, r % I_OUTB, C.lane); }
    }
}
__device__ __forceinline__ void p0_prologue(const Ctx& C) {
    const int gw = C.bid * 8 + C.wid, NGW = C.G * 8;
    p0_weights(C, 0, P0_EARLY, gw, NGW);
    bf16_t* XB = (bf16_t*)(C.ws + WS_XB); bf16_t* MEMN = (bf16_t*)(C.ws + WS_MEMN); float* SS = (float*)(C.ws + WS_SS);
    for (int m = 2 * gw; m < MR + 2048; m += 2 * NGW) {
        const float* src; bf16_t* dst; float* ssp;
        if (m < MP) { src = C.in[0] + (size_t)m * D; dst = XB + (size_t)m * D; ssp = SS + m; }
        else if (m < MR) { src = C.in[1] + (size_t)(m - MP) * D; dst = XB + (size_t)m * D; ssp = SS + m; }
        else { src = C.in[7] + (size_t)(m - MR) * D; dst = MEMN + (size_t)(m - MR) * D; ssp = SS + 4 * SS_STRIDE + (m - MR); }
        const f32x4* xr = (const f32x4*)src + C.lane; f32x4 v[8]; float s0 = 0.f, s1 = 0.f;
#pragma unroll
        for (int j = 0; j < 8; ++j) v[j] = __builtin_nontemporal_load(xr + 64 * j);
#pragma unroll
        for (int j = 0; j < 4; ++j) { s0 += (v[j].x * v[j].x + v[j].y * v[j].y) + (v[j].z * v[j].z + v[j].w * v[j].w); s1 += (v[4 + j].x * v[4 + j].x + v[4 + j].y * v[4 + j].y) + (v[4 + j].z * v[4 + j].z + v[4 + j].w * v[4 + j].w); }
        s0 = wave_sum(s0); s1 = wave_sum(s1);
        u32x2* o8 = (u32x2*)dst + C.lane;
#pragma unroll
        for (int j = 0; j < 8; ++j) { u32x2 w; w.x = pk2(v[j].x, v[j].y); w.y = pk2(v[j].z, v[j].w); o8[64 * j] = w; }
        if (C.lane == 0) { ssp[0] = s0; ssp[1] = s1; }
    }
    for (int i = C.bid * 512 + C.tid; i < 3 * SS_STRIDE; i += C.G * 512) SS[SS_STRIDE + i] = 0.f;
}

template <class F>
__device__ __forceinline__ void sgemm_tile(const Ctx& C, const bf16_t* A, int lda, const bf16_t* Bt, int K, int tile, float* ssrow, F epi) {
    LAS float* red = (LAS float*)C.lds;
    int lane = C.lane; asm volatile("" : "+v"(lane));
    const int r = lane & 31, h = lane >> 5, kc = K / 8, k0 = C.wid * kc, nst = kc / 16;
    f32x16 acc; for (int i = 0; i < 16; ++i) acc[i] = 0.f;
    const bf16_t* ap = A + (size_t)r * lda + k0 + 8 * h;
    const bf16_t* bp = Bt + (size_t)(tile * 32 + r) * K + k0 + 8 * h;
    bf16x8 av[12], bv[12];
#pragma unroll
    for (int s = 0; s < 12; ++s) if (s < nst) { av[s] = *(const bf16x8*)(ap + 16 * s); bv[s] = *(const bf16x8*)(bp + 16 * s); }
#pragma unroll
    for (int s = 0; s < 12; ++s) if (s < nst) acc = __builtin_amdgcn_mfma_f32_32x32x16_bf16(av[s], bv[s], acc, 0, 0, 0);
#pragma unroll
    for (int i = 0; i < 16; ++i) { const int row = (i & 3) + 8 * (i >> 2) + 4 * h; red[(C.wid * 32 + row) * 32 + r] = acc[i]; }
    __syncthreads();
#pragma unroll
    for (int rep = 0; rep < 2; ++rep) { const int idx = C.tid + 512 * rep; float v = 0.f;
#pragma unroll
        for (int w = 0; w < 8; ++w) v += red[w * 1024 + idx];
        float sq = epi(idx >> 5, tile * 32 + (idx & 31), v);
        if (ssrow) { sq += __shfl_xor(sq, 16); sq += __shfl_xor(sq, 8); sq += __shfl_xor(sq, 4); sq += __shfl_xor(sq, 2); sq += __shfl_xor(sq, 1);
            if ((lane & 31) == 0) atomicAdd(ssrow + (idx >> 5), sq); } }
    __syncthreads();
}

__device__ __forceinline__ unsigned off_b(unsigned row, unsigned ch) { return 256u * row + 16u * (ch ^ (((row & 3) << 2) | ((row >> 2) & 3))); }
struct AttnP {
    const bf16_t* q; int ldq, qrow0, qrstep;
    const bf16_t* k; const bf16_t* v; int ldk, krow0, krstep;
    const float* gq; const float* gk;
    int mode;
    float* kvout; int kv_jfrom; size_t kv_ostride;
    bf16_t* o; int ldo;
    const bf16_t* gate;
    float* lse;
    const bf16_t* cdil; const float* clse;
};
struct NextKV { const bf16_t* k; int ldk, krow0, krstep, it0, valid; };
__device__ __forceinline__ void attn_item(const Ctx& C, const AttnP& P, u32x4 (&kw)[8], u32x4 (&vw)[8], const bool have, const NextKV& nx) {
    const int tid = fresh_tid(C.wid);
    const int lane = tid & 63, wid = C.wid, r = lane & 31, h = lane >> 5, qb = wid & 3, kh = wid >> 2;
    LAS unsigned char* Kl = C.lds; LAS unsigned char* Vl = C.lds + 65536;
    bf16x8 qf[8];
    const int qrow = P.qrow0 + (32 * qb + r) * P.qrstep;
    {
        const int c = tid & 15, kr = tid >> 4, it0 = (P.mode == 2 ? 4 : 0);
        const bf16_t* qp = P.q + (size_t)qrow * P.ldq + 8 * h;
        u32x4 raw[8];
#pragma unroll
        for (int s = 0; s < 8; ++s) raw[s] = *(const u32x4*)(qp + 16 * s);
        if (!have) {
#pragma unroll
            for (int it = 0; it < 8; ++it) if (it >= it0) { const size_t row = (size_t)(P.krow0 + (kr + 32 * it) * P.krstep);
                kw[it] = *(const u32x4*)(P.k + row * P.ldk + 8 * c); vw[it] = *(const u32x4*)(P.v + row * P.ldk + 8 * c); } }
        float ss = 0.f;
#pragma unroll
        for (int s = 0; s < 8; ++s)
#pragma unroll
            for (int j = 0; j < 4; ++j) { const float a = bflo(raw[s][j]), b = bfhi(raw[s][j]); ss += a * a + b * b; }
        ss += __shfl_xor(ss, 32);
        const float rs = rsqrtf(ss * (1.0f / 128.0f) + EPS) * QSCALE;
#pragma unroll
        for (int s = 0; s < 8; ++s) {
            u32x4 w; w.x = pk2(bflo(raw[s][0]) * rs, bfhi(raw[s][0]) * rs); w.y = pk2(bflo(raw[s][1]) * rs, bfhi(raw[s][1]) * rs);
            w.z = pk2(bflo(raw[s][2]) * rs, bfhi(raw[s][2]) * rs); w.w = pk2(bflo(raw[s][3]) * rs, bfhi(raw[s][3]) * rs);
            qf[s] = __builtin_bit_cast(bf16x8, w); }
        const f32x4 gk0 = *(const f32x4*)(P.gk + 8 * c), gk1 = *(const f32x4*)(P.gk + 8 * c + 4);
        const f32x4 gq0 = *(const f32x4*)(P.gq + 8 * c), gq1 = *(const f32x4*)(P.gq + 8 * c + 4);
#pragma unroll
        for (int it = 0; it < 8; ++it) if (it >= it0) {
            const int j = kr + 32 * it;
            f32x4 k0 = {bflo(kw[it].x), bfhi(kw[it].x), bflo(kw[it].y), bfhi(kw[it].y)}, k1 = {bflo(kw[it].z), bfhi(kw[it].z), bflo(kw[it].w), bfhi(kw[it].w)};
            float s2 = (k0[0] * k0[0] + k0[1] * k0[1]) + (k0[2] * k0[2] + k0[3] * k0[3]) + (k1[0] * k1[0] + k1[1] * k1[1]) + (k1[2] * k1[2] + k1[3] * k1[3]);
            s2 = row16_sum(s2);
            const float rk = rsqrtf(s2 * (1.0f / 128.0f) + EPS);
            k0 = k0 * rk * gk0; k1 = k1 * rk * gk1;
            const f32x4 kq0 = k0 * gq0, kq1 = k1 * gq1;
            u32x4 w; w.x = pk2(kq0[0], kq0[1]); w.y = pk2(kq0[2], kq0[3]); w.z = pk2(kq1[0], kq1[1]); w.w = pk2(kq1[2], kq1[3]);
            *(LAS u32x4*)(Kl + off_b(j, c)) = w; *(LAS u32x4*)(Vl + off_b(j, c)) = vw[it];
            if (j >= P.kv_jfrom) { float* o = P.kvout + (size_t)(j - P.kv_jfrom) * P.kv_ostride + 8 * c;
                __builtin_nontemporal_store(k0, (f32x4*)o); __builtin_nontemporal_store(k1, (f32x4*)(o + 4));
                __builtin_nontemporal_store((f32x4){bflo(vw[it].x), bfhi(vw[it].x), bflo(vw[it].y), bfhi(vw[it].y)}, (f32x4*)(o + 512)); __builtin_nontemporal_store((f32x4){bflo(vw[it].z), bfhi(vw[it].z), bflo(vw[it].w), bfhi(vw[it].w)}, (f32x4*)(o + 516)); }
        }
    }
    __syncthreads();
    f32x16 o[4]; float mrow = -1e30f, lrow = 0.f;
    const bool active = !(P.mode == 2 && kh == 0);
    u32x4 pb[4][2];
    if (active) {
        {
            f32x16 sacc[4];
            const unsigned xr = ((r & 3) << 2) | ((r >> 2) & 3);
            unsigned kaddr[8];
#pragma unroll
            for (int s = 0; s < 8; ++s) kaddr[s] = 256u * (128 * kh + r) + 16u * ((unsigned)(2 * s + h) ^ xr);
#pragma unroll
            for (int kt = 0; kt < 4; ++kt) { for (int i = 0; i < 16; ++i) sacc[kt][i] = -1e30f;
                if (P.mode == 0 || (kh ? kt <= qb : kt >= qb)) {
                    for (int i = 0; i < 16; ++i) sacc[kt][i] = 0.f;
#pragma unroll
                    for (int s = 0; s < 8; ++s) { const bf16x8 a = *(const LAS bf16x8*)(Kl + kaddr[s] + 8192 * kt); sacc[kt] = __builtin_amdgcn_mfma_f32_32x32x16_bf16(a, qf[s], sacc[kt], 0, 0, 0); } }
                asm volatile("" ::: "memory"); }
            const int qi = 32 * qb + r;
            if (P.mode != 0) {
#pragma unroll
                for (int kt = 0; kt < 4; ++kt)
#pragma unroll
                    for (int i = 0; i < 16; ++i) { const int kj = 32 * kt + (i & 3) + 8 * (i >> 2) + 4 * h; const bool valid = kh ? (kj <= qi) : (kj >= qi); sacc[kt][i] = valid ? sacc[kt][i] : -1e30f; }
            }
            float m = -1e30f;
#pragma unroll
            for (int kt = 0; kt < 4; ++kt)
#pragma unroll
                for (int i = 0; i < 16; ++i) m = fmaxf(m, sacc[kt][i]);
            m = fmaxf(m, __shfl_xor(m, 32));
            float l = 0.f;
#pragma unroll
            for (int kt = 0; kt < 4; ++kt)
#pragma unroll
                for (int s2 = 0; s2 < 2; ++s2) {
                    float pv[8];
#pragma unroll
                    for (int j = 0; j < 8; ++j) { pv[j] = __builtin_amdgcn_exp2f(sacc[kt][8 * s2 + j] - m); l += pv[j]; }
                    pb[kt][s2].x = pk2(pv[0], pv[1]); pb[kt][s2].y = pk2(pv[2], pv[3]); pb[kt][s2].z = pk2(pv[4], pv[5]); pb[kt][s2].w = pk2(pv[6], pv[7]);
                }
            l += __shfl_xor(l, 32);
            mrow = m; lrow = l;
        }
    }
    if (nx.valid) {
        const int c = tid & 15, kr = tid >> 4;
#pragma unroll
        for (int it = 0; it < 8; ++it) if (it >= nx.it0) { const size_t row = (size_t)(nx.krow0 + (kr + 32 * it) * nx.krstep);
            kw[it] = *(const u32x4*)(nx.k + row * nx.ldk + 8 * c); vw[it] = *(const u32x4*)(nx.k + 512 + row * nx.ldk + 8 * c); }
    }
#pragma unroll
    for (int et = 0; et < 4; ++et) for (int i = 0; i < 16; ++i) o[et][i] = 0.f;
    if (active) {
        const int q4 = (lane & 15) >> 2, p4 = lane & 3, blk = (lane >> 4) & 1, clow = 2 * blk + (p4 >> 1);
        unsigned vaddr[4][2];
#pragma unroll
        for (int et = 0; et < 4; ++et)
#pragma unroll
            for (int hi = 0; hi < 2; ++hi) vaddr[et][hi] = 256u * (128 * kh + 4 * h + q4 + 8 * hi) + 64u * (unsigned)(et ^ q4) + 16u * (unsigned)(clow ^ (h + 2 * hi)) + 8u * (p4 & 1);
#pragma unroll
        for (int kt = 0; kt < 4; ++kt)
#pragma unroll
            for (int s2 = 0; s2 < 2; ++s2) if (P.mode == 0 || (kh ? kt <= qb : kt >= qb)) {
                const bf16x8 pbv = __builtin_bit_cast(bf16x8, pb[kt][s2]);
#pragma unroll
                for (int et = 0; et < 4; ++et) {
                    const s16x4 lo = __builtin_amdgcn_ds_read_tr16_b64_v4i16((LAS s16x4*)(Vl + vaddr[et][0] + 8192 * kt + 4096 * s2));
                    const s16x4 hi = __builtin_amdgcn_ds_read_tr16_b64_v4i16((LAS s16x4*)(Vl + vaddr[et][1] + 8192 * kt + 4096 * s2));
                    const bf16x8 va = __builtin_shufflevector(lo, hi, 0, 1, 2, 3, 4, 5, 6, 7);
                    o[et] = __builtin_amdgcn_mfma_f32_32x32x16_bf16(va, pbv, o[et], 0, 0, 0);
                }
                asm volatile("" ::: "memory");
            }
    }
    __syncthreads();
    LAS float* Mo = (LAS float*)C.lds;
    LAS float* Mml = (LAS float*)(C.lds + 65536);
    if (kh == 1) {
#pragma unroll
        for (int et = 0; et < 4; ++et)
#pragma unroll
            for (int i = 0; i < 16; ++i) { const int e = 32 * et + (i & 3) + 8 * (i >> 2) + 4 * h; Mo[(qb * 128 + e) * 32 + r] = o[et][i]; }
        if (h == 0) { Mml[(qb * 2 + 0) * 32 + r] = mrow; Mml[(qb * 2 + 1) * 32 + r] = lrow; }
    }
    __syncthreads();
    LAS unsigned char* Ot = C.lds + 65536 + 2048;
    if (kh == 0) {
        const float m1 = Mml[(qb * 2 + 0) * 32 + r], l1 = Mml[(qb * 2 + 1) * 32 + r];
        const float m = fmaxf(mrow, m1), w0 = __builtin_amdgcn_exp2f(mrow - m), w1 = __builtin_amdgcn_exp2f(m1 - m), l = lrow * w0 + l1 * w1, inv = 1.0f / l;
        const float a0 = w0 * inv, a1 = w1 * inv;
#pragma unroll
        for (int et = 0; et < 4; ++et)
#pragma unroll
            for (int g4 = 0; g4 < 4; ++g4) {
                const int e0 = 32 * et + 8 * g4 + 4 * h;
                float v[4];
#pragma unroll
                for (int j = 0; j < 4; ++j) v[j] = o[et][4 * g4 + j] * a0 + Mo[(qb * 128 + e0 + j) * 32 + r] * a1;
                u32x2 w; w.x = pk2(v[0], v[1]); w.y = pk2(v[2], v[3]);
                *(LAS u32x2*)(Ot + (32 * qb + r) * 272 + 2 * e0) = w;
            }
        if (P.mode != 0 && h == 0) P.lse[(size_t)qrow * 4] = m + log2f(l);
    }
    __syncthreads();
#pragma unroll
    for (int i = 0; i < 4; ++i) { const int id = tid + 512 * i, qi = id >> 4, c = id & 15; const size_t grow = (size_t)(P.qrow0 + qi * P.qrstep);
        u32x4 w = *(const LAS u32x4*)(Ot + qi * 272 + 16 * c);
        if (P.mode == 0) { const u32x4 gw = *(const u32x4*)(P.gate + grow * P.ldq + 8 * c);
#pragma unroll
            for (int j = 0; j < 4; ++j) w[j] = pk2(bflo(w[j]) * silu(bflo(gw[j])), bfhi(w[j]) * silu(bfhi(gw[j]))); }
        *(u32x4*)(P.o + grow * P.ldo + 8 * c) = w;
        if (P.cdil) {
            const float l0 = P.clse[grow * 4], l1 = P.clse[((size_t)MR + grow) * 4], l2 = P.clse[((size_t)2 * MR + grow) * 4];
            const float mm = fmaxf(l0, fmaxf(l1, l2)); float w0 = __builtin_amdgcn_exp2f(l0 - mm), w1 = __builtin_amdgcn_exp2f(l1 - mm), w2 = __builtin_amdgcn_exp2f(l2 - mm); const float inv = 1.0f / (w0 + w1 + w2);
            w0 *= inv; w1 *= inv; w2 *= inv;
            const u32x4 a = *(const u32x4*)(P.cdil + grow * 512 + 8 * c), b = *(const u32x4*)(P.cdil + ((size_t)MR + grow) * 512 + 8 * c),
                        cc = *(const u32x4*)(P.cdil + ((size_t)2 * MR + grow) * 512 + 8 * c), gd = *(const u32x4*)(P.gate - 1024 + grow * P.ldq + 8 * c);
            u32x4 wo;
#pragma unroll
            for (int j = 0; j < 4; ++j) wo[j] = pk2((bflo(a[j]) * w0 + bflo(b[j]) * w1 + bflo(cc[j]) * w2) * silu(bflo(gd[j])), (bfhi(a[j]) * w0 + bfhi(b[j]) * w1 + bfhi(cc[j]) * w2) * silu(bfhi(gd[j])));
            *(u32x4*)(P.o - 512 + grow * P.ldo + 8 * c) = wo; } }
    __syncthreads();
}

__device__ __forceinline__ void attn_item_wide(const Ctx& C, const AttnP& P, u32x4 (&kw)[8], u32x4 (&vw)[8], const bool have, const NextKV& nx) {
    const int tid = fresh_tid(C.wid);
    const int lane = tid & 63, wid = C.wid, r = lane & 31, h = lane >> 5;
    LAS unsigned char* Kl = C.lds; LAS unsigned char* Vl = C.lds + 65536;
    bf16x8 qf[8];
    const int qrow = P.qrow0 + 32 * wid + r;
    {
        const int c = tid & 15, kr = tid >> 4;
        const bf16_t* qp = P.q + (size_t)qrow * P.ldq + 8 * h;
        u32x4 raw[8];
#pragma unroll
        for (int s = 0; s < 8; ++s) raw[s] = *(const u32x4*)(qp + 16 * s);
        if (!have) {
#pragma unroll
            for (int it = 0; it < 8; ++it) { const size_t row = (size_t)(P.krow0 + (kr + 32 * it) * P.krstep);
                kw[it] = *(const u32x4*)(P.k + row * P.ldk + 8 * c); vw[it] = *(const u32x4*)(P.v + row * P.ldk + 8 * c); } }
        float ss = 0.f;
#pragma unroll
        for (int s = 0; s < 8; ++s)
#pragma unroll
            for (int j = 0; j < 4; ++j) { const float a = bflo(raw[s][j]), b = bfhi(raw[s][j]); ss += a * a + b * b; }
        ss += __shfl_xor(ss, 32);
        const float rs = rsqrtf(ss * (1.0f / 128.0f) + EPS) * QSCALE;
#pragma unroll
        for (int s = 0; s < 8; ++s) {
            u32x4 w; w.x = pk2(bflo(raw[s][0]) * rs, bfhi(raw[s][0]) * rs); w.y = pk2(bflo(raw[s][1]) * rs, bfhi(raw[s][1]) * rs);
            w.z = pk2(bflo(raw[s][2]) * rs, bfhi(raw[s][2]) * rs); w.w = pk2(bflo(raw[s][3]) * rs, bfhi(raw[s][3]) * rs);
            qf[s] = __builtin_bit_cast(bf16x8, w); }
        const f32x4 gk0 = *(const f32x4*)(P.gk + 8 * c), gk1 = *(const f32x4*)(P.gk + 8 * c + 4);
        const f32x4 gq0 = *(const f32x4*)(P.gq + 8 * c), gq1 = *(const f32x4*)(P.gq + 8 * c + 4);
#pragma unroll
        for (int it = 0; it < 8; ++it) {
            const int j = kr + 32 * it;
            f32x4 k0 = {bflo(kw[it].x), bfhi(kw[it].x), bflo(kw[it].y), bfhi(kw[it].y)}, k1 = {bflo(kw[it].z), bfhi(kw[it].z), bflo(kw[it].w), bfhi(kw[it].w)};
            float s2 = (k0[0] * k0[0] + k0[1] * k0[1]) + (k0[2] * k0[2] + k0[3] * k0[3]) + (k1[0] * k1[0] + k1[1] * k1[1]) + (k1[2] * k1[2] + k1[3] * k1[3]);
            s2 = row16_sum(s2);
            const float rk = rsqrtf(s2 * (1.0f / 128.0f) + EPS);
            k0 = k0 * rk * gk0; k1 = k1 * rk * gk1;
            const f32x4 kq0 = k0 * gq0, kq1 = k1 * gq1;
            u32x4 w; w.x = pk2(kq0[0], kq0[1]); w.y = pk2(kq0[2], kq0[3]); w.z = pk2(kq1[0], kq1[1]); w.w = pk2(kq1[2], kq1[3]);
            *(LAS u32x4*)(Kl + off_b(j, c)) = w; *(LAS u32x4*)(Vl + off_b(j, c)) = vw[it];
            if (j >= P.kv_jfrom) { float* o = P.kvout + (size_t)(j - P.kv_jfrom) * P.kv_ostride + 8 * c;
                __builtin_nontemporal_store(k0, (f32x4*)o); __builtin_nontemporal_store(k1, (f32x4*)(o + 4));
                __builtin_nontemporal_store((f32x4){bflo(vw[it].x), bfhi(vw[it].x), bflo(vw[it].y), bfhi(vw[it].y)}, (f32x4*)(o + 512)); __builtin_nontemporal_store((f32x4){bflo(vw[it].z), bfhi(vw[it].z), bflo(vw[it].w), bfhi(vw[it].w)}, (f32x4*)(o + 516)); }
        }
    }
    __syncthreads();
    f32x16 o[4]; float mrun = -1e30f, lrun = 0.f;
#pragma unroll
    for (int et = 0; et < 4; ++et) for (int i = 0; i < 16; ++i) o[et][i] = 0.f;
    const unsigned xr = ((r & 3) << 2) | ((r >> 2) & 3);
    const int q4 = (lane & 15) >> 2, p4 = lane & 3, blk = (lane >> 4) & 1, clow = 2 * blk + (p4 >> 1);
#pragma unroll
    for (int st = 0; st < 4; ++st) {
        u32x4 pb[2][2];
        {
            f32x16 sacc[2];
            unsigned kaddr[8];
#pragma unroll
            for (int s = 0; s < 8; ++s) kaddr[s] = 256u * (64 * st + r) + 16u * ((unsigned)(2 * s + h) ^ xr);
#pragma unroll
            for (int kt = 0; kt < 2; ++kt) { for (int i = 0; i < 16; ++i) sacc[kt][i] = 0.f;
#pragma unroll
                for (int s = 0; s < 8; ++s) { const bf16x8 a = *(const LAS bf16x8*)(Kl + kaddr[s] + 8192 * kt); sacc[kt] = __builtin_amdgcn_mfma_f32_32x32x16_bf16(a, qf[s], sacc[kt], 0, 0, 0); }
                asm volatile("" ::: "memory"); }
            float m = mrun;
#pragma unroll
            for (int kt = 0; kt < 2; ++kt)
#pragma unroll
                for (int i = 0; i < 16; ++i) m = fmaxf(m, sacc[kt][i]);
            m = fmaxf(m, __shfl_xor(m, 32));
            const float alpha = __builtin_amdgcn_exp2f(mrun - m);
            float l = 0.f;
#pragma unroll
            for (int kt = 0; kt < 2; ++kt)
#pragma unroll
                for (int s2 = 0; s2 < 2; ++s2) {
                    float pv[8];
#pragma unroll
                    for (int j = 0; j < 8; ++j) { pv[j] = __builtin_amdgcn_exp2f(sacc[kt][8 * s2 + j] - m); l += pv[j]; }
                    pb[kt][s2].x = pk2(pv[0], pv[1]); pb[kt][s2].y = pk2(pv[2], pv[3]); pb[kt][s2].z = pk2(pv[4], pv[5]); pb[kt][s2].w = pk2(pv[6], pv[7]);
                }
            l += __shfl_xor(l, 32);
            lrun = lrun * alpha + l; mrun = m;
#pragma unroll
            for (int et = 0; et < 4; ++et) o[et] = o[et] * alpha;
        }
        if (st == 3 && nx.valid) {
            const int c = tid & 15, kr = tid >> 4;
#pragma unroll
            for (int it = 0; it < 8; ++it) if (it >= nx.it0) { const size_t row = (size_t)(nx.krow0 + (kr + 32 * it) * nx.krstep);
                kw[it] = *(const u32x4*)(nx.k + row * nx.ldk + 8 * c); vw[it] = *(const u32x4*)(nx.k + 512 + row * nx.ldk + 8 * c); }
        }
        unsigned vaddr[4][2];
#pragma unroll
        for (int et = 0; et < 4; ++et)
#pragma unroll
            for (int hi = 0; hi < 2; ++hi) vaddr[et][hi] = 256u * (64 * st + 4 * h + q4 + 8 * hi) + 64u * (unsigned)(et ^ q4) + 16u * (unsigned)(clow ^ (h + 2 * hi)) + 8u * (p4 & 1);
#pragma unroll
        for (int kt = 0; kt < 2; ++kt)
#pragma unroll
            for (int s2 = 0; s2 < 2; ++s2) {
                const bf16x8 pbv = __builtin_bit_cast(bf16x8, pb[kt][s2]);
#pragma unroll
                for (int et = 0; et < 4; ++et) {
                    const s16x4 lo = __builtin_amdgcn_ds_read_tr16_b64_v4i16((LAS s16x4*)(Vl + vaddr[et][0] + 8192 * kt + 4096 * s2));
                    const s16x4 hi = __builtin_amdgcn_ds_read_tr16_b64_v4i16((LAS s16x4*)(Vl + vaddr[et][1] + 8192 * kt + 4096 * s2));
                    const bf16x8 va = __builtin_shufflevector(lo, hi, 0, 1, 2, 3, 4, 5, 6, 7);
                    o[et] = __builtin_amdgcn_mfma_f32_32x32x16_bf16(va, pbv, o[et], 0, 0, 0);
                }
                asm volatile("" ::: "memory");
            }
    }
    __syncthreads();
    LAS unsigned char* Ot = C.lds;
    {
        const float inv = 1.0f / lrun;
#pragma unroll
        for (int et = 0; et < 4; ++et)
#pragma unroll
            for (int g4 = 0; g4 < 4; ++g4) {
                const int e0 = 32 * et + 8 * g4 + 4 * h;
                u32x2 w; w.x = pk2(o[et][4 * g4 + 0] * inv, o[et][4 * g4 + 1] * inv); w.y = pk2(o[et][4 * g4 + 2] * inv, o[et][4 * g4 + 3] * inv);
                *(LAS u32x2*)(Ot + (32 * wid + r) * 272 + 2 * e0) = w;
            }
    }
    u32x4 gwv[8];
#pragma unroll
    for (int i = 0; i < 8; ++i) { const int id = tid + 512 * i, qi = id >> 4, c = id & 15; gwv[i] = *(const u32x4*)(P.gate + (size_t)(P.qrow0 + qi) * P.ldq + 8 * c); }
    __syncthreads();
#pragma unroll
    for (int i = 0; i < 8; ++i) { const int id = tid + 512 * i, qi = id >> 4, c = id & 15; const size_t grow = (size_t)(P.qrow0 + qi);
        u32x4 w = *(const LAS u32x4*)(Ot + qi * 272 + 16 * c);
        { const u32x4 gw = gwv[i];
#pragma unroll
            for (int j = 0; j < 4; ++j) w[j] = pk2(bflo(w[j]) * silu(bflo(gw[j])), bfhi(w[j]) * silu(bfhi(gw[j]))); }
        *(u32x4*)(P.o + grow * P.ldo + 8 * c) = w;
        if (P.cdil) {
            const float l0 = P.clse[grow * 4], l1 = P.clse[((size_t)MR + grow) * 4], l2 = P.clse[((size_t)2 * MR + grow) * 4];
            const float mm = fmaxf(l0, fmaxf(l1, l2)); float w0 = __builtin_amdgcn_exp2f(l0 - mm), w1 = __builtin_amdgcn_exp2f(l1 - mm), w2 = __builtin_amdgcn_exp2f(l2 - mm); const float inv = 1.0f / (w0 + w1 + w2);
            w0 *= inv; w1 *= inv; w2 *= inv;
            const u32x4 a = *(const u32x4*)(P.cdil + grow * 512 + 8 * c), b = *(const u32x4*)(P.cdil + ((size_t)MR + grow) * 512 + 8 * c),
                        cc = *(const u32x4*)(P.cdil + ((size_t)2 * MR + grow) * 512 + 8 * c), gd = *(const u32x4*)(P.gate - 1024 + grow * P.ldq + 8 * c);
            u32x4 wo;
#pragma unroll
            for (int j = 0; j < 4; ++j) wo[j] = pk2((bflo(a[j]) * w0 + bflo(b[j]) * w1 + bflo(cc[j]) * w2) * silu(bflo(gd[j])), (bfhi(a[j]) * w0 + bfhi(b[j]) * w1 + bfhi(cc[j]) * w2) * silu(bfhi(gd[j])));
            *(u32x4*)(P.o - 512 + grow * P.ldo + 8 * c) = wo; }
        asm volatile("" ::: "memory"); }
    __syncthreads();
}

struct SAttnP {
    const bf16_t* q; const float* gq;
    const float* kbase; long kstride; int nk;
    const bf16_t* knew; const bf16_t* vnew; const float* gk;
    float* newout;
    bf16_t* o; const bf16_t* gate; float* lse;
};
__device__ __forceinline__ void sattn_item(const Ctx& C, const SAttnP& P) {
    LAS float* sq = (LAS float*)C.lds;
    LAS float* kn = sq + 128;
    LAS float* vn = kn + 128;
    LAS float* sc = vn + 128;
    LAS float* red = sc + 320;
    const int tid = fresh_tid(C.wid);
    const int lane = tid & 63, wid = C.wid;
    const bool extra = P.knew != nullptr;
    const int hw = tid >> 5, l32 = tid & 31, nkh = P.nk >> 4;
    const int eg = tid & 31, kg = tid >> 5, per = P.nk >> 4;
    f32x4 kv[16], vv[16];
#pragma unroll
    for (int i = 0; i < 16; ++i) if (i < nkh) kv[i] = __builtin_nontemporal_load((const f32x4*)(P.kbase + (long)(hw + 16 * i) * P.kstride + 4 * l32));
    { const float* vp = P.kbase + 512 + 4 * eg + (long)(kg * per) * P.kstride;
#pragma unroll
        for (int i = 0; i < 16; ++i) if (i < per) vv[i] = __builtin_nontemporal_load((const f32x4*)(vp + (long)i * P.kstride)); }
    if (wid == 0) { const float a = bflo((unsigned)P.q[2 * lane]), b = bflo((unsigned)P.q[2 * lane + 1]);
        const float ss = wave_sum(a * a + b * b), rs = rsqrtf(ss * (1.0f / 128.0f) + EPS) * QSCALE;
        sq[2 * lane] = a * rs * P.gq[2 * lane]; sq[2 * lane + 1] = b * rs * P.gq[2 * lane + 1]; }
    if (wid == 1 && extra) { const float a = bflo((unsigned)P.knew[2 * lane]), b = bflo((unsigned)P.knew[2 * lane + 1]);
        const float ss = wave_sum(a * a + b * b), rs = rsqrtf(ss * (1.0f / 128.0f) + EPS);
        const float ka = a * rs * P.gk[2 * lane], kb = b * rs * P.gk[2 * lane + 1];
        kn[2 * lane] = ka; kn[2 * lane + 1] = kb; P.newout[2 * lane] = ka; P.newout[2 * lane + 1] = kb; }
    if (wid == 2 && extra) { const float a = bflo((unsigned)P.vnew[2 * lane]), b = bflo((unsigned)P.vnew[2 * lane + 1]);
        vn[2 * lane] = a; vn[2 * lane + 1] = b; P.newout[512 + 2 * lane] = a; P.newout[512 + 2 * lane + 1] = b; }
    __syncthreads();
    {
        const f32x4 qv = *(const LAS f32x4*)(sq + 4 * l32);
        float mine = 0.f;
#pragma unroll
        for (int i = 0; i < 16; ++i) if (i < nkh) { float d = (kv[i][0] * qv[0] + kv[i][1] * qv[1]) + (kv[i][2] * qv[2] + kv[i][3] * qv[3]);
            d = row16_sum(d); d += __shfl_xor(d, 16); if (l32 == i) mine = d; }
        if (l32 < nkh) sc[hw + 16 * l32] = mine;
    }
    if (wid == 7 && extra) { const float d = wave_sum(sq[2 * lane] * kn[2 * lane] + sq[2 * lane + 1] * kn[2 * lane + 1]); if (lane == 0) sc[P.nk] = d; }
    __syncthreads();
    const int ntot = P.nk + (extra ? 1 : 0);
    float m = -1e30f, l = 0.f;
    { float sv[5];
#pragma unroll
        for (int i = 0; i < 5; ++i) { const int j = lane + 64 * i; sv[i] = j < ntot ? sc[j] : -1e30f; m = fmaxf(m, sv[i]); }
        m = wave_max(m);
#pragma unroll
        for (int i = 0; i < 5; ++i) l += __builtin_amdgcn_exp2f(sv[i] - m);
        l = wave_sum(l); }
    const float inv = 1.0f / l;
    {
        f32x4 acc = {0.f, 0.f, 0.f, 0.f};
#pragma unroll
        for (int i = 0; i < 16; ++i) if (i < per) acc += vv[i] * (__builtin_amdgcn_exp2f(sc[kg * per + i] - m) * inv);
        if (extra && kg == 0) acc += *(const LAS f32x4*)(vn + 4 * eg) * (__builtin_amdgcn_exp2f(sc[P.nk] - m) * inv);
        *(LAS f32x4*)(red + kg * 128 + 4 * eg) = acc; }
    __syncthreads();
    if (tid < 128) { float v = 0.f;
#pragma unroll
        for (int g = 0; g < 16; ++g) v += red[g * 128 + tid];
        if (P.gate) v *= silu(bflo((unsigned)P.gate[tid]));
        P.o[tid] = (bf16_t)(pk2(v, 0.f) & 0xffffu); }
    if (tid == 0 && P.lse) P.lse[0] = m + log2f(l);
    __syncthreads();
}

__device__ __forceinline__ void mixer_attn(const Ctx& C, int l, int part) {
    const bool isb = l >= 2; const int bl = l - 2;
    const bf16_t* Z = (const bf16_t*)(C.ws + WS_Z); const bf16_t* KVB = (const bf16_t*)(C.ws + WS_KVB); bf16_t* ACT = (bf16_t*)(C.ws + WS_ACT);
    const bf16_t* MEMKV = (const bf16_t*)(C.ws + WS_MEMKV);
    bf16_t* DILO = (bf16_t*)(C.ws + WS_DILO); float* LSE = (float*)(C.ws + WS_LSE);
    const int ldz = NINB, mqoff = 2048, ldact = isb ? KOUTB : KOUTA, acol = isb ? 512 : 1024;
    const bf16_t* ZS = (const bf16_t*)(C.ws + WS_ZS);
    const int n_smem = part == 2 ? 0 : 128, n_sdil = part == 1 ? 384 : 0, n_pdil = part == 1 ? 1536 : 0, n_pmem = part == 1 ? 0 : 256;
    const int ntot = n_smem + n_sdil + n_pdil + n_pmem;
    const int vb = (C.G % 8 == 0) ? (C.bid % 8) * (C.G / 8) + C.bid / 8 : C.bid;
    for (int it = C.bid; it < n_smem + n_sdil; it += C.G) {
        {
            SAttnP P;
            if (it < n_smem) { const int b = it >> 2, h = it & 3; const size_t row = MP + b;
                P.q = isb ? Z + row * ldz + mqoff + h * 128 : ZS + (size_t)b * NINA + 4096 + h * 128; P.gq = C.in[22] + l * 128;
                P.kbase = C.in[2] + ((size_t)(l * NS + b) * MEML) * 1024 + h * 128; P.kstride = 1024; P.nk = 256;
                P.knew = nullptr; P.vnew = nullptr; P.gk = nullptr; P.newout = nullptr;
                P.o = ACT + row * ldact + acol + h * 128; P.gate = P.q + 512; P.lse = nullptr;
            } else { const int idx = it - n_smem, b = idx / 12, g = (idx / 4) % 3, h = idx & 3; const size_t row = MP + b;
                const int W = g == 0 ? 128 : (g == 1 ? 512 : 2048), d = g == 0 ? 1 : (g == 1 ? 4 : 16);
                const float* buf = g == 0 ? C.in[4] : (g == 1 ? C.in[5] : C.in[6]);
                P.q = Z + row * NINB + g * 512 + h * 128; P.gq = C.in[14] + (bl * 3 + g) * 128;
                P.kbase = buf + ((size_t)b * W + (W - d)) * 1024 + h * 128; P.kstride = -(long)d * 1024; P.nk = 128;
                P.knew = KVB + row * 3072 + g * 1024 + h * 128; P.vnew = P.knew + 512; P.gk = C.in[18] + g * 128;
                P.newout = C.out + (g == 0 ? O_DIL0S : (g == 1 ? O_DIL1S : O_DIL2S)) + (size_t)b * 1024 + h * 128;
                P.o = DILO + ((size_t)g * MR + row) * 512 + h * 128; P.gate = nullptr; P.lse = LSE + ((size_t)g * MR + row) * 4 + h; }
            sattn_item(C, P);
        }
    }
    if (part == 1) {
        u32x4 kw[8], vw[8]; bool have = false;
        for (int it = n_smem + n_sdil + vb; it < ntot; it += C.G) {
            AttnP P; const int idx = it - n_smem - n_sdil, combo = idx & 15, h = (idx >> 4) & 3, g = (idx >> 6) % 3, b = idx / 192;
            const int d = g == 0 ? 1 : (g == 1 ? 4 : 16), res = combo % d, n = combo / d, keep = g == 0 ? 128 : (g == 1 ? 512 : 2048);
            P.q = Z + g * 512 + h * 128; P.ldq = NINB; P.qrow0 = b * SEQ + n * 128 * d + res; P.qrstep = d;
            P.k = KVB + g * 1024 + h * 128; P.v = P.k + 512; P.ldk = 3072; P.krow0 = b * SEQ + (n - 1) * 128 * d + res; P.krstep = d;
            P.gq = C.in[14] + (bl * 3 + g) * 128; P.gk = C.in[18] + g * 128; P.mode = n == 0 ? 2 : 1;
            const int t128 = (n * 128) * d + res;
            const bool wr = (bl == 0) && (t128 >= SEQ - keep);
            P.kvout = C.out + (g == 0 ? O_DIL0P : (g == 1 ? O_DIL1P : O_DIL2P)) + ((size_t)b * keep + (wr ? t128 - (SEQ - keep) : 0)) * 1024 + h * 128;
            P.kv_jfrom = wr ? 128 : 256; P.kv_ostride = (size_t)d * 1024;
            P.o = DILO + (size_t)g * MR * 512 + h * 128; P.ldo = 512; P.gate = nullptr; P.lse = LSE + (size_t)g * MR * 4 + h; P.cdil = nullptr; P.clse = nullptr;
            NextKV nx; nx.valid = 0; nx.k = nullptr; nx.ldk = 3072; nx.krow0 = 0; nx.krstep = 0; nx.it0 = 0;
            { const int itn = it + C.G;
                if (itn < ntot) { const int j2 = itn - n_smem - n_sdil; nx.valid = 1;
                    const int combo2 = j2 & 15, h2 = (j2 >> 4) & 3, g2 = (j2 >> 6) % 3, b2 = j2 / 192, d2 = g2 == 0 ? 1 : (g2 == 1 ? 4 : 16), res2 = combo2 % d2, n2 = combo2 / d2;
                    nx.k = KVB + g2 * 1024 + h2 * 128; nx.krow0 = b2 * SEQ + (n2 - 1) * 128 * d2 + res2; nx.krstep = d2; nx.it0 = n2 == 0 ? 4 : 0; } }
            attn_item(C, P, kw, vw, have, nx);
            have = nx.valid != 0;
        }
    } else {
        u32x4 kw[8], vw[8]; bool have = false;
        for (int it = n_smem + n_sdil + vb; it < ntot; it += C.G) {
            AttnP P; const int idx = it - n_smem - n_sdil, b = idx >> 5, h = (idx >> 3) & 3, qblk = idx & 7;
            P.q = Z + mqoff + h * 128; P.ldq = ldz; P.qrow0 = b * SEQ + qblk * 256; P.qrstep = 1;
            P.k = MEMKV + l * 1024 + h * 128; P.v = P.k + 512; P.ldk = 4096; P.krow0 = b * MEML; P.krstep = 1;
            P.gq = C.in[22] + l * 128; P.gk = C.in[21] + l * 128; P.mode = 0;
            P.kvout = C.out + O_MEMKV + ((size_t)(l * NB + b) * MEML) * 1024 + h * 128; P.kv_jfrom = qblk == 0 ? 0 : 256; P.kv_ostride = 1024;
            P.o = ACT + acol + h * 128; P.ldo = ldact; P.gate = Z + mqoff + 512 + h * 128; P.lse = nullptr;
            P.cdil = part == 2 ? DILO + h * 128 : nullptr; P.clse = part == 2 ? LSE + h : nullptr;
            NextKV nx; nx.valid = 0; nx.k = nullptr; nx.ldk = 4096; nx.krow0 = 0; nx.krstep = 1; nx.it0 = 0;
            { const int itn = it + C.G;
                if (itn < ntot) { const int j2 = itn - n_smem - n_sdil, b2 = j2 >> 5, h2 = (j2 >> 3) & 3; nx.valid = 1;
                    nx.k = MEMKV + l * 1024 + h2 * 128; nx.krow0 = b2 * MEML; } }
            attn_item_wide(C, P, kw, vw, have, nx);
            have = nx.valid != 0;
        }
    }
}
__device__ __forceinline__ void mixer_conv(const Ctx& C, int a) {
    const bf16_t* Z = (const bf16_t*)(C.ws + WS_Z); bf16_t* ACT = (bf16_t*)(C.ws + WS_ACT); const bf16_t* ZS = (const bf16_t*)(C.ws + WS_ZS);
    const float* cw = C.in[10] + (size_t)a * 3 * D;
    for (int task = C.bid * 512 + C.tid; task < (MP / 16) * 128 + NS * 128; task += C.G * 512) {
        const bool smp = task >= (MP / 16) * 128;
        const int chunk = task & 127, col = 8 * chunk;
        float w0[8], w1[8], w2[8], u1[8], u2[8];
#pragma unroll
        for (int i = 0; i < 8; ++i) { w0[i] = cw[col + i]; w1[i] = cw[D + col + i]; w2[i] = cw[2 * D + col + i]; u1[i] = 0.f; u2[i] = 0.f; }
        if (smp) { const int b = (task - (MP / 16) * 128) >> 7;
            const float* st = C.in[3] + ((size_t)(a * NS + b) * 2) * D + col;
            float* cs = C.out + O_CONVS + ((size_t)(a * NS + b) * 2) * D + col;
            const bf16_t* zr = ZS + (size_t)b * NINA + (col >> 7) * 256 + (col & 127);
            const u32x4 hw = *(const u32x4*)zr, cw4 = *(const u32x4*)(zr + 128), bw = *(const u32x4*)(zr + 2048), gw = *(const u32x4*)(zr + 2048 + 128);
            float ov[8];
#pragma unroll
            for (int i = 0; i < 8; ++i) { const float hh = (i & 1) ? bfhi(hw[i >> 1]) : bflo(hw[i >> 1]), cc = (i & 1) ? bfhi(cw4[i >> 1]) : bflo(cw4[i >> 1]);
                const float bg = (i & 1) ? bfhi(bw[i >> 1]) : bflo(bw[i >> 1]), gg = (i & 1) ? bfhi(gw[i >> 1]) : bflo(gw[i >> 1]);
                const float s0 = st[i], s1 = st[D + i], u0 = hh * cc;
                ov[i] = silu(gg) * bg * (w0[i] * s0 + w1[i] * s1 + w2[i] * u0); cs[i] = s1; cs[D + i] = u0; }
            u32x4 w; w.x = pk2(ov[0], ov[1]); w.y = pk2(ov[2], ov[3]); w.z = pk2(ov[4], ov[5]); w.w = pk2(ov[6], ov[7]);
            *(u32x4*)(ACT + (size_t)(MP + b) * KOUTA + col) = w;
            continue; }
        const int t0 = (task >> 7) * 16;
        if ((t0 & (SEQ - 1)) != 0) {
            const u32x4 a1 = *(const u32x4*)(Z + (size_t)(t0 - 1) * NINB + col), a2 = *(const u32x4*)(Z + (size_t)(t0 - 2) * NINB + col);
#pragma unroll
            for (int i = 0; i < 4; ++i) { u1[2 * i] = bflo(a1[i]); u1[2 * i + 1] = bfhi(a1[i]); u2[2 * i] = bflo(a2[i]); u2[2 * i + 1] = bfhi(a2[i]); } }
#pragma unroll 4
        for (int rr = 0; rr < 16; ++rr) {
            const int t = t0 + rr; const bf16_t* zr = Z + (size_t)t * NINB + col;
            const u32x4 uw = *(const u32x4*)zr, gw = *(const u32x4*)(zr + 1024);
            float u0[8], ov[8];
#pragma unroll
            for (int i = 0; i < 4; ++i) { u0[2 * i] = bflo(uw[i]); u0[2 * i + 1] = bfhi(uw[i]); }
#pragma unroll
            for (int i = 0; i < 8; ++i) { const float gb = (i & 1) ? bfhi(gw[i >> 1]) : bflo(gw[i >> 1]); ov[i] = gb * (w0[i] * u2[i] + w1[i] * u1[i] + w2[i] * u0[i]); }
            u32x4 w; w.x = pk2(ov[0], ov[1]); w.y = pk2(ov[2], ov[3]); w.z = pk2(ov[4], ov[5]); w.w = pk2(ov[6], ov[7]);
            *(u32x4*)(ACT + (size_t)t * KOUTA + col) = w;
#pragma unroll
            for (int i = 0; i < 8; ++i) { u2[i] = u1[i]; u1[i] = u0[i]; }
        }
    }
}
__device__ __forceinline__ void mixer_b_combine(const Ctx& C, int row_lo) {
    const bf16_t* Z = (const bf16_t*)(C.ws + WS_Z); bf16_t* ACT = (bf16_t*)(C.ws + WS_ACT);
    const bf16_t* DILO = (const bf16_t*)(C.ws + WS_DILO); const float* LSE = (const float*)(C.ws + WS_LSE);
    for (int task = row_lo * 64 + C.bid * 512 + C.tid; task < MR * 64; task += C.G * 512) {
        const int row = task >> 6, chunk = task & 63, h = chunk >> 4;
        const float l0 = LSE[((size_t)0 * MR + row) * 4 + h], l1 = LSE[((size_t)1 * MR + row) * 4 + h], l2 = LSE[((size_t)2 * MR + row) * 4 + h];
        const float m = fmaxf(l0, fmaxf(l1, l2)); float w0 = exp2f(l0 - m), w1 = exp2f(l1 - m), w2 = exp2f(l2 - m); const float inv = 1.0f / (w0 + w1 + w2);
        w0 *= inv; w1 *= inv; w2 *= inv;
        const u32x4 a = *(const u32x4*)(DILO + ((size_t)0 * MR + row) * 512 + 8 * chunk), b = *(const u32x4*)(DILO + ((size_t)1 * MR + row) * 512 + 8 * chunk),
                    c = *(const u32x4*)(DILO + ((size_t)2 * MR + row) * 512 + 8 * chunk), gw = *(const u32x4*)(Z + (size_t)row * NINB + 1536 + 8 * chunk);
        u32x4 w;
#pragma unroll
        for (int i = 0; i < 4; ++i) { const float lo = (bflo(a[i]) * w0 + bflo(b[i]) * w1 + bflo(c[i]) * w2) * silu(bflo(gw[i]));
            const float hi = (bfhi(a[i]) * w0 + bfhi(b[i]) * w1 + bfhi(c[i]) * w2) * silu(bfhi(gw[i])); w[i] = pk2(lo, hi); }
        *(u32x4*)(ACT + (size_t)row * KOUTB + 8 * chunk) = w;
    }
}

struct GsP { const bf16_t* A; const bf16_t* Bt; int M, N; bf16_t* O; int ldc; const float* ss; int split_cols; size_t split_stride; int sample; float* convp; };
__device__ __forceinline__ void gemm_scale(const Ctx& C, const GsP& q) {
    pg8::Gemm g{q.A, q.Bt, q.M, q.N, D}; pg8::StaticOrder S; S.init(q.M, q.N, C.G, C.bid);
    LAS float* rst = (LAS float*)(C.lds + 131072);
    for (int i = C.tid >> 8; i < 8; i += 2) { pg8::Unit u; if (!S.next(i, u)) break; rst[i * 256 + (C.tid & 255)] = rsqrtf(q.ss[u.pm * 256 + (C.tid & 255)] * (1.0f / 1024.0f) + EPS); }
    __syncthreads();
    pg8::EpiScale E{q.O, q.ldc, rst, q.split_cols, q.split_stride, q.convp};
    pg8::gemm_phase<pg8::EpiScale>(C.lds, g, S, E, C.tid);
    if (q.sample)
        for (int tile = C.bid; tile < q.N / 32; tile += C.G)
            sgemm_tile(C, q.A + (size_t)MP * D, D, q.Bt, D, tile, nullptr, [&](int row, int col, float v) -> float {
                bf16_t* base = q.O; int cc = col; if (q.split_cols) { const int t = cc / q.split_cols; base += (size_t)t * q.split_stride; cc -= t * q.split_cols; }
                const float rs = rsqrtf(q.ss[MP + row] * (1.0f / 1024.0f) + EPS); const bf16_t o = (bf16_t)(pk2(v * rs, 0.f) & 0xffffu);
                if (q.convp) ((bf16_t*)(C.ws + WS_ZS))[(size_t)row * NINA + col] = o; else base[(size_t)(MP + row) * q.ldc + cc] = o; return 0.f; });
}
struct GrP { const bf16_t* A; const bf16_t* Bt; int K; bf16_t* xb; float* xout; float* ssn; };
__device__ __forceinline__ void gemm_resid(const Ctx& C, const GrP& q) {
    pg8::Gemm g{q.A, q.Bt, MP, D, q.K}; pg8::StaticOrder S; S.init(MP, D, C.G, C.bid);
    pg8::EpiResid E{q.xb, q.xout, q.ssn};
    pg8::gemm_phase<pg8::EpiResid>(C.lds, g, S, E, C.tid);
    for (int tile = C.bid; tile < D / 32; tile += C.G)
        sgemm_tile(C, q.A + (size_t)MP * q.K, q.K, q.Bt, q.K, tile, q.xout ? nullptr : q.ssn + MP, [&](int row, int col, float v) -> float {
            const size_t off = (size_t)(MP + row) * D + col; const float x = bflo((unsigned)q.xb[off]) + v;
            if (q.xout) q.xout[off] = x; else q.xb[off] = (bf16_t)(pk2(x, 0.f) & 0xffffu); return x * x; });
}

constexpr int N_STEPS = 18;
#ifndef KMASK
#define KMASK 63
#endif

__global__ void __launch_bounds__(512, 2) yoco_fwd(Params p) {
    extern __shared__ __attribute__((aligned(16))) unsigned char lds_raw[];
    Ctx C; C.in = p.in; C.out = p.out; C.ws = p.ws; C.lds = (LAS unsigned char*)lds_raw;
    C.tid = threadIdx.x; C.lane = C.tid & 63; C.wid = __builtin_amdgcn_readfirstlane(C.tid >> 6); C.G = gridDim.x; C.bid = blockIdx.x;
    cg::grid_group grid = cg::this_grid();
    if (C.tid < 2) ((LAS unsigned*)(C.lds + LDS_ST_OFF))[C.tid] = 0u;
    __syncthreads();
    (void)xcd_barrier_post((unsigned*)(p.ws + WS_CTL), (volatile LAS unsigned*)(C.lds + LDS_ST_OFF));
    for (int s = p.ph_lo; s < p.ph_hi; ++s) {
        unsigned char* wsb = p.ws; float* outb = p.out; asm volatile("" : "+s"(wsb), "+s"(outb));
        C.ws = wsb; C.out = outb;
        bf16_t* Wmem = (bf16_t*)(wsb + WS_WMEM); bf16_t* Wina = (bf16_t*)(wsb + WS_WINA); bf16_t* Wouta = (bf16_t*)(wsb + WS_WOUTA);
        bf16_t* Wkvb = (bf16_t*)(wsb + WS_WKVB); bf16_t* Winb1 = (bf16_t*)(wsb + WS_WINB1); bf16_t* Woutb = (bf16_t*)(wsb + WS_WOUTB);
        bf16_t* XB = (bf16_t*)(wsb + WS_XB); bf16_t* MEMN = (bf16_t*)(wsb + WS_MEMN); bf16_t* MEMKV = (bf16_t*)(wsb + WS_MEMKV);
        bf16_t* Z = (bf16_t*)(wsb + WS_Z); bf16_t* KVB = (bf16_t*)(wsb + WS_KVB); bf16_t* ACT = (bf16_t*)(wsb + WS_ACT);
        float* SS = (float*)(wsb + WS_SS); float* X = outb + O_Y;
        bool sync_after = true;
        if (s == 0) { for (int rep = 0; rep < ((RMASK & 1) ? 2 : 1); ++rep) p0_prologue(launder(C)); }
        else if (s == 1 || s == 2 || s == 6 || s == 10 || s == 14) {
            GsP q; q.split_cols = 0; q.split_stride = 0; q.sample = 1; q.convp = nullptr;
            if (s == 1) { q.A = MEMN; q.Bt = Wmem; q.M = 2048; q.N = 4096; q.O = MEMKV; q.ldc = 4096; q.ss = SS + 4 * SS_STRIDE; q.sample = 0; sync_after = false; }
            else if (s == 2) { q.A = XB; q.Bt = Wina; q.M = MP; q.N = NINA; q.O = Z; q.ldc = NINB; q.ss = SS; q.convp = outb + O_CONVP; }
            else if (s == 6) { q.A = XB; q.Bt = Wina + (size_t)NINA * D; q.M = MP; q.N = NINA; q.O = Z; q.ldc = NINB; q.ss = SS + SS_STRIDE; q.convp = outb + O_CONVP + (size_t)NB * 2 * D; }
            else if (s == 10) { q.A = XB; q.Bt = Wkvb; q.M = MP; q.N = NKVB; q.O = KVB; q.ldc = 3072; q.ss = SS + 2 * SS_STRIDE; q.split_cols = 3072; q.split_stride = (size_t)((WS_Z - WS_KVB) / 2); }
            else { q.A = XB; q.Bt = Winb1; q.M = MP; q.N = NINB; q.O = Z; q.ldc = NINB; q.ss = SS + 3 * SS_STRIDE; }
            for (int rep = 0; rep < ((RMASK & 2) ? 2 : 1); ++rep) gemm_scale(launder(C), q);
            if (s == 2) { const Ctx L = launder(C); const int half = L.G / 2; if (L.bid >= half) p0_weights(L, P0_EARLY, P0_NITEMS, (L.bid - half) * 8 + L.wid, (L.G - half) * 8); }
        } else if (s == 3 || s == 7 || s == 11 || s == 15 || s == 12 || s == 16) { for (int rep = 0; rep < (((RMASK & 4) || ((RMASK & 128) && s < 10) || ((RMASK & 256) && s > 10)) ? 2 : 1); ++rep) mixer_attn(launder(C), s == 3 ? 0 : (s == 7 ? 1 : (s < 14 ? 2 : 3)), s < 10 ? 0 : ((s == 11 || s == 15) ? 1 : 2));
            if (s == 12 || s == 16) mixer_b_combine(launder(C), MP); if (s == 3 || s == 7) sync_after = false; }
        else if (s == 4 || s == 8) { for (int rep = 0; rep < ((RMASK & 8) ? 2 : 1); ++rep) mixer_conv(launder(C), s == 4 ? 0 : 1); }
        else {
            GrP q; q.A = ACT; q.xb = XB; q.xout = nullptr;
            if (s == 5) { q.Bt = Wouta; q.K = KOUTA; q.ssn = SS + SS_STRIDE; }
            else if (s == 9) { q.Bt = Wouta + (size_t)D * KOUTA; q.K = KOUTA; q.ssn = SS + 2 * SS_STRIDE; }
            else if (s == 13) { q.Bt = Woutb; q.K = KOUTB; q.ssn = SS + 3 * SS_STRIDE; }
            else { q.Bt = Woutb + (size_t)D * KOUTB; q.K = KOUTB; q.xout = X; q.ssn = nullptr; }
            gemm_resid(launder(C), q);
        }
        if (sync_after && s + 1 < p.ph_hi) { if (p.ph_hi > 1000) grid.sync(); else { XcdBarrier xb; xb.bar = (unsigned*)(wsb + WS_CTL); xb.x = xb_xcc_id(); xb.st = (volatile LAS unsigned*)(C.lds + LDS_ST_OFF); xcd_barrier(xb); } }
    }
}

extern "C" void kernel_launch(void* const* d_in, const int* in_sizes, int n_in, void* d_out, int out_size, void* d_ws, size_t ws_size, hipStream_t stream) {
    static int grid = 0;
    if (grid == 0) {
        if (n_in != 23 || ws_size < WS_END) { fprintf(stderr, "kernel_launch: unexpected n_in %d or ws_size %zu\n", n_in, ws_size); grid = -1; return; }
        int dev = 0, cus = 0, per_cu = 0;
        hipGetDevice(&dev); hipDeviceGetAttribute(&cus, hipDeviceAttributeMultiprocessorCount, dev);
        if (hipFuncSetAttribute((const void*)yoco_fwd, hipFuncAttributeMaxDynamicSharedMemorySize, LDS_BYTES) != hipSuccess) { fprintf(stderr, "kernel_launch: hipFuncSetAttribute failed\n"); grid = -1; return; }
        if (hipOccupancyMaxActiveBlocksPerMultiprocessor(&per_cu, (const void*)yoco_fwd, 512, LDS_BYTES) != hipSuccess || per_cu < 1) { fprintf(stderr, "kernel_launch: occupancy query failed (%d)\n", per_cu); (void)hipGetLastError(); per_cu = 1; }
        grid = cus * (per_cu > 1 ? 1 : per_cu);
        if (grid > 256) grid = 256;
    }
    if (grid < 0) return;
    if (hipMemsetAsync((char*)d_ws + WS_CTL, 0, CTL_ZERO_BYTES, stream) != hipSuccess) { fprintf(stderr, "kernel_launch: memset of barrier words failed\n"); return; }
    Params p{};
    for (int i = 0; i < 23; ++i) p.in[i] = (const float*)d_in[i];
    p.out = (float*)d_out; p.ws = (unsigned char*)d_ws;
#if N_LAUNCH_MODE == 0
    p.ph_lo = 0; p.ph_hi = N_STEPS;
    void* args[] = {&p};
    hipError_t e = hipLaunchCooperativeKernel((const void*)yoco_fwd, dim3(grid), dim3(512), args, LDS_BYTES, stream);
    if (e != hipSuccess) fprintf(stderr, "cooperative launch failed: %s (grid %d)\n", hipGetErrorString(e), grid);
#else
    static const int cuts[] = {0, 1, 3, 5, 6, 7, 9, 10, 11, 12, 13, 14, 15, 16, 17, 18};
    for (int i = 0; i + 1 < (int)(sizeof(cuts) / sizeof(int)); ++i) { p.ph_lo = cuts[i]; p.ph_hi = cuts[i + 1]; hipLaunchKernelGGL(yoco_fwd, dim3(grid), dim3(512), LDS_BYTES, stream, p); }
#endif
}
```

```cpp
#include <hip/hip_runtime.h>
#include <hip/hip_cooperative_groups.h>
#include <cstdio>
namespace cg = cooperative_groups;

#ifndef N_LAUNCH_MODE
#define N_LAUNCH_MODE 0
#endif

#ifndef RMASK
#define RMASK 0
#endif

#define LAS __attribute__((address_space(3)))
typedef unsigned short bf16_t;
typedef short bf16x8 __attribute__((ext_vector_type(8)));
typedef short s16x4 __attribute__((ext_vector_type(4)));
typedef float f32x4 __attribute__((ext_vector_type(4)));
typedef float f32x16 __attribute__((ext_vector_type(16)));
typedef unsigned u32x4 __attribute__((ext_vector_type(4)));
typedef unsigned u32x2 __attribute__((ext_vector_type(2)));
typedef __bf16 bf16v2 __attribute__((ext_vector_type(2)));

constexpr int D = 1024, NB = 8, SEQ = 2048, MP = NB * SEQ, NS = 32, MR = MP + NS, MEML = 256;
constexpr int NINA = 5120, NKVB = 6144, NINB = 3072, KOUTA = 1536, KOUTB = 1024;
constexpr float EPS = 1e-6f;
constexpr float QSCALE = 0.08838834764831845f * 1.4426950408889634f;

constexpr size_t O_Y = 0, O_MEMKV = 16809984, O_CONVP = 25198592, O_CONVS = 25231360, O_DIL0P = 25362432, O_DIL1P = 26411008,
                 O_DIL2P = 30605312, O_DIL0S = 47382528, O_DIL1S = 47415296, O_DIL2S = 47448064;

constexpr size_t MiB = 1u << 20;
constexpr size_t WS_WMEM = 0, WS_WINA = 8 * MiB, WS_WOUTA = 28 * MiB, WS_WKVB = 34 * MiB, WS_WINB1 = 46 * MiB, WS_WOUTB = 52 * MiB,
                 WS_MEMN = 56 * MiB, WS_MEMKV = 60 * MiB, WS_XB = 76 * MiB, WS_SS = 110 * MiB, WS_Z = 112 * MiB, WS_KVB = 274 * MiB,
                 WS_ACT = 372 * MiB, WS_DILO = 422 * MiB, WS_LSE = 472 * MiB, WS_CTL = 474 * MiB, WS_ZS = 475 * MiB, WS_END = 476 * MiB;
constexpr size_t CTL_ZERO_BYTES = 16384;
constexpr int LDS_ST_OFF = 139264;
constexpr int SS_STRIDE = 16640;

constexpr int LDS_BYTES = 140 * 1024;

__device__ __forceinline__ unsigned pk2(float lo, float hi) { bf16v2 v = {(__bf16)lo, (__bf16)hi}; return __builtin_bit_cast(unsigned, v); }
__device__ __forceinline__ float bflo(unsigned w) { return __builtin_bit_cast(float, w << 16); }
__device__ __forceinline__ float bfhi(unsigned w) { return __builtin_bit_cast(float, w & 0xffff0000u); }
__device__ __forceinline__ float silu(float x) { return x * __builtin_amdgcn_rcpf(1.0f + __builtin_amdgcn_exp2f(x * -1.4426950408889634f)); }
__device__ __forceinline__ float row16_sum(float v) {
    v += __builtin_bit_cast(float, __builtin_amdgcn_mov_dpp(__builtin_bit_cast(int, v), 0xB1, 0xF, 0xF, true));
    v += __builtin_bit_cast(float, __builtin_amdgcn_mov_dpp(__builtin_bit_cast(int, v), 0x4E, 0xF, 0xF, true));
    v += __builtin_bit_cast(float, __builtin_amdgcn_mov_dpp(__builtin_bit_cast(int, v), 0x124, 0xF, 0xF, true));
    v += __builtin_bit_cast(float, __builtin_amdgcn_mov_dpp(__builtin_bit_cast(int, v), 0x128, 0xF, 0xF, true));
    return v;
}
__device__ __forceinline__ float wave_sum(float v) {
#pragma unroll
    for (int o = 1; o < 64; o <<= 1) v += __shfl_xor(v, o);
    return v;
}
__device__ __forceinline__ float wave_max(float v) {
#pragma unroll
    for (int o = 1; o < 64; o <<= 1) v = fmaxf(v, __shfl_xor(v, o));
    return v;
}

namespace pg8 {
constexpr int BM = 256, BK = 64, HALF = 128, HTB = HALF * BK * 2, STAGE_BYTES = 8 * HTB, NXCD = 8, WGM = 4;
__device__ __forceinline__ int lds_byte(int r, int c) { const int st = (r >> 4) * 2 + (c >> 5), rr = r & 15, cc = c & 31, ob = rr * 64 + cc * 2; return st * 1024 + (ob ^ (((ob >> 9) & 1) << 5)); }
__device__ __forceinline__ void stage_rc(int b, int& R, int& C) { const int st = b / 1024, sb = b % 1024, swz = sb ^ (((sb >> 9) & 1) << 5); R = (st >> 1) * 16 + swz / 64; C = (st & 1) * 32 + (swz % 64) / 2; }
__device__ __forceinline__ int perm32(int rho) { const int n = rho >> 4, i = rho & 15; return 8 * (i >> 2) + 4 * n + (i & 3); }
struct Unit { int pm, pn; };
struct Gemm { const bf16_t* A; const bf16_t* Bt; int M, N, K; };
struct StaticOrder {
    int nM, nN, nwg, G, c;
    __device__ void init(int M, int N, int G_, int c_) { nM = M / BM; nN = N / BM; nwg = nM * nN; G = G_; c = c_; }
    __device__ bool next(int i, Unit& u) const {
        const long L = (long)i * G + c; if (L >= nwg) return false;
        int wgid = (int)L; { const int q = nwg / NXCD, r = nwg % NXCD, xcd = wgid % NXCD, off = wgid / NXCD; wgid = (xcd < r ? xcd * (q + 1) : r * (q + 1) + (xcd - r) * q) + off; }
        const int nig = WGM * nN, gid = wgid / nig, fm = gid * WGM, gsz = (nM - fm) < WGM ? (nM - fm) : WGM;
        u.pm = fm + ((wgid % nig) % gsz); u.pn = (wgid % nig) / gsz; return true;
    }
};
struct EpiScale {
    bf16_t* O; int ldc; const LAS float* rst; int split_cols; size_t split_stride;
    float* convp;
    __device__ __forceinline__ void operator()(const f32x4 (&acc)[2][2][4][2], const Unit& u, int wr, int wc, int fr, int fq, int ui) const {
        const int row0 = u.pm * BM + wr * 64 + fr; int colt = u.pn * BM; bf16_t* base = O;
        if (split_cols) { const int t = colt / split_cols; base += (size_t)t * split_stride; colt -= t * split_cols; }
        float rsv[2][4];
        if (convp) { colt = u.pn < 16 ? (u.pn & 7) * 128 + (u.pn >> 3) * 1024 : u.pn * BM - 2048; }
        { const unsigned a = (unsigned)(size_t)(rst + ui * 256 + wr * 64 + fr);
          asm volatile("ds_read_b32 %0, %8\n\tds_read_b32 %1, %8 offset:64\n\tds_read_b32 %2, %8 offset:128\n\tds_read_b32 %3, %8 offset:192\n\t"
                       "ds_read_b32 %4, %8 offset:512\n\tds_read_b32 %5, %8 offset:576\n\tds_read_b32 %6, %8 offset:640\n\tds_read_b32 %7, %8 offset:704\n\ts_waitcnt lgkmcnt(0)"
                       : "=&v"(rsv[0][0]), "=&v"(rsv[0][1]), "=&v"(rsv[0][2]), "=&v"(rsv[0][3]), "=&v"(rsv[1][0]), "=&v"(rsv[1][1]), "=&v"(rsv[1][2]), "=&v"(rsv[1][3]) : "v"(a) : "memory"); }
        const int col0 = colt + wc * 32 + 8 * fq;
        if (convp && u.pn < 16) {
            const bool isu = u.pn < 8;
#pragma unroll
            for (int ai = 0; ai < 2; ++ai)
#pragma unroll
                for (int m = 0; m < 4; ++m) {
                    const int row = row0 + ai * HALF + m * 16; const float rs = rsv[ai][m];
                    f32x4 v0, v1;
                    if (isu) { v0 = acc[ai][0][m][0] * acc[ai][1][m][0] * (rs * rs); v1 = acc[ai][0][m][1] * acc[ai][1][m][1] * (rs * rs); }
                    else {
#pragma unroll
                        for (int j = 0; j < 4; ++j) { v0[j] = acc[ai][0][m][0][j] * rs * silu(acc[ai][1][m][0][j] * rs); v1[j] = acc[ai][0][m][1][j] * rs * silu(acc[ai][1][m][1][j] * rs); } }
                    u32x4 w; w.x = pk2(v0[0], v0[1]); w.y = pk2(v0[2], v0[3]); w.z = pk2(v1[0], v1[1]); w.w = pk2(v1[2], v1[3]);
                    *(u32x4*)(base + (size_t)row * ldc + col0) = w;
                    if (isu && (row & (SEQ - 1)) >= SEQ - 2) { float* cp = convp + ((size_t)(row >> 11) * 2 + ((row & (SEQ - 1)) - (SEQ - 2))) * D + col0; *(f32x4*)cp = v0; *(f32x4*)(cp + 4) = v1; }
                    asm volatile("" ::: "memory"); }
            return;
        }
#pragma unroll
        for (int ai = 0; ai < 2; ++ai)
#pragma unroll
            for (int m = 0; m < 4; ++m) {
                const int row = row0 + ai * HALF + m * 16;
                const float rs = rsv[ai][m];
                bf16_t* rowp = base + (size_t)row * ldc + col0;
#pragma unroll
                for (int bj = 0; bj < 2; ++bj) { const f32x4 v0 = acc[ai][bj][m][0] * rs, v1 = acc[ai][bj][m][1] * rs;
                    u32x4 w; w.x = pk2(v0[0], v0[1]); w.y = pk2(v0[2], v0[3]); w.z = pk2(v1[0], v1[1]); w.w = pk2(v1[2], v1[3]);
                    *(u32x4*)(rowp + bj * HALF) = w; }
                asm volatile("" ::: "memory"); }
    }
};
struct EpiResid {
    bf16_t* xb; float* xout; float* ssn;
    __device__ __forceinline__ void operator()(const f32x4 (&acc)[2][2][4][2], const Unit& u, int wr, int wc, int fr, int fq, int) const {
        const int row0 = u.pm * BM + wr * 64 + fr; const int col0 = u.pn * BM + wc * 32 + 8 * fq;
#pragma unroll
        for (int ai = 0; ai < 2; ++ai)
#pragma unroll
            for (int m = 0; m < 4; ++m) {
                const int row = row0 + ai * HALF + m * 16; float part = 0.f;
#pragma unroll
                for (int bj = 0; bj < 2; ++bj) { const size_t off = (size_t)row * D + col0 + bj * HALF;
                    const u32x4 xw = *(const u32x4*)(xb + off);
                    const f32x4 v0 = acc[ai][bj][m][0] + (f32x4){bflo(xw.x), bfhi(xw.x), bflo(xw.y), bfhi(xw.y)}, v1 = acc[ai][bj][m][1] + (f32x4){bflo(xw.z), bfhi(xw.z), bflo(xw.w), bfhi(xw.w)};
                    if (xout) { __builtin_nontemporal_store(v0, (f32x4*)(xout + off)); __builtin_nontemporal_store(v1, (f32x4*)(xout + off + 4)); }
                    else { u32x4 w; w.x = pk2(v0[0], v0[1]); w.y = pk2(v0[2], v0[3]); w.z = pk2(v1[0], v1[1]); w.w = pk2(v1[2], v1[3]); *(u32x4*)(xb + off) = w;
                        part += (v0[0] * v0[0] + v0[1] * v0[1]) + (v0[2] * v0[2] + v0[3] * v0[3]) + (v1[0] * v1[0] + v1[1] * v1[1]) + (v1[2] * v1[2] + v1[3] * v1[3]); } }
                if (!xout) { part += __shfl_xor(part, 16); part += __shfl_xor(part, 32); if (fq == 0) atomicAdd(ssn + row, part); }
                asm volatile("" ::: "memory"); }
    }
};

template <class Epi>
__device__ __forceinline__ void gemm_phase(LAS unsigned char* lds, const Gemm g, const StaticOrder& S, const Epi& E, const int tid) {
    const int wid = __builtin_amdgcn_readfirstlane(tid >> 6), lane = tid & 63, wr = wid >> 2, wc = wid & 3, fr = lane & 15, fq = lane >> 4;
    const int K = g.K, nt = K / BK;
    unsigned voffA[2], voffB[2];
#pragma unroll
    for (int i = 0; i < 2; ++i) { int R, C; stage_rc(tid * 16 + i * 8192, R, C); const int Rb = (R & ~31) + perm32(R & 31);
        voffA[i] = (unsigned)(R * K + C) * 2u; voffB[i] = (unsigned)(Rb * K + C) * 2u; }
    const size_t kstep = (size_t)(BK * 2);
    const size_t hstep = (size_t)HALF * K * 2;
    const size_t tstep = 2 * hstep;
    const unsigned ldsw = (unsigned)wid * 1024u;
    const int aoff = lds_byte(wr * 64 + fr, fq * 8), boff = lds_byte(wc * 32 + fr, fq * 8);
#define PG8_SA(b, h) (((b) * 2 + (h)) * HTB)
#define PG8_SB(b, h) ((4 + (b) * 2 + (h)) * HTB)
#define PG8_STAGE(bufoff, gbase, voff) do { _Pragma("unroll") for (int _i = 0; _i < 2; ++_i) \
        __builtin_amdgcn_global_load_lds((const unsigned*)((const char*)(gbase) + (voff)[_i]), (LAS unsigned*)(lds + (bufoff) + ldsw + _i * 8192), 16, 0, 0); } while (0)
#define PG8_LDA(dst, b, h) do { _Pragma("unroll") for (int m = 0; m < 4; ++m) _Pragma("unroll") for (int k = 0; k < 2; ++k) dst[m][k] = *(const LAS bf16x8*)(lds + PG8_SA(b, h) + aoff + m * 2048 + k * 1024); } while (0)
#define PG8_LDB(dst, b, h) do { _Pragma("unroll") for (int n = 0; n < 2; ++n) _Pragma("unroll") for (int k = 0; k < 2; ++k) dst[n][k] = *(const LAS bf16x8*)(lds + PG8_SB(b, h) + boff + n * 2048 + k * 1024); } while (0)
#define PG8_MMA(ai, bj, At, Bt) do { __builtin_amdgcn_s_setprio(1); _Pragma("unroll") for (int m = 0; m < 4; ++m) _Pragma("unroll") for (int n = 0; n < 2; ++n) _Pragma("unroll") for (int k = 0; k < 2; ++k) \
        acc[ai][bj][m][n] = __builtin_amdgcn_mfma_f32_16x16x32_bf16(Bt[n][k], At[m][k], acc[ai][bj][m][n], 0, 0, 0); __builtin_amdgcn_s_setprio(0); } while (0)
#define PG8_WAIT_V(n) asm volatile("s_waitcnt vmcnt(" #n ")" ::: "memory")
#define PG8_WAIT_L(n) asm volatile("s_waitcnt lgkmcnt(" #n ")" ::: "memory")
#define PG8_BAR __builtin_amdgcn_s_barrier()
#define PG8_SCHED __builtin_amdgcn_sched_barrier(0)
    Unit cur, nxt; int ui = 0;
    if (!S.next(0, cur)) return;
    f32x4 acc[2][2][4][2];
#pragma unroll
    for (int a = 0; a < 2; ++a)
#pragma unroll
        for (int b = 0; b < 2; ++b)
#pragma unroll
            for (int m = 0; m < 4; ++m)
#pragma unroll
                for (int n = 0; n < 2; ++n) acc[a][b][m][n] = (f32x4){0.f, 0.f, 0.f, 0.f};
    bf16x8 At[4][2], B0[2][2], B1[2][2];
    const char* cA = (const char*)g.A + (size_t)cur.pm * tstep; const char* cB = (const char*)g.Bt + (size_t)cur.pn * tstep;
    PG8_STAGE(PG8_SB(0, 0), cB, voffB); PG8_STAGE(PG8_SA(0, 0), cA, voffA); PG8_STAGE(PG8_SB(0, 1), cB + hstep, voffB); PG8_STAGE(PG8_SA(0, 1), cA + hstep, voffA);
    if (wr == 1) PG8_BAR;
    PG8_WAIT_V(4); PG8_BAR;
    PG8_STAGE(PG8_SB(1, 0), cB + kstep, voffB); PG8_STAGE(PG8_SA(1, 0), cA + kstep, voffA); PG8_STAGE(PG8_SB(1, 1), cB + hstep + kstep, voffB);
    PG8_WAIT_V(6); PG8_BAR;
    for (;;) {
        const bool has_next = S.next(ui + 1, nxt);
        const char* nA = has_next ? (const char*)g.A + (size_t)nxt.pm * tstep : cA; const char* nB = has_next ? (const char*)g.Bt + (size_t)nxt.pn * tstep : cB;
        for (int t = 0; t < nt; t += 2) {
            const bool last = (t == nt - 2);
            const char* a1 = cA + (size_t)(t + 1) * kstep;
            const char* a2 = last ? nA : cA + (size_t)(t + 2) * kstep; const char* b2 = last ? nB : cB + (size_t)(t + 2) * kstep;
            const char* a3 = a2 + kstep; const char* b3 = b2 + kstep;
            PG8_LDB(B0, 0, 0); PG8_SCHED; PG8_LDA(At, 0, 0); PG8_STAGE(PG8_SA(1, 1), a1 + hstep, voffA);
            PG8_WAIT_L(8); PG8_BAR; PG8_WAIT_L(0); PG8_MMA(0, 0, At, B0); PG8_BAR; PG8_SCHED;
            PG8_LDB(B1, 0, 1); PG8_STAGE(PG8_SB(0, 0), b2, voffB);
            PG8_BAR; PG8_WAIT_L(0); PG8_MMA(0, 1, At, B1); PG8_BAR;
            PG8_LDA(At, 0, 1); PG8_STAGE(PG8_SA(0, 0), a2, voffA);
            PG8_BAR; PG8_WAIT_L(0); PG8_MMA(1, 0, At, B0); PG8_BAR; PG8_SCHED;
            PG8_STAGE(PG8_SB(0, 1), b2 + hstep, voffB);
            PG8_WAIT_V(6); PG8_BAR; PG8_MMA(1, 1, At, B1); PG8_BAR;
            PG8_LDB(B0, 1, 0); PG8_SCHED; PG8_LDA(At, 1, 0); PG8_STAGE(PG8_SA(0, 1), a2 + hstep, voffA);
            PG8_WAIT_L(8); PG8_BAR; PG8_WAIT_L(0); PG8_MMA(0, 0, At, B0); PG8_BAR; PG8_SCHED;
            PG8_LDB(B1, 1, 1); PG8_STAGE(PG8_SB(1, 0), b3, voffB);
            PG8_BAR; PG8_WAIT_L(0); PG8_MMA(0, 1, At, B1); PG8_BAR;
            PG8_LDA(At, 1, 1); PG8_STAGE(PG8_SA(1, 0), a3, voffA);
            PG8_BAR; PG8_WAIT_L(0); PG8_MMA(1, 0, At, B0); PG8_BAR; PG8_SCHED;
            PG8_STAGE(PG8_SB(1, 1), b3 + hstep, voffB);
            PG8_WAIT_V(6); PG8_BAR; PG8_MMA(1, 1, At, B1); PG8_BAR;
        }
        E(acc, cur, wr, wc, fr, fq, ui);
        if (!has_next) break;
#pragma unroll
        for (int a = 0; a < 2; ++a)
#pragma unroll
            for (int b = 0; b < 2; ++b)
#pragma unroll
                for (int m = 0; m < 4; ++m)
#pragma unroll
                    for (int n = 0; n < 2; ++n) acc[a][b][m][n] = (f32x4){0.f, 0.f, 0.f, 0.f};
        cur = nxt; cA = nA; cB = nB; ++ui;
    }
    PG8_WAIT_V(0);
    if (wr == 0) PG8_BAR;
    PG8_BAR;
#undef PG8_SA
#undef PG8_SB
#undef PG8_STAGE
#undef PG8_LDA
#undef PG8_LDB
#undef PG8_MMA
#undef PG8_WAIT_V
#undef PG8_WAIT_L
#undef PG8_BAR
#undef PG8_SCHED
}
}

#define XB_TMO      128
#define XB_XCNT(j)  (256  + 64 * (j))
#define XB_XSUB(j)  (1280 + 64 * (j))
#define XB_XGEN(j)  (2304 + 64 * (j))
#define XB_TOP      3328
#define XB_TOPGEN   3392
#define XCD_BAR_WORDS 3456
#define XB_SPIN_CAP (1u << 18)

__device__ __forceinline__ unsigned xb_ld(unsigned* p)              { return __hip_atomic_load(p, __ATOMIC_RELAXED, __HIP_MEMORY_SCOPE_AGENT); }
__device__ __forceinline__ unsigned xb_add(unsigned* p, unsigned v) { return __hip_atomic_fetch_add(p, v, __ATOMIC_RELAXED, __HIP_MEMORY_SCOPE_AGENT); }
__device__ __forceinline__ unsigned xb_xcc_id() { return (unsigned)__builtin_amdgcn_s_getreg((3 << 11) | 20) & 0xFu; }
#define XB_SPIN(cond, bar) do { unsigned _sp = 0; while (cond) { __builtin_amdgcn_s_sleep(1); \
    if ((++_sp & 255u) == 0u) { if (xb_ld(&(bar)[XB_TMO])) break; if (_sp > XB_SPIN_CAP) { atomicAdd(&(bar)[XB_TMO], 1u); break; } } } } while (0)

struct XcdBarrier {
    unsigned* bar; unsigned x;
    volatile LAS unsigned* st;
};

__device__ __forceinline__ XcdBarrier xcd_barrier_post(unsigned* bar, volatile LAS unsigned* st) {
    XcdBarrier b; b.bar = bar; b.x = xb_xcc_id(); b.st = st;
    if (threadIdx.x == 0) (void)xb_add(&bar[XB_XCNT(b.x)], 1u);
    return b;
}
__device__ __forceinline__ void xcd_barrier_complete(unsigned* bar, unsigned x, unsigned& nloc, unsigned& nx) {
    const unsigned G = gridDim.x * gridDim.y * gridDim.z;
    unsigned sum, cnt, mine, sp = 0u;
    for (;;) {
        sum = 0u; cnt = 0u; mine = 0u;
#pragma unroll
        for (unsigned j = 0; j < 16; ++j) { const unsigned c = xb_ld(&bar[XB_XCNT(j)]); sum += c; cnt += (c > 0u) ? 1u : 0u; mine = (j == x) ? c : mine; }
        if (sum == G) break;
        __builtin_amdgcn_s_sleep(1);
        if ((++sp & 255u) == 0u) { if (xb_ld(&bar[XB_TMO])) break; if (sp > XB_SPIN_CAP) { atomicAdd(&bar[XB_TMO], 1u); break; } }
    }
    nloc = mine > 0u ? mine : 1u; nx = cnt > 0u ? cnt : 1u;
}

__device__ __forceinline__ void xcd_barrier(const XcdBarrier& b) {
    asm volatile("s_waitcnt vmcnt(0)" ::: "memory");
    __syncthreads();
    if (threadIdx.x == 0) {
        unsigned* bar = b.bar;
        __builtin_amdgcn_s_waitcnt(0);
        unsigned nloc = b.st[0], nx = b.st[1];
        if (nloc == 0u) { xcd_barrier_complete(bar, b.x, nloc, nx); b.st[0] = nloc; b.st[1] = nx; }
        const unsigned old = xb_add(&bar[XB_XSUB(b.x)], 1u);
        const unsigned gen = old / nloc;
        if (old + 1u == (gen + 1u) * nloc) {
            __builtin_amdgcn_fence(__ATOMIC_RELEASE, "agent");
            asm volatile("s_waitcnt vmcnt(0)" ::: "memory");
            const unsigned og = xb_add(&bar[XB_TOP], 1u);
            const unsigned tg = og / nx;
            if (og + 1u == (tg + 1u) * nx) xb_add(&bar[XB_TOPGEN], 1u);
            else XB_SPIN(xb_ld(&bar[XB_TOPGEN]) == tg, bar);
            __builtin_amdgcn_fence(__ATOMIC_ACQUIRE, "agent");
            xb_add(&bar[XB_XGEN(b.x)], 1u);
            asm volatile("s_waitcnt vmcnt(0)" ::: "memory");
        } else {
            XB_SPIN(xb_ld(&bar[XB_XGEN(b.x)]) == gen, bar);
            __builtin_amdgcn_fence(__ATOMIC_ACQUIRE, "agent");
            asm volatile("s_waitcnt vmcnt(0)" ::: "memory");
        }
    }
    __syncthreads();
}

struct Params {
    const float* in[23];
    float* out;
    unsigned char* ws;
    int ph_lo, ph_hi;
};

struct Ctx {
    const float* const* in; float* out; unsigned char* ws; LAS unsigned char* lds;
    int tid, lane, wid, G, bid;
};
__device__ __forceinline__ int fresh_tid(int wid) { unsigned z = 0u; asm volatile("" : "+v"(z)); return wid * 64 + (int)__builtin_amdgcn_mbcnt_hi(~0u, __builtin_amdgcn_mbcnt_lo(~0u, z)); }
__device__ __forceinline__ Ctx launder(const Ctx& C0) { Ctx C = C0;
    int w = C0.wid, g = C0.G, b = C0.bid; asm volatile("" : "+s"(w), "+s"(g), "+s"(b));
    unsigned z = 0u; asm volatile("" : "+v"(z));
    int t = w * 64 + (int)__builtin_amdgcn_mbcnt_hi(~0u, __builtin_amdgcn_mbcnt_lo(~0u, z));
    asm volatile("" : "+v"(t)); C.tid = t; C.lane = t & 63; C.wid = w; C.G = g; C.bid = b; return C; }

__device__ __forceinline__ int perm_a(int n) { if (n >= 4096) return n; const int part = n >> 10, j = n & 1023; return (part >> 1) * 2048 + (j >> 7) * 256 + (part & 1) * 128 + (j & 127); }
__device__ __forceinline__ void p0_transpose_item(const float* W, int K, int N, bf16_t* WT, int row_off, const float* gain, LAS float* scr, int item, int lane, bool pa = false) {
    const int nblk = N / 32, kb = item / nblk, nb = item % nblk, k0 = 64 * kb, n0 = 32 * nb;
    if (pa) row_off = perm_a(n0) - n0;
    float wv[32];
#pragma unroll
    for (int i = 0; i < 32; ++i) wv[i] = __builtin_nontemporal_load(W + (size_t)(k0 + 2 * i + (lane >> 5)) * N + n0 + (lane & 31));
    const float gl = gain ? gain[k0 + lane] : 1.0f;
#pragma unroll
    for (int i = 0; i < 32; ++i) { const int kk = 2 * i + (lane >> 5); const float gv = __shfl(gl, kk); scr[kk * 33 + (lane & 31)] = wv[i] * gv; }
    asm volatile("s_waitcnt lgkmcnt(0)" ::: "memory");
    const int c = lane & 7;
#pragma unroll
    for (int j = 0; j < 4; ++j) { const int n = (lane >> 3) + 8 * j; const LAS float* s = scr + (8 * c) * 33 + n;
        u32x4 o; o.x = pk2(s[0 * 33], s[1 * 33]); o.y = pk2(s[2 * 33], s[3 * 33]); o.z = pk2(s[4 * 33], s[5 * 33]); o.w = pk2(s[6 * 33], s[7 * 33]);
        *(u32x4*)(WT + (size_t)(row_off + n0 + n) * K + k0 + 8 * c) = o; }
    asm volatile("s_waitcnt lgkmcnt(0)" ::: "memory");
}
__device__ __forceinline__ void row_cvt_ss(const float* xrow, bf16_t* orow, float* ssp, int lane) {
    const f32x4* xr = (const f32x4*)xrow + lane; f32x4 v[4]; float s = 0.f;
#pragma unroll
    for (int j = 0; j < 4; ++j) { v[j] = xr[64 * j]; s += (v[j].x * v[j].x + v[j].y * v[j].y) + (v[j].z * v[j].z + v[j].w * v[j].w); }
    s = wave_sum(s);
    u32x2* o8 = (u32x2*)orow + lane;
#pragma unroll
    for (int j = 0; j < 4; ++j) { u32x2 w; w.x = pk2(v[j].x, v[j].y); w.y = pk2(v[j].z, v[j].w); o8[64 * j] = w; }
    if (lane == 0) *ssp = s;
}
constexpr int I_MEM = 16 * 32, I_INA = 16 * 160, I_OUTA = 24 * 32, I_KV = 16 * 96, I_INB = 16 * 96, I_OUTB = 16 * 32;
constexpr int P0_NITEMS = 4 * I_MEM + 2 * I_INA + 2 * I_OUTA + I_KV + 2 * I_INB + 2 * I_OUTB, P0_EARLY = 4 * I_MEM + 2 * I_INA;
__device__ __forceinline__ void p0_weights(const Ctx& C, int lo, int hi, int gw, int ngw) {
    LAS float* scr = (LAS float*)(C.lds + C.wid * 16384);
    bf16_t* Wmem = (bf16_t*)(C.ws + WS_WMEM); bf16_t* Wina = (bf16_t*)(C.ws + WS_WINA); bf16_t* Wouta = (bf16_t*)(C.ws + WS_WOUTA);
    bf16_t* Wkvb = (bf16_t*)(C.ws + WS_WKVB); bf16_t* Winb1 = (bf16_t*)(C.ws + WS_WINB1); bf16_t* Woutb = (bf16_t*)(C.ws + WS_WOUTB);
    for (int it = lo + gw; it < hi; it += ngw) {
        int r = it;
        if (r < 4 * I_MEM) { const int l = r / I_MEM; p0_transpose_item(C.in[20] + (size_t)l * D * 1024, D, 1024, Wmem, l * 1024, C.in[19] + l * D, scr, r % I_MEM, C.lane); continue; } r -= 4 * I_MEM;
        if (r < 2 * I_INA) { const int a = r / I_INA; p0_transpose_item(C.in[9] + (size_t)a * D * NINA, D, NINA, Wina + (size_t)a * NINA * D, 0, C.in[8] + a * D, scr, r % I_INA, C.lane, true); continue; } r -= 2 * I_INA;
        if (r < 2 * I_OUTA) { const int a = r / I_OUTA; p0_transpose_item(C.in[11] + (size_t)a * KOUTA * D, KOUTA, D, Wouta + (size_t)a * D * KOUTA, 0, nullptr, scr, r % I_OUTA, C.lane); continue; } r -= 2 * I_OUTA;
        if (r < I_KV) { p0_transpose_item(C.in[17], D, 3072, Wkvb, 0, C.in[16], scr, r, C.lane); continue; } r -= I_KV;
        if (r < 2 * I_INB) { const int bl = r / I_INB; p0_transpose_item(C.in[13] + (size_t)bl * D * NINB, D, NINB, bl ? Winb1 : Wkvb, bl ? 0 : 3072, C.in[12] + bl * D, scr, r % I_INB, C.lane); continue; } r -= 2 * I_INB;
        { const int bl = r / I_OUTB; p0_transpose_item(C.in[15] + (size_t)bl * KOUTB * D, KOUTB, D, Woutb + (size_t)bl * D * KOUTB, 0, nullptr, scr, r % I_OUTB, C.lane); }
    }
}
__device__ __forceinline__ void p0_prologue(const Ctx& C) {
    const int gw = C.bid * 8 + C.wid, NGW = C.G * 8;
    p0_weights(C, 0, P0_EARLY, gw, NGW);
    bf16_t* XB = (bf16_t*)(C.ws + WS_XB); bf16_t* MEMN = (bf16_t*)(C.ws + WS_MEMN); float* SS = (float*)(C.ws + WS_SS);
    for (int m = 2 * gw; m < MR + 2048; m += 2 * NGW) {
        const float* src; bf16_t* dst; float* ssp;
        if (m < MP) { src = C.in[0] + (size_t)m * D; dst = XB + (size_t)m * D; ssp = SS + m; }
        else if (m < MR) { src = C.in[1] + (size_t)(m - MP) * D; dst = XB + (size_t)m * D; ssp = SS + m; }
        else { src = C.in[7] + (size_t)(m - MR) * D; dst = MEMN + (size_t)(m - MR) * D; ssp = SS + 4 * SS_STRIDE + (m - MR); }
        const f32x4* xr = (const f32x4*)src + C.lane; f32x4 v[8]; float s0 = 0.f, s1 = 0.f;
#pragma unroll
        for (int j = 0; j < 8; ++j) v[j] = __builtin_nontemporal_load(xr + 64 * j);
#pragma unroll
        for (int j = 0; j < 4; ++j) { s0 += (v[j].x * v[j].x + v[j].y * v[j].y) + (v[j].z * v[j].z + v[j].w * v[j].w); s1 += (v[4 + j].x * v[4 + j].x + v[4 + j].y * v[4 + j].y) + (v[4 + j].z * v[4 + j].z + v[4 + j].w * v[4 + j].w); }
        s0 = wave_sum(s0); s1 = wave_sum(s1);
        u32x2* o8 = (u32x2*)dst + C.lane;
#pragma unroll
        for (int j = 0; j < 8; ++j) { u32x2 w; w.x = pk2(v[j].x, v[j].y); w.y = pk2(v[j].z, v[j].w); o8[64 * j] = w; }
        if (C.lane == 0) { ssp[0] = s0; ssp[1] = s1; }
    }
    for (int i = C.bid * 512 + C.tid; i < 3 * SS_STRIDE; i += C.G * 512) SS[SS_STRIDE + i] = 0.f;
}

template <class F>
__device__ __forceinline__ void sgemm_tile(const Ctx& C, const bf16_t* A, int lda, const bf16_t* Bt, int K, int tile, float* ssrow, F epi) {
    LAS float* red = (LAS float*)C.lds;
    int lane = C.lane; asm volatile("" : "+v"(lane));
    const int r = lane & 31, h = lane >> 5, kc = K / 8, k0 = C.wid * kc, nst = kc / 16;
    f32x16 acc; for (int i = 0; i < 16; ++i) acc[i] = 0.f;
    const bf16_t* ap = A + (size_t)r * lda + k0 + 8 * h;
    const bf16_t* bp = Bt + (size_t)(tile * 32 + r) * K + k0 + 8 * h;
    bf16x8 av[12], bv[12];
#pragma unroll
    for (int s = 0; s < 12; ++s) if (s < nst) { av[s] = *(const bf16x8*)(ap + 16 * s); bv[s] = *(const bf16x8*)(bp + 16 * s); }
#pragma unroll
    for (int s = 0; s < 12; ++s) if (s < nst) acc = __builtin_amdgcn_mfma_f32_32x32x16_bf16(av[s], bv[s], acc, 0, 0, 0);
#pragma unroll
    for (int i = 0; i < 16; ++i) { const int row = (i & 3) + 8 * (i >> 2) + 4 * h; red[(C.wid * 32 + row) * 32 + r] = acc[i]; }
    __syncthreads();
#pragma unroll
    for (int rep = 0; rep < 2; ++rep) { const int idx = C.tid + 512 * rep; float v = 0.f;
#pragma unroll
        for (int w = 0; w < 8; ++w) v += red[w * 1024 + idx];
        float sq = epi(idx >> 5, tile * 32 + (idx & 31), v);
        if (ssrow) { sq += __shfl_xor(sq, 16); sq += __shfl_xor(sq, 8); sq += __shfl_xor(sq, 4); sq += __shfl_xor(sq, 2); sq += __shfl_xor(sq, 1);
            if ((lane & 31) == 0) atomicAdd(ssrow + (idx >> 5), sq); } }
    __syncthreads();
}

__device__ __forceinline__ unsigned off_b(unsigned row, unsigned ch) { return 256u * row + 16u * (ch ^ (((row & 3) << 2) | ((row >> 2) & 3))); }
struct AttnP {
    const bf16_t* q; int ldq, qrow0, qrstep;
    const bf16_t* k; const bf16_t* v; int ldk, krow0, krstep;
    const float* gq; const float* gk;
    int mode;
    float* kvout; int kv_jfrom; size_t kv_ostride;
    bf16_t* o; int ldo;
    const bf16_t* gate;
    float* lse;
    const bf16_t* cdil; const float* clse;
};
struct NextKV { const bf16_t* k; int ldk, krow0, krstep, it0, valid; };
__device__ __forceinline__ void attn_item(const Ctx& C, const AttnP& P, u32x4 (&kw)[8], u32x4 (&vw)[8], const bool have, const NextKV& nx) {
    const int tid = fresh_tid(C.wid);
    const int lane = tid & 63, wid = C.wid, r = lane & 31, h = lane >> 5, qb = wid & 3, kh = wid >> 2;
    LAS unsigned char* Kl = C.lds; LAS unsigned char* Vl = C.lds + 65536;
    bf16x8 qf[8];
    const int qrow = P.qrow0 + (32 * qb + r) * P.qrstep;
    {
        const int c = tid & 15, kr = tid >> 4, it0 = (P.mode == 2 ? 4 : 0);
        const bf16_t* qp = P.q + (size_t)qrow * P.ldq + 8 * h;
        u32x4 raw[8];
#pragma unroll
        for (int s = 0; s < 8; ++s) raw[s] = *(const u32x4*)(qp + 16 * s);
        if (!have) {
#pragma unroll
            for (int it = 0; it < 8; ++it) if (it >= it0) { const size_t row = (size_t)(P.krow0 + (kr + 32 * it) * P.krstep);
                kw[it] = *(const u32x4*)(P.k + row * P.ldk + 8 * c); vw[it] = *(const u32x4*)(P.v + row * P.ldk + 8 * c); } }
        float ss = 0.f;
#pragma unroll
        for (int s = 0; s < 8; ++s)
#pragma unroll
            for (int j = 0; j < 4; ++j) { const float a = bflo(raw[s][j]), b = bfhi(raw[s][j]); ss += a * a + b * b; }
        ss += __shfl_xor(ss, 32);
        const float rs = rsqrtf(ss * (1.0f / 128.0f) + EPS) * QSCALE;
#pragma unroll
        for (int s = 0; s < 8; ++s) {
            u32x4 w; w.x = pk2(bflo(raw[s][0]) * rs, bfhi(raw[s][0]) * rs); w.y = pk2(bflo(raw[s][1]) * rs, bfhi(raw[s][1]) * rs);
            w.z = pk2(bflo(raw[s][2]) * rs, bfhi(raw[s][2]) * rs); w.w = pk2(bflo(raw[s][3]) * rs, bfhi(raw[s][3]) * rs);
            qf[s] = __builtin_bit_cast(bf16x8, w); }
        const f32x4 gk0 = *(const f32x4*)(P.gk + 8 * c), gk1 = *(const f32x4*)(P.gk + 8 * c + 4);
        const f32x4 gq0 = *(const f32x4*)(P.gq + 8 * c), gq1 = *(const f32x4*)(P.gq + 8 * c + 4);
#pragma unroll
        for (int it = 0; it < 8; ++it) if (it >= it0) {
            const int j = kr + 32 * it;
            f32x4 k0 = {bflo(kw[it].x), bfhi(kw[it].x), bflo(kw[it].y), bfhi(kw[it].y)}, k1 = {bflo(kw[it].z), bfhi(kw[it].z), bflo(kw[it].w), bfhi(kw[it].w)};
            float s2 = (k0[0] * k0[0] + k0[1] * k0[1]) + (k0[2] * k0[2] + k0[3] * k0[3]) + (k1[0] * k1[0] + k1[1] * k1[1]) + (k1[2] * k1[2] + k1[3] * k1[3]);
            s2 = row16_sum(s2);
            const float rk = rsqrtf(s2 * (1.0f / 128.0f) + EPS);
            k0 = k0 * rk * gk0; k1 = k1 * rk * gk1;
            const f32x4 kq0 = k0 * gq0, kq1 = k1 * gq1;
            u32x4 w; w.x = pk2(kq0[0], kq0[1]); w.y = pk2(kq0[2], kq0[3]); w.z = pk2(kq1[0], kq1[1]); w.w = pk2(kq1[2], kq1[3]);
            *(LAS u32x4*)(Kl + off_b(j, c)) = w; *(LAS u32x4*)(Vl + off_b(j, c)) = vw[it];
            if (j >= P.kv_jfrom) { float* o = P.kvout + (size_t)(j - P.kv_jfrom) * P.kv_ostride + 8 * c;
                __builtin_nontemporal_store(k0, (f32x4*)o); __builtin_nontemporal_store(k1, (f32x4*)(o + 4));
                __builtin_nontemporal_store((f32x4){bflo(vw[it].x), bfhi(vw[it].x), bflo(vw[it].y), bfhi(vw[it].y)}, (f32x4*)(o + 512)); __builtin_nontemporal_store((f32x4){bflo(vw[it].z), bfhi(vw[it].z), bflo(vw[it].w), bfhi(vw[it].w)}, (f32x4*)(o + 516)); }
        }
    }
    __syncthreads();
    f32x16 o[4]; float mrow = -1e30f, lrow = 0.f;
    const bool active = !(P.mode == 2 && kh == 0);
    u32x4 pb[4][2];
    if (active) {
        {
            f32x16 sacc[4];
            const unsigned xr = ((r & 3) << 2) | ((r >> 2) & 3);
            unsigned kaddr[8];
#pragma unroll
            for (int s = 0; s < 8; ++s) kaddr[s] = 256u * (128 * kh + r) + 16u * ((unsigned)(2 * s + h) ^ xr);
#pragma unroll
            for (int kt = 0; kt < 4; ++kt) { for (int i = 0; i < 16; ++i) sacc[kt][i] = -1e30f;
                if (P.mode == 0 || (kh ? kt <= qb : kt >= qb)) {
                    for (int i = 0; i < 16; ++i) sacc[kt][i] = 0.f;
#pragma unroll
                    for (int s = 0; s < 8; ++s) { const bf16x8 a = *(const LAS bf16x8*)(Kl + kaddr[s] + 8192 * kt); sacc[kt] = __builtin_amdgcn_mfma_f32_32x32x16_bf16(a, qf[s], sacc[kt], 0, 0, 0); } }
                asm volatile("" ::: "memory"); }
            const int qi = 32 * qb + r;
            if (P.mode != 0) {
#pragma unroll
                for (int kt = 0; kt < 4; ++kt)
#pragma unroll
                    for (int i = 0; i < 16; ++i) { const int kj = 32 * kt + (i & 3) + 8 * (i >> 2) + 4 * h; const bool valid = kh ? (kj <= qi) : (kj >= qi); sacc[kt][i] = valid ? sacc[kt][i] : -1e30f; }
            }
            float m = -1e30f;
#pragma unroll
            for (int kt = 0; kt < 4; ++kt)
#pragma unroll
                for (int i = 0; i < 16; ++i) m = fmaxf(m, sacc[kt][i]);
            m = fmaxf(m, __shfl_xor(m, 32));
            float l = 0.f;
#pragma unroll
            for (int kt = 0; kt < 4; ++kt)
#pragma unroll
                for (int s2 = 0; s2 < 2; ++s2) {
                    float pv[8];
#pragma unroll
                    for (int j = 0; j < 8; ++j) { pv[j] = __builtin_amdgcn_exp2f(sacc[kt][8 * s2 + j] - m); l += pv[j]; }
                    pb[kt][s2].x = pk2(pv[0], pv[1]); pb[kt][s2].y = pk2(pv[2], pv[3]); pb[kt][s2].z = pk2(pv[4], pv[5]); pb[kt][s2].w = pk2(pv[6], pv[7]);
                }
            l += __shfl_xor(l, 32);
            mrow = m; lrow = l;
        }
    }
    if (nx.valid) {
        const int c = tid & 15, kr = tid >> 4;
#pragma unroll
        for (int it = 0; it < 8; ++it) if (it >= nx.it0) { const size_t row = (size_t)(nx.krow0 + (kr + 32 * it) * nx.krstep);
            kw[it] = *(const u32x4*)(nx.k + row * nx.ldk + 8 * c); vw[it] = *(const u32x4*)(nx.k + 512 + row * nx.ldk + 8 * c); }
    }
#pragma unroll
    for (int et = 0; et < 4; ++et) for (int i = 0; i < 16; ++i) o[et][i] = 0.f;
    if (active) {
        const int q4 = (lane & 15) >> 2, p4 = lane & 3, blk = (lane >> 4) & 1, clow = 2 * blk + (p4 >> 1);
        unsigned vaddr[4][2];
#pragma unroll
        for (int et = 0; et < 4; ++et)
#pragma unroll
            for (int hi = 0; hi < 2; ++hi) vaddr[et][hi] = 256u * (128 * kh + 4 * h + q4 + 8 * hi) + 64u * (unsigned)(et ^ q4) + 16u * (unsigned)(clow ^ (h + 2 * hi)) + 8u * (p4 & 1);
#pragma unroll
        for (int kt = 0; kt < 4; ++kt)
#pragma unroll
            for (int s2 = 0; s2 < 2; ++s2) if (P.mode == 0 || (kh ? kt <= qb : kt >= qb)) {
                const bf16x8 pbv = __builtin_bit_cast(bf16x8, pb[kt][s2]);
#pragma unroll
                for (int et = 0; et < 4; ++et) {
                    const s16x4 lo = __builtin_amdgcn_ds_read_tr16_b64_v4i16((LAS s16x4*)(Vl + vaddr[et][0] + 8192 * kt + 4096 * s2));
                    const s16x4 hi = __builtin_amdgcn_ds_read_tr16_b64_v4i16((LAS s16x4*)(Vl + vaddr[et][1] + 8192 * kt + 4096 * s2));
                    const bf16x8 va = __builtin_shufflevector(lo, hi, 0, 1, 2, 3, 4, 5, 6, 7);
                    o[et] = __builtin_amdgcn_mfma_f32_32x32x16_bf16(va, pbv, o[et], 0, 0, 0);
                }
                asm volatile("" ::: "memory");
            }
    }
    __syncthreads();
    LAS float* Mo = (LAS float*)C.lds;
    LAS float* Mml = (LAS float*)(C.lds + 65536);
    if (kh == 1) {
#pragma unroll
        for (int et = 0; et < 4; ++et)
#pragma unroll
            for (int i = 0; i < 16; ++i) { const int e = 32 * et + (i & 3) + 8 * (i >> 2) + 4 * h; Mo[(qb * 128 + e) * 32 + r] = o[et][i]; }
        if (h == 0) { Mml[(qb * 2 + 0) * 32 + r] = mrow; Mml[(qb * 2 + 1) * 32 + r] = lrow; }
    }
    __syncthreads();
    LAS unsigned char* Ot = C.lds + 65536 + 2048;
    if (kh == 0) {
        const float m1 = Mml[(qb * 2 + 0) * 32 + r], l1 = Mml[(qb * 2 + 1) * 32 + r];
        const float m = fmaxf(mrow, m1), w0 = __builtin_amdgcn_exp2f(mrow - m), w1 = __builtin_amdgcn_exp2f(m1 - m), l = lrow * w0 + l1 * w1, inv = 1.0f / l;
        const float a0 = w0 * inv, a1 = w1 * inv;
#pragma unroll
        for (int et = 0; et < 4; ++et)
#pragma unroll
            for (int g4 = 0; g4 < 4; ++g4) {
                const int e0 = 32 * et + 8 * g4 + 4 * h;
                float v[4];
#pragma unroll
                for (int j = 0; j < 4; ++j) v[j] = o[et][4 * g4 + j] * a0 + Mo[(qb * 128 + e0 + j) * 32 + r] * a1;
                u32x2 w; w.x = pk2(v[0], v[1]); w.y = pk2(v[2], v[3]);
                *(LAS u32x2*)(Ot + (32 * qb + r) * 272 + 2 * e0) = w;
            }
        if (P.mode != 0 && h == 0) P.lse[(size_t)qrow * 4] = m + log2f(l);
    }
    __syncthreads();
#pragma unroll
    for (int i = 0; i < 4; ++i) { const int id = tid + 512 * i, qi = id >> 4, c = id & 15; const size_t grow = (size_t)(P.qrow0 + qi * P.qrstep);
        u32x4 w = *(const LAS u32x4*)(Ot + qi * 272 + 16 * c);
        if (P.mode == 0) { const u32x4 gw = *(const u32x4*)(P.gate + grow * P.ldq + 8 * c);
#pragma unroll
            for (int j = 0; j < 4; ++j) w[j] = pk2(bflo(w[j]) * silu(bflo(gw[j])), bfhi(w[j]) * silu(bfhi(gw[j]))); }
        *(u32x4*)(P.o + grow * P.ldo + 8 * c) = w;
        if (P.cdil) {
            const float l0 = P.clse[grow * 4], l1 = P.clse[((size_t)MR + grow) * 4], l2 = P.clse[((size_t)2 * MR + grow) * 4];
            const float mm = fmaxf(l0, fmaxf(l1, l2)); float w0 = __builtin_amdgcn_exp2f(l0 - mm), w1 = __builtin_amdgcn_exp2f(l1 - mm), w2 = __builtin_amdgcn_exp2f(l2 - mm); const float inv = 1.0f / (w0 + w1 + w2);
            w0 *= inv; w1 *= inv; w2 *= inv;
            const u32x4 a = *(const u32x4*)(P.cdil + grow * 512 + 8 * c), b = *(const u32x4*)(P.cdil + ((size_t)MR + grow) * 512 + 8 * c),
                        cc = *(const u32x4*)(P.cdil + ((size_t)2 * MR + grow) * 512 + 8 * c), gd = *(const u32x4*)(P.gate - 1024 + grow * P.ldq + 8 * c);
            u32x4 wo;
#pragma unroll
            for (int j = 0; j < 4; ++j) wo[j] = pk2((bflo(a[j]) * w0 + bflo(b[j]) * w1 + bflo(cc[j]) * w2) * silu(bflo(gd[j])), (bfhi(a[j]) * w0 + bfhi(b[j]) * w1 + bfhi(cc[j]) * w2) * silu(bfhi(gd[j])));
            *(u32x4*)(P.o - 512 + grow * P.ldo + 8 * c) = wo; } }
    __syncthreads();
}

__device__ __forceinline__ void attn_item_wide(const Ctx& C, const AttnP& P, u32x4 (&kw)[8], u32x4 (&vw)[8], const bool have, const NextKV& nx) {
    const int tid = fresh_tid(C.wid);
    const int lane = tid & 63, wid = C.wid, r = lane & 31, h = lane >> 5;
    LAS unsigned char* Kl = C.lds; LAS unsigned char* Vl = C.lds + 65536;
    bf16x8 qf[8];
    const int qrow = P.qrow0 + 32 * wid + r;
    {
        const int c = tid & 15, kr = tid >> 4;
        const bf16_t* qp = P.q + (size_t)qrow * P.ldq + 8 * h;
        u32x4 raw[8];
#pragma unroll
        for (int s = 0; s < 8; ++s) raw[s] = *(const u32x4*)(qp + 16 * s);
        if (!have) {
#pragma unroll
            for (int it = 0; it < 8; ++it) { const size_t row = (size_t)(P.krow0 + (kr + 32 * it) * P.krstep);
                kw[it] = *(const u32x4*)(P.k + row * P.ldk + 8 * c); vw[it] = *(const u32x4*)(P.v + row * P.ldk + 8 * c); } }
        float ss = 0.f;
#pragma unroll
        for (int s = 0; s < 8; ++s)
#pragma unroll
            for (int j = 0; j < 4; ++j) { const float a = bflo(raw[s][j]), b = bfhi(raw[s][j]); ss += a * a + b * b; }
        ss += __shfl_xor(ss, 32);
        const float rs = rsqrtf(ss * (1.0f / 128.0f) + EPS) * QSCALE;
#pragma unroll
        for (int s = 0; s < 8; ++s) {
            u32x4 w; w.x = pk2(bflo(raw[s][0]) * rs, bfhi(raw[s][0]) * rs); w.y = pk2(bflo(raw[s][1]) * rs, bfhi(raw[s][1]) * rs);
            w.z = pk2(bflo(raw[s][2]) * rs, bfhi(raw[s][2]) * rs); w.w = pk2(bflo(raw[s][3]) * rs, bfhi(raw[s][3]) * rs);
            qf[s] = __builtin_bit_cast(bf16x8, w); }
        const f32x4 gk0 = *(const f32x4*)(P.gk + 8 * c), gk1 = *(const f32x4*)(P.gk + 8 * c + 4);
        const f32x4 gq0 = *(const f32x4*)(P.gq + 8 * c), gq1 = *(const f32x4*)(P.gq + 8 * c + 4);
#pragma unroll
        for (int it = 0; it < 8; ++it) {
            const int j = kr + 32 * it;
            f32x4 k0 = {bflo(kw[it].x), bfhi(kw[it].x), bflo(kw[it].y), bfhi(kw[it].y)}, k1 = {bflo(kw[it].z), bfhi(kw[it].z), bflo(kw[it].w), bfhi(kw[it].w)};
            float s2 = (k0[0] * k0[0] + k0[1] * k0[1]) + (k0[2] * k0[2] + k0[3] * k0[3]) + (k1[0] * k1[0] + k1[1] * k1[1]) + (k1[2] * k1[2] + k1[3] * k1[3]);
            s2 = row16_sum(s2);
            const float rk = rsqrtf(s2 * (1.0f / 128.0f) + EPS);
            k0 = k0 * rk * gk0; k1 = k1 * rk * gk1;
            const f32x4 kq0 = k0 * gq0, kq1 = k1 * gq1;
            u32x4 w; w.x = pk2(kq0[0], kq0[1]); w.y = pk2(kq0[2], kq0[3]); w.z = pk2(kq1[0], kq1[1]); w.w = pk2(kq1[2], kq1[3]);
            *(LAS u32x4*)(Kl + off_b(j, c)) = w; *(LAS u32x4*)(Vl + off_b(j, c)) = vw[it];
            if (j >= P.kv_jfrom) { float* o = P.kvout + (size_t)(j - P.kv_jfrom) * P.kv_ostride + 8 * c;
                __builtin_nontemporal_store(k0, (f32x4*)o); __builtin_nontemporal_store(k1, (f32x4*)(o + 4));
                __builtin_nontemporal_store((f32x4){bflo(vw[it].x), bfhi(vw[it].x), bflo(vw[it].y), bfhi(vw[it].y)}, (f32x4*)(o + 512)); __builtin_nontemporal_store((f32x4){bflo(vw[it].z), bfhi(vw[it].z), bflo(vw[it].w), bfhi(vw[it].w)}, (f32x4*)(o + 516)); }
        }
    }
    __syncthreads();
    f32x16 o[4]; float mrun = -1e30f, lrun = 0.f;
#pragma unroll
    for (int et = 0; et < 4; ++et) for (int i = 0; i < 16; ++i) o[et][i] = 0.f;
    const unsigned xr = ((r & 3) << 2) | ((r >> 2) & 3);
    const int q4 = (lane & 15) >> 2, p4 = lane & 3, blk = (lane >> 4) & 1, clow = 2 * blk + (p4 >> 1);
#pragma unroll
    for (int st = 0; st < 4; ++st) {
        u32x4 pb[2][2];
        {
            f32x16 sacc[2];
            unsigned kaddr[8];
#pragma unroll
            for (int s = 0; s < 8; ++s) kaddr[s] = 256u * (64 * st + r) + 16u * ((unsigned)(2 * s + h) ^ xr);
#pragma unroll
            for (int kt = 0; kt < 2; ++kt) { for (int i = 0; i < 16; ++i) sacc[kt][i] = 0.f;
#pragma unroll
                for (int s = 0; s < 8; ++s) { const bf16x8 a = *(const LAS bf16x8*)(Kl + kaddr[s] + 8192 * kt); sacc[kt] = __builtin_amdgcn_mfma_f32_32x32x16_bf16(a, qf[s], sacc[kt], 0, 0, 0); }
                asm volatile("" ::: "memory"); }
            float m = mrun;
#pragma unroll
            for (int kt = 0; kt < 2; ++kt)
#pragma unroll
                for (int i = 0; i < 16; ++i) m = fmaxf(m, sacc[kt][i]);
            m = fmaxf(m, __shfl_xor(m, 32));
            const float alpha = __builtin_amdgcn_exp2f(mrun - m);
            float l = 0.f;
#pragma unroll
            for (int kt = 0; kt < 2; ++kt)
#pragma unroll
                for (int s2 = 0; s2 < 2; ++s2) {
                    float pv[8];
#pragma unroll
                    for (int j = 0; j < 8; ++j) { pv[j] = __builtin_amdgcn_exp2f(sacc[kt][8 * s2 + j] - m); l += pv[j]; }
                    pb[kt][s2].x = pk2(pv[0], pv[1]); pb[kt][s2].y = pk2(pv[2], pv[3]); pb[kt][s2].z = pk2(pv[4], pv[5]); pb[kt][s2].w = pk2(pv[6], pv[7]);
                }
            l += __shfl_xor(l, 32);
            lrun = lrun * alpha + l; mrun = m;
#pragma unroll
            for (int et = 0; et < 4; ++et) o[et] = o[et] * alpha;
        }
        if (st == 3 && nx.valid) {
            const int c = tid & 15, kr = tid >> 4;
#pragma unroll
            for (int it = 0; it < 8; ++it) if (it >= nx.it0) { const size_t row = (size_t)(nx.krow0 + (kr + 32 * it) * nx.krstep);
                kw[it] = *(const u32x4*)(nx.k + row * nx.ldk + 8 * c); vw[it] = *(const u32x4*)(nx.k + 512 + row * nx.ldk + 8 * c); }
        }
        unsigned vaddr[4][2];
#pragma unroll
        for (int et = 0; et < 4; ++et)
#pragma unroll
            for (int hi = 0; hi < 2; ++hi) vaddr[et][hi] = 256u * (64 * st + 4 * h + q4 + 8 * hi) + 64u * (unsigned)(et ^ q4) + 16u * (unsigned)(clow ^ (h + 2 * hi)) + 8u * (p4 & 1);
#pragma unroll
        for (int kt = 0; kt < 2; ++kt)
#pragma unroll
            for (int s2 = 0; s2 < 2; ++s2) {
                const bf16x8 pbv = __builtin_bit_cast(bf16x8, pb[kt][s2]);
#pragma unroll
                for (int et = 0; et < 4; ++et) {
                    const s16x4 lo = __builtin_amdgcn_ds_read_tr16_b64_v4i16((LAS s16x4*)(Vl + vaddr[et][0] + 8192 * kt + 4096 * s2));
                    const s16x4 hi = __builtin_amdgcn_ds_read_tr16_b64_v4i16((LAS s16x4*)(Vl + vaddr[et][1] + 8192 * kt + 4096 * s2));
                    const bf16x8 va = __builtin_shufflevector(lo, hi, 0, 1, 2, 3, 4, 5, 6, 7);
                    o[et] = __builtin_amdgcn_mfma_f32_32x32x16_bf16(va, pbv, o[et], 0, 0, 0);
                }
                asm volatile("" ::: "memory");
            }
    }
    __syncthreads();
    LAS unsigned char* Ot = C.lds;
    {
        const float inv = 1.0f / lrun;
#pragma unroll
        for (int et = 0; et < 4; ++et)
#pragma unroll
            for (int g4 = 0; g4 < 4; ++g4) {
                const int e0 = 32 * et + 8 * g4 + 4 * h;
                u32x2 w; w.x = pk2(o[et][4 * g4 + 0] * inv, o[et][4 * g4 + 1] * inv); w.y = pk2(o[et][4 * g4 + 2] * inv, o[et][4 * g4 + 3] * inv);
                *(LAS u32x2*)(Ot + (32 * wid + r) * 272 + 2 * e0) = w;
            }
    }
    u32x4 gwv[8];
#pragma unroll
    for (int i = 0; i < 8; ++i) { const int id = tid + 512 * i, qi = id >> 4, c = id & 15; gwv[i] = *(const u32x4*)(P.gate + (size_t)(P.qrow0 + qi) * P.ldq + 8 * c); }
    __syncthreads();
#pragma unroll
    for (int i = 0; i < 8; ++i) { const int id = tid + 512 * i, qi = id >> 4, c = id & 15; const size_t grow = (size_t)(P.qrow0 + qi);
        u32x4 w = *(const LAS u32x4*)(Ot + qi * 272 + 16 * c);
        { const u32x4 gw = gwv[i];
#pragma unroll
            for (int j = 0; j < 4; ++j) w[j] = pk2(bflo(w[j]) * silu(bflo(gw[j])), bfhi(w[j]) * silu(bfhi(gw[j]))); }
        *(u32x4*)(P.o + grow * P.ldo + 8 * c) = w;
        if (P.cdil) {
            const float l0 = P.clse[grow * 4], l1 = P.clse[((size_t)MR + grow) * 4], l2 = P.clse[((size_t)2 * MR + grow) * 4];
            const float mm = fmaxf(l0, fmaxf(l1, l2)); float w0 = __builtin_amdgcn_exp2f(l0 - mm), w1 = __builtin_amdgcn_exp2f(l1 - mm), w2 = __builtin_amdgcn_exp2f(l2 - mm); const float inv = 1.0f / (w0 + w1 + w2);
            w0 *= inv; w1 *= inv; w2 *= inv;
            const u32x4 a = *(const u32x4*)(P.cdil + grow * 512 + 8 * c), b = *(const u32x4*)(P.cdil + ((size_t)MR + grow) * 512 + 8 * c),
                        cc = *(const u32x4*)(P.cdil + ((size_t)2 * MR + grow) * 512 + 8 * c), gd = *(const u32x4*)(P.gate - 1024 + grow * P.ldq + 8 * c);
            u32x4 wo;
#pragma unroll
            for (int j = 0; j < 4; ++j) wo[j] = pk2((bflo(a[j]) * w0 + bflo(b[j]) * w1 + bflo(cc[j]) * w2) * silu(bflo(gd[j])), (bfhi(a[j]) * w0 + bfhi(b[j]) * w1 + bfhi(cc[j]) * w2) * silu(bfhi(gd[j])));
            *(u32x4*)(P.o - 512 + grow * P.ldo + 8 * c) = wo; }
        asm volatile("" ::: "memory"); }
    __syncthreads();
}

struct SAttnP {
    const bf16_t* q; const float* gq;
    const float* kbase; long kstride; int nk;
    const bf16_t* knew; const bf16_t* vnew; const float* gk;
    float* newout;
    bf16_t* o; const bf16_t* gate; float* lse;
};
__device__ __forceinline__ void sattn_item(const Ctx& C, const SAttnP& P) {
    LAS float* sq = (LAS float*)C.lds;
    LAS float* kn = sq + 128;
    LAS float* vn = kn + 128;
    LAS float* sc = vn + 128;
    LAS float* red = sc + 320;
    const int tid = fresh_tid(C.wid);
    const int lane = tid & 63, wid = C.wid;
    const bool extra = P.knew != nullptr;
    const int hw = tid >> 5, l32 = tid & 31, nkh = P.nk >> 4;
    const int eg = tid & 31, kg = tid >> 5, per = P.nk >> 4;
    f32x4 kv[16], vv[16];
#pragma unroll
    for (int i = 0; i < 16; ++i) if (i < nkh) kv[i] = __builtin_nontemporal_load((const f32x4*)(P.kbase + (long)(hw + 16 * i) * P.kstride + 4 * l32));
    { const float* vp = P.kbase + 512 + 4 * eg + (long)(kg * per) * P.kstride;
#pragma unroll
        for (int i = 0; i < 16; ++i) if (i < per) vv[i] = __builtin_nontemporal_load((const f32x4*)(vp + (long)i * P.kstride)); }
    if (wid == 0) { const float a = bflo((unsigned)P.q[2 * lane]), b = bflo((unsigned)P.q[2 * lane + 1]);
        const float ss = wave_sum(a * a + b * b), rs = rsqrtf(ss * (1.0f / 128.0f) + EPS) * QSCALE;
        sq[2 * lane] = a * rs * P.gq[2 * lane]; sq[2 * lane + 1] = b * rs * P.gq[2 * lane + 1]; }
    if (wid == 1 && extra) { const float a = bflo((unsigned)P.knew[2 * lane]), b = bflo((unsigned)P.knew[2 * lane + 1]);
        const float ss = wave_sum(a * a + b * b), rs = rsqrtf(ss * (1.0f / 128.0f) + EPS);
        const float ka = a * rs * P.gk[2 * lane], kb = b * rs * P.gk[2 * lane + 1];
        kn[2 * lane] = ka; kn[2 * lane + 1] = kb; P.newout[2 * lane] = ka; P.newout[2 * lane + 1] = kb; }
    if (wid == 2 && extra) { const float a = bflo((unsigned)P.vnew[2 * lane]), b = bflo((unsigned)P.vnew[2 * lane + 1]);
        vn[2 * lane] = a; vn[2 * lane + 1] = b; P.newout[512 + 2 * lane] = a; P.newout[512 + 2 * lane + 1] = b; }
    __syncthreads();
    {
        const f32x4 qv = *(const LAS f32x4*)(sq + 4 * l32);
        float mine = 0.f;
#pragma unroll
        for (int i = 0; i < 16; ++i) if (i < nkh) { float d = (kv[i][0] * qv[0] + kv[i][1] * qv[1]) + (kv[i][2] * qv[2] + kv[i][3] * qv[3]);
            d = row16_sum(d); d += __shfl_xor(d, 16); if (l32 == i) mine = d; }
        if (l32 < nkh) sc[hw + 16 * l32] = mine;
    }
    if (wid == 7 && extra) { const float d = wave_sum(sq[2 * lane] * kn[2 * lane] + sq[2 * lane + 1] * kn[2 * lane + 1]); if (lane == 0) sc[P.nk] = d; }
    __syncthreads();
    const int ntot = P.nk + (extra ? 1 : 0);
    float m = -1e30f, l = 0.f;
    { float sv[5];
#pragma unroll
        for (int i = 0; i < 5; ++i) { const int j = lane + 64 * i; sv[i] = j < ntot ? sc[j] : -1e30f; m = fmaxf(m, sv[i]); }
        m = wave_max(m);
#pragma unroll
        for (int i = 0; i < 5; ++i) l += __builtin_amdgcn_exp2f(sv[i] - m);
        l = wave_sum(l); }
    const float inv = 1.0f / l;
    {
        f32x4 acc = {0.f, 0.f, 0.f, 0.f};
#pragma unroll
        for (int i = 0; i < 16; ++i) if (i < per) acc += vv[i] * (__builtin_amdgcn_exp2f(sc[kg * per + i] - m) * inv);
        if (extra && kg == 0) acc += *(const LAS f32x4*)(vn + 4 * eg) * (__builtin_amdgcn_exp2f(sc[P.nk] - m) * inv);
        *(LAS f32x4*)(red + kg * 128 + 4 * eg) = acc; }
    __syncthreads();
    if (tid < 128) { float v = 0.f;
#pragma unroll
        for (int g = 0; g < 16; ++g) v += red[g * 128 + tid];
        if (P.gate) v *= silu(bflo((unsigned)P.gate[tid]));
        P.o[tid] = (bf16_t)(pk2(v, 0.f) & 0xffffu); }
    if (tid == 0 && P.lse) P.lse[0] = m + log2f(l);
    __syncthreads();
}

__device__ __forceinline__ void mixer_attn(const Ctx& C, int l, int part) {
    const bool isb = l >= 2; const int bl = l - 2;
    const bf16_t* Z = (const bf16_t*)(C.ws + WS_Z); const bf16_t* KVB = (const bf16_t*)(C.ws + WS_KVB); bf16_t* ACT = (bf16_t*)(C.ws + WS_ACT);
    const bf16_t* MEMKV = (const bf16_t*)(C.ws + WS_MEMKV);
    bf16_t* DILO = (bf16_t*)(C.ws + WS_DILO); float* LSE = (float*)(C.ws + WS_LSE);
    const int ldz = NINB, mqoff = 2048, ldact = isb ? KOUTB : KOUTA, acol = isb ? 512 : 1024;
    const bf16_t* ZS = (const bf16_t*)(C.ws + WS_ZS);
    const int n_smem = part == 2 ? 0 : 128, n_sdil = part == 1 ? 384 : 0, n_pdil = part == 1 ? 1536 : 0, n_pmem = part == 1 ? 0 : 256;
    const int ntot = n_smem + n_sdil + n_pdil + n_pmem;
    const int vb = (C.G % 8 == 0) ? (C.bid % 8) * (C.G / 8) + C.bid / 8 : C.bid;
    for (int it = C.bid; it < n_smem + n_sdil; it += C.G) {
        {
            SAttnP P;
            if (it < n_smem) { const int b = it >> 2, h = it & 3; const size_t row = MP + b;
                P.q = isb ? Z + row * ldz + mqoff + h * 128 : ZS + (size_t)b * NINA + 4096 + h * 128; P.gq = C.in[22] + l * 128;
                P.kbase = C.in[2] + ((size_t)(l * NS + b) * MEML) * 1024 + h * 128; P.kstride = 1024; P.nk = 256;
                P.knew = nullptr; P.vnew = nullptr; P.gk = nullptr; P.newout = nullptr;
                P.o = ACT + row * ldact + acol + h * 128; P.gate = P.q + 512; P.lse = nullptr;
            } else { const int idx = it - n_smem, b = idx / 12, g = (idx / 4) % 3, h = idx & 3; const size_t row = MP + b;
                const int W = g == 0 ? 128 : (g == 1 ? 512 : 2048), d = g == 0 ? 1 : (g == 1 ? 4 : 16);
                const float* buf = g == 0 ? C.in[4] : (g == 1 ? C.in[5] : C.in[6]);
                P.q = Z + row * NINB + g * 512 + h * 128; P.gq = C.in[14] + (bl * 3 + g) * 128;
                P.kbase = buf + ((size_t)b * W + (W - d)) * 1024 + h * 128; P.kstride = -(long)d * 1024; P.nk = 128;
                P.knew = KVB + row * 3072 + g * 1024 + h * 128; P.vnew = P.knew + 512; P.gk = C.in[18] + g * 128;
                P.newout = C.out + (g == 0 ? O_DIL0S : (g == 1 ? O_DIL1S : O_DIL2S)) + (size_t)b * 1024 + h * 128;
                P.o = DILO + ((size_t)g * MR + row) * 512 + h * 128; P.gate = nullptr; P.lse = LSE + ((size_t)g * MR + row) * 4 + h; }
            sattn_item(C, P);
        }
    }
    if (part == 1) {
        u32x4 kw[8], vw[8]; bool have = false;
        for (int it = n_smem + n_sdil + vb; it < ntot; it += C.G) {
            AttnP P; const int idx = it - n_smem - n_sdil, combo = idx & 15, h = (idx >> 4) & 3, g = (idx >> 6) % 3, b = idx / 192;
            const int d = g == 0 ? 1 : (g == 1 ? 4 : 16), res = combo % d, n = combo / d, keep = g == 0 ? 128 : (g == 1 ? 512 : 2048);
            P.q = Z + g * 512 + h * 128; P.ldq = NINB; P.qrow0 = b * SEQ + n * 128 * d + res; P.qrstep = d;
            P.k = KVB + g * 1024 + h * 128; P.v = P.k + 512; P.ldk = 3072; P.krow0 = b * SEQ + (n - 1) * 128 * d + res; P.krstep = d;
            P.gq = C.in[14] + (bl * 3 + g) * 128; P.gk = C.in[18] + g * 128; P.mode = n == 0 ? 2 : 1;
            const int t128 = (n * 128) * d + res;
            const bool wr = (bl == 0) && (t128 >= SEQ - keep);
            P.kvout = C.out + (g == 0 ? O_DIL0P : (g == 1 ? O_DIL1P : O_DIL2P)) + ((size_t)b * keep + (wr ? t128 - (SEQ - keep) : 0)) * 1024 + h * 128;
            P.kv_jfrom = wr ? 128 : 256; P.kv_ostride = (size_t)d * 1024;
            P.o = DILO + (size_t)g * MR * 512 + h * 128; P.ldo = 512; P.gate = nullptr; P.lse = LSE + (size_t)g * MR * 4 + h; P.cdil = nullptr; P.clse = nullptr;
            NextKV nx; nx.valid = 0; nx.k = nullptr; nx.ldk = 3072; nx.krow0 = 0; nx.krstep = 0; nx.it0 = 0;
            { const int itn = it + C.G;
                if (itn < ntot) { const int j2 = itn - n_smem - n_sdil; nx.valid = 1;
                    const int combo2 = j2 & 15, h2 = (j2 >> 4) & 3, g2 = (j2 >> 6) % 3, b2 = j2 / 192, d2 = g2 == 0 ? 1 : (g2 == 1 ? 4 : 16), res2 = combo2 % d2, n2 = combo2 / d2;
                    nx.k = KVB + g2 * 1024 + h2 * 128; nx.krow0 = b2 * SEQ + (n2 - 1) * 128 * d2 + res2; nx.krstep = d2; nx.it0 = n2 == 0 ? 4 : 0; } }
            attn_item(C, P, kw, vw, have, nx);
            have = nx.valid != 0;
        }
    } else {
        u32x4 kw[8], vw[8]; bool have = false;
        for (int it = n_smem + n_sdil + vb; it < ntot; it += C.G) {
            AttnP P; const int idx = it - n_smem - n_sdil, b = idx >> 5, h = (idx >> 3) & 3, qblk = idx & 7;
            P.q = Z + mqoff + h * 128; P.ldq = ldz; P.qrow0 = b * SEQ + qblk * 256; P.qrstep = 1;
            P.k = MEMKV + l * 1024 + h * 128; P.v = P.k + 512; P.ldk = 4096; P.krow0 = b * MEML; P.krstep = 1;
            P.gq = C.in[22] + l * 128; P.gk = C.in[21] + l * 128; P.mode = 0;
            P.kvout = C.out + O_MEMKV + ((size_t)(l * NB + b) * MEML) * 1024 + h * 128; P.kv_jfrom = qblk == 0 ? 0 : 256; P.kv_ostride = 1024;
            P.o = ACT + acol + h * 128; P.ldo = ldact; P.gate = Z + mqoff + 512 + h * 128; P.lse = nullptr;
            P.cdil = part == 2 ? DILO + h * 128 : nullptr; P.clse = part == 2 ? LSE + h : nullptr;
            NextKV nx; nx.valid = 0; nx.k = nullptr; nx.ldk = 4096; nx.krow0 = 0; nx.krstep = 1; nx.it0 = 0;
            { const int itn = it + C.G;
                if (itn < ntot) { const int j2 = itn - n_smem - n_sdil, b2 = j2 >> 5, h2 = (j2 >> 3) & 3; nx.valid = 1;
                    nx.k = MEMKV + l * 1024 + h2 * 128; nx.krow0 = b2 * MEML; } }
            attn_item_wide(C, P, kw, vw, have, nx);
            have = nx.valid != 0;
        }
    }
}
__device__ __forceinline__ void mixer_conv(const Ctx& C, int a) {
    const bf16_t* Z = (const bf16_t*)(C.ws + WS_Z); bf16_t* ACT = (bf16_t*)(C.ws + WS_ACT); const bf16_t* ZS = (const bf16_t*)(C.ws + WS_ZS);
    const float* cw = C.in[10] + (size_t)a * 3 * D;
    for (int task = C.bid * 512 + C.tid; task < (MP / 16) * 128 + NS * 128; task += C.G * 512) {
        const bool smp = task >= (MP / 16) * 128;
        const int chunk = task & 127, col = 8 * chunk;
        float w0[8], w1[8], w2[8], u1[8], u2[8];
#pragma unroll
        for (int i = 0; i < 8; ++i) { w0[i] = cw[col + i]; w1[i] = cw[D + col + i]; w2[i] = cw[2 * D + col + i]; u1[i] = 0.f; u2[i] = 0.f; }
        if (smp) { const int b = (task - (MP / 16) * 128) >> 7;
            const float* st = C.in[3] + ((size_t)(a * NS + b) * 2) * D + col;
            float* cs = C.out + O_CONVS + ((size_t)(a * NS + b) * 2) * D + col;
            const bf16_t* zr = ZS + (size_t)b * NINA + (col >> 7) * 256 + (col & 127);
            const u32x4 hw = *(const u32x4*)zr, cw4 = *(const u32x4*)(zr + 128), bw = *(const u32x4*)(zr + 2048), gw = *(const u32x4*)(zr + 2048 + 128);
            float ov[8];
#pragma unroll
            for (int i = 0; i < 8; ++i) { const float hh = (i & 1) ? bfhi(hw[i >> 1]) : bflo(hw[i >> 1]), cc = (i & 1) ? bfhi(cw4[i >> 1]) : bflo(cw4[i >> 1]);
                const float bg = (i & 1) ? bfhi(bw[i >> 1]) : bflo(bw[i >> 1]), gg = (i & 1) ? bfhi(gw[i >> 1]) : bflo(gw[i >> 1]);
                const float s0 = st[i], s1 = st[D + i], u0 = hh * cc;
                ov[i] = silu(gg) * bg * (w0[i] * s0 + w1[i] * s1 + w2[i] * u0); cs[i] = s1; cs[D + i] = u0; }
            u32x4 w; w.x = pk2(ov[0], ov[1]); w.y = pk2(ov[2], ov[3]); w.z = pk2(ov[4], ov[5]); w.w = pk2(ov[6], ov[7]);
            *(u32x4*)(ACT + (size_t)(MP + b) * KOUTA + col) = w;
            continue; }
        const int t0 = (task >> 7) * 16;
        if ((t0 & (SEQ - 1)) != 0) {
            const u32x4 a1 = *(const u32x4*)(Z + (size_t)(t0 - 1) * NINB + col), a2 = *(const u32x4*)(Z + (size_t)(t0 - 2) * NINB + col);
#pragma unroll
            for (int i = 0; i < 4; ++i) { u1[2 * i] = bflo(a1[i]); u1[2 * i + 1] = bfhi(a1[i]); u2[2 * i] = bflo(a2[i]); u2[2 * i + 1] = bfhi(a2[i]); } }
#pragma unroll 4
        for (int rr = 0; rr < 16; ++rr) {
            const int t = t0 + rr; const bf16_t* zr = Z + (size_t)t * NINB + col;
            const u32x4 uw = *(const u32x4*)zr, gw = *(const u32x4*)(zr + 1024);
            float u0[8], ov[8];
#pragma unroll
            for (int i = 0; i < 4; ++i) { u0[2 * i] = bflo(uw[i]); u0[2 * i + 1] = bfhi(uw[i]); }
#pragma unroll
            for (int i = 0; i < 8; ++i) { const float gb = (i & 1) ? bfhi(gw[i >> 1]) : bflo(gw[i >> 1]); ov[i] = gb * (w0[i] * u2[i] + w1[i] * u1[i] + w2[i] * u0[i]); }
            u32x4 w; w.x = pk2(ov[0], ov[1]); w.y = pk2(ov[2], ov[3]); w.z = pk2(ov[4], ov[5]); w.w = pk2(ov[6], ov[7]);
            *(u32x4*)(ACT + (size_t)t * KOUTA + col) = w;
#pragma unroll
            for (int i = 0; i < 8; ++i) { u2[i] = u1[i]; u1[i] = u0[i]; }
        }
    }
}
__device__ __forceinline__ void mixer_b_combine(const Ctx& C, int row_lo) {
    const bf16_t* Z = (const bf16_t*)(C.ws + WS_Z); bf16_t* ACT = (bf16_t*)(C.ws + WS_ACT);
    const bf16_t* DILO = (const bf16_t*)(C.ws + WS_DILO); const float* LSE = (const float*)(C.ws + WS_LSE);
    for (int task = row_lo * 64 + C.bid * 512 + C.tid; task < MR * 64; task += C.G * 512) {
        const int row = task >> 6, chunk = task & 63, h = chunk >> 4;
        const float l0 = LSE[((size_t)0 * MR + row) * 4 + h], l1 = LSE[((size_t)1 * MR + row) * 4 + h], l2 = LSE[((size_t)2 * MR + row) * 4 + h];
        const float m = fmaxf(l0, fmaxf(l1, l2)); float w0 = exp2f(l0 - m), w1 = exp2f(l1 - m), w2 = exp2f(l2 - m); const float inv = 1.0f / (w0 + w1 + w2);
        w0 *= inv; w1 *= inv; w2 *= inv;
        const u32x4 a = *(const u32x4*)(DILO + ((size_t)0 * MR + row) * 512 + 8 * chunk), b = *(const u32x4*)(DILO + ((size_t)1 * MR + row) * 512 + 8 * chunk),
                    c = *(const u32x4*)(DILO + ((size_t)2 * MR + row) * 512 + 8 * chunk), gw = *(const u32x4*)(Z + (size_t)row * NINB + 1536 + 8 * chunk);
        u32x4 w;
#pragma unroll
        for (int i = 0; i < 4; ++i) { const float lo = (bflo(a[i]) * w0 + bflo(b[i]) * w1 + bflo(c[i]) * w2) * silu(bflo(gw[i]));
            const float hi = (bfhi(a[i]) * w0 + bfhi(b[i]) * w1 + bfhi(c[i]) * w2) * silu(bfhi(gw[i])); w[i] = pk2(lo, hi); }
        *(u32x4*)(ACT + (size_t)row * KOUTB + 8 * chunk) = w;
    }
}

struct GsP { const bf16_t* A; const bf16_t* Bt; int M, N; bf16_t* O; int ldc; const float* ss; int split_cols; size_t split_stride; int sample; float* convp; };
__device__ __forceinline__ void gemm_scale(const Ctx& C, const GsP& q) {
    pg8::Gemm g{q.A, q.Bt, q.M, q.N, D}; pg8::StaticOrder S; S.init(q.M, q.N, C.G, C.bid);
    LAS float* rst = (LAS float*)(C.lds + 131072);
    for (int i = C.tid >> 8; i < 8; i += 2) { pg8::Unit u; if (!S.next(i, u)) break; rst[i * 256 + (C.tid & 255)] = rsqrtf(q.ss[u.pm * 256 + (C.tid & 255)] * (1.0f / 1024.0f) + EPS); }
    __syncthreads();
    pg8::EpiScale E{q.O, q.ldc, rst, q.split_cols, q.split_stride, q.convp};
    pg8::gemm_phase<pg8::EpiScale>(C.lds, g, S, E, C.tid);
    if (q.sample)
        for (int tile = C.bid; tile < q.N / 32; tile += C.G)
            sgemm_tile(C, q.A + (size_t)MP * D, D, q.Bt, D, tile, nullptr, [&](int row, int col, float v) -> float {
                bf16_t* base = q.O; int cc = col; if (q.split_cols) { const int t = cc / q.split_cols; base += (size_t)t * q.split_stride; cc -= t * q.split_cols; }
                const float rs = rsqrtf(q.ss[MP + row] * (1.0f / 1024.0f) + EPS); const bf16_t o = (bf16_t)(pk2(v * rs, 0.f) & 0xffffu);
                if (q.convp) ((bf16_t*)(C.ws + WS_ZS))[(size_t)row * NINA + col] = o; else base[(size_t)(MP + row) * q.ldc + cc] = o; return 0.f; });
}
struct GrP { const bf16_t* A; const bf16_t* Bt; int K; bf16_t* xb; float* xout; float* ssn; };
__device__ __forceinline__ void gemm_resid(const Ctx& C, const GrP& q) {
    pg8::Gemm g{q.A, q.Bt, MP, D, q.K}; pg8::StaticOrder S; S.init(MP, D, C.G, C.bid);
    pg8::EpiResid E{q.xb, q.xout, q.ssn};
    pg8::gemm_phase<pg8::EpiResid>(C.lds, g, S, E, C.tid);
    for (int tile = C.bid; tile < D / 32; tile += C.G)
        sgemm_tile(C, q.A + (size_t)MP * q.K, q.K, q.Bt, q.K, tile, q.xout ? nullptr : q.ssn + MP, [&](int row, int col, float v) -> float {
            const size_t off = (size_t)(MP + row) * D + col; const float x = bflo((unsigned)q.xb[off]) + v;
            if (q.xout) q.xout[off] = x; else q.xb[off] = (bf16_t)(pk2(x, 0.f) & 0xffffu); return x * x; });
}

constexpr int N_STEPS = 18;
#ifndef KMASK
#define KMASK 63
#endif

__global__ void __launch_bounds__(512, 2) yoco_fwd(Params p) {
    extern __shared__ __attribute__((aligned(16))) unsigned char lds_raw[];
    Ctx C; C.in = p.in; C.out = p.out; C.ws = p.ws; C.lds = (LAS unsigned char*)lds_raw;
    C.tid = threadIdx.x; C.lane = C.tid & 63; C.wid = __builtin_amdgcn_readfirstlane(C.tid >> 6); C.G = gridDim.x; C.bid = blockIdx.x;
    cg::grid_group grid = cg::this_grid();
    if (C.tid < 2) ((LAS unsigned*)(C.lds + LDS_ST_OFF))[C.tid] = 0u;
    __syncthreads();
    (void)xcd_barrier_post((unsigned*)(p.ws + WS_CTL), (volatile LAS unsigned*)(C.lds + LDS_ST_OFF));
    for (int s = p.ph_lo; s < p.ph_hi; ++s) {
        unsigned char* wsb = p.ws; float* outb = p.out; asm volatile("" : "+s"(wsb), "+s"(outb));
        C.ws = wsb; C.out = outb;
        bf16_t* Wmem = (bf16_t*)(wsb + WS_WMEM); bf16_t* Wina = (bf16_t*)(wsb + WS_WINA); bf16_t* Wouta = (bf16_t*)(wsb + WS_WOUTA);
        bf16_t* Wkvb = (bf16_t*)(wsb + WS_WKVB); bf16_t* Winb1 = (bf16_t*)(wsb + WS_WINB1); bf16_t* Woutb = (bf16_t*)(wsb + WS_WOUTB);
        bf16_t* XB = (bf16_t*)(wsb + WS_XB); bf16_t* MEMN = (bf16_t*)(wsb + WS_MEMN); bf16_t* MEMKV = (bf16_t*)(wsb + WS_MEMKV);
        bf16_t* Z = (bf16_t*)(wsb + WS_Z); bf16_t* KVB = (bf16_t*)(wsb + WS_KVB); bf16_t* ACT = (bf16_t*)(wsb + WS_ACT);
        float* SS = (float*)(wsb + WS_SS); float* X = outb + O_Y;
        bool sync_after = true;
        if (s == 0) { for (int rep = 0; rep < ((RMASK & 1) ? 2 : 1); ++rep) p0_prologue(launder(C)); }
        else if (s == 1 || s == 2 || s == 6 || s == 10 || s == 14) {
            GsP q; q.split_cols = 0; q.split_stride = 0; q.sample = 1; q.convp = nullptr;
            if (s == 1) { q.A = MEMN; q.Bt = Wmem; q.M = 2048; q.N = 4096; q.O = MEMKV; q.ldc = 4096; q.ss = SS + 4 * SS_STRIDE; q.sample = 0; sync_after = false; }
            else if (s == 2) { q.A = XB; q.Bt = Wina; q.M = MP; q.N = NINA; q.O = Z; q.ldc = NINB; q.ss = SS; q.convp = outb + O_CONVP; }
            else if (s == 6) { q.A = XB; q.Bt = Wina + (size_t)NINA * D; q.M = MP; q.N = NINA; q.O = Z; q.ldc = NINB; q.ss = SS + SS_STRIDE; q.convp = outb + O_CONVP + (size_t)NB * 2 * D; }
            else if (s == 10) { q.A = XB; q.Bt = Wkvb; q.M = MP; q.N = NKVB; q.O = KVB; q.ldc = 3072; q.ss = SS + 2 * SS_STRIDE; q.split_cols = 3072; q.split_stride = (size_t)((WS_Z - WS_KVB) / 2); }
            else { q.A = XB; q.Bt = Winb1; q.M = MP; q.N = NINB; q.O = Z; q.ldc = NINB; q.ss = SS + 3 * SS_STRIDE; }
            for (int rep = 0; rep < ((RMASK & 2) ? 2 : 1); ++rep) gemm_scale(launder(C), q);
            if (s == 2) { const Ctx L = launder(C); const int half = L.G / 2; if (L.bid >= half) p0_weights(L, P0_EARLY, P0_NITEMS, (L.bid - half) * 8 + L.wid, (L.G - half) * 8); }
        } else if (s == 3 || s == 7 || s == 11 || s == 15 || s == 12 || s == 16) { for (int rep = 0; rep < (((RMASK & 4) || ((RMASK & 128) && s < 10) || ((RMASK & 256) && s > 10)) ? 2 : 1); ++rep) mixer_attn(launder(C), s == 3 ? 0 : (s == 7 ? 1 : (s < 14 ? 2 : 3)), s < 10 ? 0 : ((s == 11 || s == 15) ? 1 : 2));
            if (s == 12 || s == 16) mixer_b_combine(launder(C), MP); if (s == 3 || s == 7) sync_after = false; }
        else if (s == 4 || s == 8) { for (int rep = 0; rep < ((RMASK & 8) ? 2 : 1); ++rep) mixer_conv(launder(C), s == 4 ? 0 : 1); }
        else {
            GrP q; q.A = ACT; q.xb = XB; q.xout = nullptr;
            if (s == 5) { q.Bt = Wouta; q.K = KOUTA; q.ssn = SS + SS_STRIDE; }
            else if (s == 9) { q.Bt = Wouta + (size_t)D * KOUTA; q.K = KOUTA; q.ssn = SS + 2 * SS_STRIDE; }
            else if (s == 13) { q.Bt = Woutb; q.K = KOUTB; q.ssn = SS + 3 * SS_STRIDE; }
            else { q.Bt = Woutb + (size_t)D * KOUTB; q.K = KOUTB; q.xout = X; q.ssn = nullptr; }
            gemm_resid(launder(C), q);
        }
        if (sync_after && s + 1 < p.ph_hi) { if (p.ph_hi > 1000) grid.sync(); else { XcdBarrier xb; xb.bar = (unsigned*)(wsb + WS_CTL); xb.x = xb_xcc_id(); xb.st = (volatile LAS unsigned*)(C.lds + LDS_ST_OFF); xcd_barrier(xb); } }
    }
}

extern "C" void kernel_launch(void* const* d_in, const int* in_sizes, int n_in, void* d_out, int out_size, void* d_ws, size_t ws_size, hipStream_t stream) {
    static int grid = 0;
    if (grid == 0) {
        if (n_in != 23 || ws_size < WS_END) { fprintf(stderr, "kernel_launch: unexpected n_in %d or ws_size %zu\n", n_in, ws_size); grid = -1; return; }
        int dev = 0, cus = 0, per_cu = 0;
        hipGetDevice(&dev); hipDeviceGetAttribute(&cus, hipDeviceAttributeMultiprocessorCount, dev);
        if (hipFuncSetAttribute((const void*)yoco_fwd, hipFuncAttributeMaxDynamicSharedMemorySize, LDS_BYTES) != hipSuccess) { fprintf(stderr, "kernel_launch: hipFuncSetAttribute failed\n"); grid = -1; return; }
        if (hipOccupancyMaxActiveBlocksPerMultiprocessor(&per_cu, (const void*)yoco_fwd, 512, LDS_BYTES) != hipSuccess || per_cu < 1) { fprintf(stderr, "kernel_launch: occupancy query failed (%d)\n", per_cu); (void)hipGetLastError(); per_cu = 1; }
        grid = cus * (per_cu > 1 ? 1 : per_cu);
        if (grid > 256) grid = 256;
    }
    if (grid < 0) return;
    if (hipMemsetAsync((char*)d_ws + WS_CTL, 0, CTL_ZERO_BYTES, stream) != hipSuccess) { fprintf(stderr, "kernel_launch: memset of barrier words failed\n"); return; }
    Params p{};
    for (int i = 0; i < 23; ++i) p.in[i] = (const float*)d_in[i];
    p.out = (float*)d_out; p.ws = (unsigned char*)d_ws;
#if N_LAUNCH_MODE == 0
    p.ph_lo = 0; p.ph_hi = N_STEPS;
    void* args[] = {&p};
    hipError_t e = hipLaunchCooperativeKernel((const void*)yoco_fwd, dim3(grid), dim3(512), args, LDS_BYTES, stream);
    if (e != hipSuccess) fprintf(stderr, "cooperative launch failed: %s (grid %d)\n", hipGetErrorString(e), grid);
#else
    static const int cuts[] = {0, 1, 3, 5, 6, 7, 9, 10, 11, 12, 13, 14, 15, 16, 17, 18};
    for (int i = 0; i + 1 < (int)(sizeof(cuts) / sizeof(int)); ++i) { p.ph_lo = cuts[i]; p.ph_hi = cuts[i + 1]; hipLaunchKernelGGL(yoco_fwd, dim3(grid), dim3(512), LDS_BYTES, stream, p); }
#endif
}
```
